# Optimizing an MI355X kernel written in HIP

```python
import jax, jax.numpy as jnp
from jax import lax
import numpy as np

D_MODEL = 1024
BATCH = 8
SEQ = 4096
DEPTH = 2

GRID_W = 64
CTX_LEN = 256
MIX_WIDTH = D_MODEL
FNET_WIDTH = MIX_WIDTH // 2
FNET_GROUPS = 4
FNET_GROUP_DIM = FNET_WIDTH // FNET_GROUPS
GLA_WIDTH = MIX_WIDTH - FNET_WIDTH
GLA_HEADS = 4
GLA_DV = GLA_WIDTH // GLA_HEADS
GLA_DK = GLA_DV // 2
GLA_QK = GLA_HEADS * GLA_DK
GATE_RANK = 16
GATE_NORMALIZER = 16.0
GLA_CHUNK = 64
D_FF = 2816
N_EXPERTS = 8
TOP_K = 2
EXPERT_FF = 3584
N_DENSE = (DEPTH + 1) // 2
N_MOE = DEPTH // 2
EPS = 1e-6
SPLIT_POINTS = (FNET_WIDTH,
                FNET_WIDTH + GLA_QK,
                FNET_WIDTH + 2 * GLA_QK,
                FNET_WIDTH + 2 * GLA_QK + GLA_WIDTH,
                FNET_WIDTH + 2 * GLA_QK + 2 * GLA_WIDTH,
                FNET_WIDTH + 2 * GLA_QK + 2 * GLA_WIDTH + GATE_RANK)
IN_WIDTH = FNET_WIDTH + 2 * GLA_QK + 2 * GLA_WIDTH + 2 * GATE_RANK

kernel_name = 'hybrid_fnet_gla_moe_dit'


def rmsnorm(x, w):
    xf = x.astype(jnp.float32)
    y = xf * lax.rsqrt(jnp.mean(xf * xf, axis=-1, keepdims=True) + EPS)
    return y.astype(x.dtype) * w


def modulate(h, shift, scale):
    return h * (1 + scale) + shift


def fourier_mix(u):
    B, L, _ = u.shape
    ug = u.reshape(B, L, FNET_GROUPS, FNET_GROUP_DIM).astype(jnp.float32)
    y = jnp.fft.fftn(ug, axes=(1, 3), norm='ortho').real
    return y.reshape(B, L, FNET_WIDTH).astype(u.dtype)


def gla_chunked(q, k, v, log_a, s0):
    B, L, H, DK = q.shape
    DV = v.shape[-1]
    n = L // GLA_CHUNK

    def to_chunks(t):
        return jnp.moveaxis(t.astype(jnp.float32).reshape(B, n, GLA_CHUNK, H, t.shape[-1]), 1, 0)

    qs, ks, vs, gs = to_chunks(q), to_chunks(k), to_chunks(v), to_chunks(log_a)
    causal = jnp.tril(jnp.ones((GLA_CHUNK, GLA_CHUNK), dtype=bool))[None, :, :, None, None]

    def step(S, inp):
        qc, kc, vc, gc = inp
        b = jnp.cumsum(gc, axis=1)
        o_inter = jnp.einsum('bthk,bhkv->bthv', qc * jnp.exp(b), S)
        diff = b[:, :, None] - b[:, None, :]
        decay = jnp.where(causal, jnp.exp(jnp.where(causal, diff, 0.0)), 0.0)
        scores = jnp.einsum('bthk,bshk,btshk->bhts', qc, kc, decay)
        o_intra = jnp.einsum('bhts,bshv->bthv', scores, vc)
        b_last = b[:, -1]
        S_new = jnp.exp(b_last)[..., None] * S + jnp.einsum(
            'bshk,bshv->bhkv', kc * jnp.exp(b_last[:, None] - b), vc)
        return S_new, o_inter + o_intra

    s_fin, o = lax.scan(step, s0.astype(jnp.float32), (qs, ks, vs, gs))
    o = jnp.moveaxis(o, 0, 1).reshape(B, L, H, DV)
    return o, s_fin


def split_projection(p, w_gate_f, b_gate_f, w_gate_b, b_gate_b):
    B, L, _ = p.shape
    u, q, k, v, g, lf, lb = jnp.split(p, SPLIT_POINTS, axis=-1)
    q = q.reshape(B, L, GLA_HEADS, GLA_DK) * (GLA_DK ** -0.5)
    k = k.reshape(B, L, GLA_HEADS, GLA_DK)
    v = v.reshape(B, L, GLA_HEADS, GLA_DV)
    log_f = jax.nn.log_sigmoid((lf @ w_gate_f + b_gate_f).astype(jnp.float32)) / GATE_NORMALIZER
    log_b = jax.nn.log_sigmoid((lb @ w_gate_b + b_gate_b).astype(jnp.float32)) / GATE_NORMALIZER
    log_f = log_f.reshape(B, L, GLA_HEADS, GLA_DK)
    log_b = log_b.reshape(B, L, GLA_HEADS, GLA_DK)
    return u, q, k, v, g, log_f, log_b


def gla_output(o, g, gla_norm_w):
    B, L = o.shape[:2]
    on = o * lax.rsqrt(jnp.mean(o * o, axis=-1, keepdims=True) + EPS)
    on = on.astype(g.dtype) * gla_norm_w
    return on.reshape(B, L, GLA_WIDTH) * jax.nn.silu(g)


def token_mixer(hx, hc, w_in, w_gate_f, b_gate_f, w_gate_b, b_gate_b, gla_norm_w, w_out, ctx_out):
    ux, qx, kx, vx, gx, lfx, lbx = split_projection(hx @ w_in, w_gate_f, b_gate_f, w_gate_b, b_gate_b)
    uc, qc, kc, vc, gc, lfc, lbc = split_projection(hc @ w_in, w_gate_f, b_gate_f, w_gate_b, b_gate_b)
    flip = lambda t: jnp.flip(t, axis=1)
    s0 = jnp.zeros((hx.shape[0], GLA_HEADS, GLA_DK, GLA_DV), jnp.float32)
    oc_f, sc_f = gla_chunked(qc, kc, vc, lfc, s0)
    ox_f, _ = gla_chunked(qx, kx, vx, lfx, sc_f)
    oc_b, sc_b = gla_chunked(flip(qc), flip(kc), flip(vc), flip(lbc), s0)
    ox_b, _ = gla_chunked(flip(qx), flip(kx), flip(vx), flip(lbx), sc_b)
    yx = gla_output(ox_f + flip(ox_b), gx, gla_norm_w)
    out_x = jnp.concatenate([fourier_mix(ux), yx], axis=-1) @ w_out
    if ctx_out:
        yc = gla_output(oc_f + flip(oc_b), gc, gla_norm_w)
        out_c = jnp.concatenate([fourier_mix(uc), yc], axis=-1) @ w_out
    else:
        out_c = None
    return out_x, out_c


def swiglu(h, w1, w3, w2):
    return (jax.nn.silu(h @ w1) * (h @ w3)) @ w2


def moe_swiglu(h, router_w, w1, w3, w2):
    B, L, D = h.shape
    t = h.reshape(B * L, D)
    logits = (t @ router_w).astype(jnp.float32)
    top_v, top_i = lax.top_k(logits, TOP_K)
    gates = jax.nn.softmax(top_v, axis=-1)
    combine = jnp.einsum('tk,tke->te', gates, jax.nn.one_hot(top_i, N_EXPERTS, dtype=jnp.float32))
    combine = combine.astype(t.dtype)
    out = jnp.zeros_like(t)
    for e in range(N_EXPERTS):
        out = out + combine[:, e:e + 1] * swiglu(t, w1[e], w3[e], w2[e])
    return out.reshape(B, L, D)


def channel_mixer(h, l, ffn_w1, ffn_w3, ffn_w2, router_w, moe_w1, moe_w3, moe_w2):
    i = l // 2
    if l % 2 == 0:
        return swiglu(h, ffn_w1[i], ffn_w3[i], ffn_w2[i])
    return moe_swiglu(h, router_w[i], moe_w1[i], moe_w3[i], moe_w2[i])


def setup_inputs(seed: int = 0) -> dict:
    key = jax.random.key(seed)
    ks = jax.random.split(key, 26)
    nrm = lambda k, shape, s: jax.random.normal(k, shape, jnp.float32) * s
    D = D_MODEL
    return {
        'x': nrm(ks[0], (BATCH, SEQ, D), 1.0),
        'c': nrm(ks[1], (BATCH, D), 1.0),
        'ctx': nrm(ks[2], (BATCH, CTX_LEN, D), 1.0),
        'c_ctx': nrm(ks[3], (D,), 1.0),
        'w_mod': nrm(ks[4], (DEPTH, D, 6 * D), 0.5 * D ** -0.5),
        'b_mod': nrm(ks[5], (DEPTH, 6 * D), 0.02),
        'norm_mix_w': 1.0 + nrm(ks[6], (DEPTH, D), 0.02),
        'norm_ffn_w': 1.0 + nrm(ks[7], (DEPTH, D), 0.02),
        'w_in': nrm(ks[8], (DEPTH, D, IN_WIDTH), D ** -0.5),
        'w_gate_f': nrm(ks[9], (DEPTH, GATE_RANK, GLA_QK), GATE_RANK ** -0.5),
        'b_gate_f': nrm(ks[10], (DEPTH, GLA_QK), 0.5),
        'w_gate_b': nrm(ks[11], (DEPTH, GATE_RANK, GLA_QK), GATE_RANK ** -0.5),
        'b_gate_b': nrm(ks[12], (DEPTH, GLA_QK), 0.5),
        'gla_norm_w': 1.0 + nrm(ks[13], (DEPTH, GLA_DV), 0.02),
        'w_out': nrm(ks[14], (DEPTH, MIX_WIDTH, D), MIX_WIDTH ** -0.5),
        'ffn_w1': nrm(ks[15], (N_DENSE, D, D_FF), D ** -0.5),
        'ffn_w3': nrm(ks[16], (N_DENSE, D, D_FF), D ** -0.5),
        'ffn_w2': nrm(ks[17], (N_DENSE, D_FF, D), D_FF ** -0.5),
        'router_w': nrm(ks[18], (N_MOE, D, N_EXPERTS), D ** -0.5),
        'moe_w1': nrm(ks[19], (N_MOE, N_EXPERTS, D, EXPERT_FF), D ** -0.5),
        'moe_w3': nrm(ks[20], (N_MOE, N_EXPERTS, D, EXPERT_FF), D ** -0.5),
        'moe_w2': nrm(ks[21], (N_MOE, N_EXPERTS, EXPERT_FF, D), EXPERT_FF ** -0.5),
        'final_norm_w': 1.0 + nrm(ks[22], (D,), 0.02),
    }


def reference(x, c, ctx, c_ctx, w_mod, b_mod, norm_mix_w, norm_ffn_w, w_in,
              w_gate_f, b_gate_f, w_gate_b, b_gate_b, gla_norm_w, w_out,
              ffn_w1, ffn_w3, ffn_w2, router_w, moe_w1, moe_w3, moe_w2, final_norm_w):
    silu_c = jax.nn.silu(c)
    silu_cc = jax.nn.silu(c_ctx)
    for l in range(DEPTH):
        last = l == DEPTH - 1
        mod_x = (silu_c @ w_mod[l] + b_mod[l])[:, None, :]
        mod_c = (silu_cc @ w_mod[l] + b_mod[l])[None, None, :]
        sh1x, sc1x, g1x, sh2x, sc2x, g2x = jnp.split(mod_x, 6, axis=-1)
        sh1c, sc1c, g1c, sh2c, sc2c, g2c = jnp.split(mod_c, 6, axis=-1)
        hx = modulate(rmsnorm(x, norm_mix_w[l]), sh1x, sc1x)
        hc = modulate(rmsnorm(ctx, norm_mix_w[l]), sh1c, sc1c)
        mx, mc = token_mixer(hx, hc, w_in[l], w_gate_f[l], b_gate_f[l], w_gate_b[l], b_gate_b[l],
                             gla_norm_w[l], w_out[l], not last)
        x = x + g1x * mx
        hx = modulate(rmsnorm(x, norm_ffn_w[l]), sh2x, sc2x)
        x = x + g2x * channel_mixer(hx, l, ffn_w1, ffn_w3, ffn_w2, router_w, moe_w1, moe_w3, moe_w2)
        if not last:
            ctx = ctx + g1c * mc
            hc = modulate(rmsnorm(ctx, norm_ffn_w[l]), sh2c, sc2c)
            ctx = ctx + g2c * channel_mixer(hc, l, ffn_w1, ffn_w3, ffn_w2, router_w, moe_w1, moe_w3, moe_w2)
    return rmsnorm(x, final_norm_w)
```

```cpp
#include <hip/hip_runtime.h>
#include <cstdio>
#include <cstdint>

#ifndef CONV_Q_GIN
#define CONV_Q_GIN 4
#define CONV_Q_GOUT 6
#define CONV_Q_FUP 4
#define CONV_Q_FDN 9
#endif
#ifndef REP_GIN
#define REP_GIN 1
#endif
#ifndef REP_GOUT
#define REP_GOUT 1
#endif
#ifndef REP_FUP
#define REP_FUP 1
#endif
#ifndef REP_MUP
#define REP_MUP 1
#endif
#ifndef REP_GEMM
#define REP_GEMM 1
#endif
#ifndef REP_NORM
#define REP_NORM 1
#endif
#ifndef REP_MIXA
#define REP_MIXA 1
#endif
#ifndef REP_VAR
#define REP_VAR 0
#endif
#ifndef REP_MASK
#define REP_MASK 7
#endif
#ifndef REP_MIXC
#define REP_MIXC 1
#endif
#ifndef REP_PRO
#define REP_PRO 1
#endif
#ifndef I8_GIN
#define I8_GIN 1
#endif
#ifndef I8_FUP
#define I8_FUP 1
#endif
#ifndef FP8_FUP
#define FP8_FUP 0
#endif
#ifndef FP8_FDN
#define FP8_FDN 1
#endif
#ifndef MK_MULTI
#define MK_MULTI 0
#endif

constexpr int D = 1024, NB = 8, SEQ = 4096, CTXL = 256;
constexpr int NL = NB * SEQ;
constexpr int NC = NB * CTXL;
constexpr int MT = NL + NC;
constexpr int INW = 2080, INP = 2304;
constexpr int DFF = 2816, EFF = 3584, NE = 8;
constexpr int MOD6 = 6 * D;
constexpr float EPS = 1e-6f;
constexpr float FP8_SH = 16.0f, FP8_SW = 512.0f, FP8_SHID = 8.0f;
constexpr int PC_U = 0, PC_Q = 512, PC_K = 768, PC_V = 1024, PC_G = 1536, PC_LF = 2048, PC_LB = 2064;

namespace pg8 {
#define PG8_LAS __attribute__((address_space(3)))
typedef unsigned short bf16_t;
typedef short bf16x8 __attribute__((ext_vector_type(8)));
typedef float f32x4 __attribute__((ext_vector_type(4)));
typedef unsigned u32x4 __attribute__((ext_vector_type(4)));
constexpr int BM = 256, BK = 64, HALF = 128, HTB = HALF * BK * 2, STAGE_BYTES = 8 * HTB, NXCD = 8, WGM = 8;

__host__ __device__ __forceinline__ int lds_byte(int r, int c) { const int st = (r >> 4) * 2 + (c >> 5), rr = r & 15, cc = c & 31, ob = rr * 64 + cc * 2; return st * 1024 + (ob ^ (((ob >> 9) & 1) << 5)); }
__host__ __device__ __forceinline__ void stage_rc(int b, int& R, int& C) { const int st = b / 1024, sb = b % 1024, swz = sb ^ (((sb >> 9) & 1) << 5); R = (st >> 1) * 16 + swz / 64; C = (st & 1) * 32 + (swz % 64) / 2; }
__host__ __device__ __forceinline__ int perm32(int rho) { const int n = rho >> 4, i = rho & 15; return 8 * (i >> 2) + 4 * n + (i & 3); }

struct Unit { int pm, pn; const char* a; const char* b; const int* ridx; };

__device__ __forceinline__ const char* uptr(const char* p) { const unsigned long long v = (unsigned long long)p; const unsigned lo = __builtin_amdgcn_readfirstlane((unsigned)v), hi = __builtin_amdgcn_readfirstlane((unsigned)(v >> 32)); return (const char*)(((unsigned long long)hi << 32) | lo); }
__device__ __forceinline__ void glds_s(const char* base, unsigned voff, unsigned lds_dst) { unsigned keep;
    asm volatile("s_mov_b32 %0, m0\n\ts_mov_b32 m0, %3\n\ts_nop 0\n\tglobal_load_lds_dwordx4 %1, %2\n\ts_mov_b32 m0, %0" : "=&s"(keep) : "v"(voff), "s"((unsigned long long)base), "s"(lds_dst) : "memory"); }
struct OrderCore {
    int nM, nN, nwg, G, c;
    __device__ __forceinline__ void init(int nM_, int nN_, int G_, int c_) { nM = nM_; nN = nN_; nwg = nM * nN; G = G_; c = c_; }
    __device__ __forceinline__ bool tile(int i, int& pm, int& pn) const {
        const long L = (long)i * G + c; if (L >= nwg) return false;
        int wgid = (int)L; { const int q = nwg / NXCD, r = nwg % NXCD, xcd = wgid % NXCD, off = wgid / NXCD; wgid = (xcd < r ? xcd * (q + 1) : r * (q + 1) + (xcd - r) * q) + off; }
        const int nig = WGM * nN, gid = wgid / nig, fm = gid * WGM, gsz = (nM - fm) < WGM ? (nM - fm) : WGM;
        pm = fm + ((wgid % nig) % gsz); pn = (wgid % nig) / gsz; return true;
    }
};
struct DenseOrder {
    OrderCore oc; const char* A; const char* Bt; size_t tstep;
    __device__ __forceinline__ void init(const bf16_t* A_, const bf16_t* Bt_, int M, int N, int K, int G, int c) { oc.init(M / BM, N / BM, G, c); A = (const char*)A_; Bt = (const char*)Bt_; tstep = (size_t)BM * K * 2; }
    __device__ __forceinline__ bool next(int i, Unit& u) const { if (!oc.tile(i, u.pm, u.pn)) return false; u.pm = __builtin_amdgcn_readfirstlane(u.pm); u.pn = __builtin_amdgcn_readfirstlane(u.pn); u.a = uptr(A + (size_t)u.pm * tstep); u.b = uptr(Bt + (size_t)u.pn * tstep); u.ridx = nullptr; return true; }
};
struct MoeOrder {
    OrderCore oc; const char* A; const char* Bt; size_t tstepA, tstepB, estride; const int* texp; const int* ridx; int nt0, gap;
    __device__ __forceinline__ bool next(int i, Unit& u) const { if (!oc.tile(i, u.pm, u.pn)) return false;
        u.pm = u.pm < nt0 ? u.pm : u.pm + gap;
        const int e = __builtin_amdgcn_readfirstlane(__hip_atomic_load(texp + u.pm, __ATOMIC_RELAXED, __HIP_MEMORY_SCOPE_AGENT));
        u.pm = __builtin_amdgcn_readfirstlane(u.pm); u.pn = __builtin_amdgcn_readfirstlane(u.pn); u.a = uptr(A + (size_t)u.pm * tstepA); u.b = uptr(Bt + (size_t)e * estride + (size_t)u.pn * tstepB); u.ridx = (const int*)uptr((const char*)(ridx + u.pm * BM)); return true; }
};

typedef int v4i_t __attribute__((ext_vector_type(4)));
typedef int v8i_t __attribute__((ext_vector_type(8)));
__device__ __forceinline__ v8i_t cat8(const bf16x8 lo, const bf16x8 hi) { const v4i_t a = __builtin_bit_cast(v4i_t, lo), b = __builtin_bit_cast(v4i_t, hi); return __builtin_shufflevector(a, b, 0, 1, 2, 3, 4, 5, 6, 7); }
__device__ __forceinline__ void mfma8(f32x4& acc, const v8i_t a, const v8i_t b, const int sc) {
    asm volatile("v_mfma_scale_f32_16x16x128_f8f6f4 %0, %1, %2, %0, %3, %3 op_sel_hi:[0,0,0]" : "+v"(acc) : "v"(a), "v"(b), "v"(sc)); }
__device__ __forceinline__ unsigned pk4_fp8_raw(float a, float b, float c, float d) { int r = __builtin_amdgcn_cvt_pk_fp8_f32(a, b, 0, false); r = __builtin_amdgcn_cvt_pk_fp8_f32(c, d, r, true); return (unsigned)r; }
__device__ __forceinline__ unsigned pk4_fp8(float a, float b, float c, float d) { return pk4_fp8_raw(__builtin_amdgcn_fmed3f(a, -448.f, 448.f), __builtin_amdgcn_fmed3f(b, -448.f, 448.f), __builtin_amdgcn_fmed3f(c, -448.f, 448.f), __builtin_amdgcn_fmed3f(d, -448.f, 448.f)); }
__device__ __forceinline__ float clamp448(float v) { return __builtin_fminf(__builtin_fmaxf(v, -448.0f), 448.0f); }
__device__ __forceinline__ unsigned cvt_pk_bf16(float lo, float hi) { unsigned r; asm volatile("v_cvt_pk_bf16_f32 %0, %1, %2" : "=v"(r) : "v"(lo), "v"(hi)); return r; }

struct EpiBf16 {
    static constexpr bool PERM = true;
    bf16_t* O; int ldc;
    __device__ __forceinline__ void operator()(const f32x4 (&acc)[2][2][4][2], const Unit& u, int wr, int wc, int fr, int fq) const {
        const int row0 = u.pm * BM + wr * 64 + fr, col0 = u.pn * BM + wc * 32 + 8 * fq;
#pragma unroll
        for (int ai = 0; ai < 2; ++ai)
#pragma unroll
            for (int m = 0; m < 4; ++m) { bf16_t* rowp = O + (size_t)(row0 + ai * HALF + m * 16) * ldc + col0;
#pragma unroll
                for (int bj = 0; bj < 2; ++bj) { const f32x4 v0 = acc[ai][bj][m][0], v1 = acc[ai][bj][m][1];
                    u32x4 w; w.x = cvt_pk_bf16(v0[0], v0[1]); w.y = cvt_pk_bf16(v0[2], v0[3]); w.z = cvt_pk_bf16(v1[0], v1[1]); w.w = cvt_pk_bf16(v1[2], v1[3]);
                    *(u32x4*)(rowp + bj * HALF) = w; } }
    }
};
__device__ __forceinline__ float silu_f(float a) { return a * __builtin_amdgcn_rcpf(1.0f + __builtin_amdgcn_exp2f(a * -1.4426950408889634f)); }
struct EpiSwiGLU {
    static constexpr bool PERM = true;
    bf16_t* O; int ldc; float inv;
    __device__ __forceinline__ void operator()(const f32x4 (&acc)[2][2][4][2], const Unit& u, int wr, int wc, int fr, int fq) const {
        const int row0 = u.pm * BM + wr * 64 + fr, col0 = u.pn * HALF + wc * 32 + 8 * fq;
#pragma unroll
        for (int ai = 0; ai < 2; ++ai)
#pragma unroll
            for (int m = 0; m < 4; ++m) { bf16_t* rowp = O + (size_t)(row0 + ai * HALF + m * 16) * ldc + col0;
                float h[8]; typedef float f2 __attribute__((ext_vector_type(2)));
                const float kexp = inv * -1.4426950408889634f, c0 = 1.0f / (inv * inv), lc0 = __builtin_log2f(c0);
#pragma unroll
                for (int n = 0; n < 2; ++n)
#pragma unroll
                    for (int j = 0; j < 4; j += 2) { const f2 a1 = {acc[ai][0][m][n][j], acc[ai][0][m][n][j + 1]}, a3 = {acc[ai][1][m][n][j], acc[ai][1][m][n][j + 1]};
                        const f2 t = a1 * kexp + lc0; f2 d; d.x = __builtin_amdgcn_exp2f(t.x); d.y = __builtin_amdgcn_exp2f(t.y); d = d + c0;
                        f2 rr; rr.x = __builtin_amdgcn_rcpf(d.x); rr.y = __builtin_amdgcn_rcpf(d.y); const f2 hv = (a1 * a3) * rr; h[4 * n + j] = hv.x; h[4 * n + j + 1] = hv.y; }
                u32x4 w; w.x = cvt_pk_bf16(h[0], h[1]); w.y = cvt_pk_bf16(h[2], h[3]); w.z = cvt_pk_bf16(h[4], h[5]); w.w = cvt_pk_bf16(h[6], h[7]);
                *(u32x4*)rowp = w; }
    }
};
struct EpiSwiGLU8 {
    static constexpr bool PERM = true;
    unsigned char* O; int ldc; float inv, oscale; int skip;
    __device__ __forceinline__ void operator()(const f32x4 (&acc)[2][2][4][2], const Unit& u, int wr, int wc, int fr, int fq) const {
        if (skip) return;
        const int row0 = u.pm * BM + wr * 64 + fr, col0 = u.pn * HALF + wc * 32 + 8 * fq;
        const float kexp = inv * -1.4426950408889634f, c0 = 1.0f / (inv * inv * oscale), lc0 = __builtin_log2f(c0);
        typedef unsigned u32x2 __attribute__((ext_vector_type(2))); typedef float f2 __attribute__((ext_vector_type(2)));
#pragma unroll
        for (int ai = 0; ai < 2; ++ai)
#pragma unroll
            for (int m = 0; m < 4; ++m) { unsigned char* rowp = O + (size_t)(row0 + ai * HALF + m * 16) * ldc + col0;
                float h[8];
#pragma unroll
                for (int n = 0; n < 2; ++n)
#pragma unroll
                    for (int j = 0; j < 4; j += 2) { const f2 a1 = {acc[ai][0][m][n][j], acc[ai][0][m][n][j + 1]}, a3 = {acc[ai][1][m][n][j], acc[ai][1][m][n][j + 1]};
                        const f2 t = a1 * kexp + lc0; f2 d; d.x = __builtin_amdgcn_exp2f(t.x); d.y = __builtin_amdgcn_exp2f(t.y); d = d + c0;
                        f2 rr; rr.x = __builtin_amdgcn_rcpf(d.x); rr.y = __builtin_amdgcn_rcpf(d.y); const f2 hv = (a1 * a3) * rr;
                        h[4 * n + j] = __builtin_amdgcn_fmed3f(hv.x, -448.0f, 448.0f); h[4 * n + j + 1] = __builtin_amdgcn_fmed3f(hv.y, -448.0f, 448.0f); }
                *(u32x2*)rowp = (u32x2){pk4_fp8_raw(h[0], h[1], h[2], h[3]), pk4_fp8_raw(h[4], h[5], h[6], h[7])}; }
    }
};
typedef unsigned u32x2_t __attribute__((ext_vector_type(2)));
__device__ __forceinline__ f32x4 bf4_to_f32(const u32x2_t v) { f32x4 r; r.x = __uint_as_float(v.x << 16); r.y = __uint_as_float(v.x & 0xffff0000u); r.z = __uint_as_float(v.y << 16); r.w = __uint_as_float(v.y & 0xffff0000u); return r; }
__device__ __forceinline__ u32x2_t f32_to_bf4(const f32x4 v) { return (u32x2_t){cvt_pk_bf16(v.x, v.y), cvt_pk_bf16(v.z, v.w)}; }
struct EpiBf16i {
    static constexpr bool PERM = true;
    bf16_t* O; int ldc; const float* rowstep; const float* colstep;
    __device__ __forceinline__ void operator()(const f32x4 (&acc)[2][2][4][2], const Unit& u, int wr, int wc, int fr, int fq) const {
        const int row0 = u.pm * BM + wr * 64 + fr, col0 = u.pn * BM + wc * 32 + 8 * fq;
        f32x4 cs[2][2];
#pragma unroll
        for (int bj = 0; bj < 2; ++bj)
#pragma unroll
            for (int n = 0; n < 2; ++n) cs[bj][n] = *(const f32x4*)(colstep + col0 + bj * HALF + 4 * n);
#pragma unroll
        for (int ai = 0; ai < 2; ++ai)
#pragma unroll
            for (int m = 0; m < 4; ++m) { const int row = row0 + ai * HALF + m * 16; bf16_t* rowp = O + (size_t)row * ldc + col0; const float rs = rowstep[row];
#pragma unroll
                for (int bj = 0; bj < 2; ++bj) { float v[8];
#pragma unroll
                    for (int n = 0; n < 2; ++n)
#pragma unroll
                        for (int j = 0; j < 4; ++j) { const float x = acc[ai][bj][m][n][j]; v[4 * n + j] = (float)__float_as_int(x) * (rs * cs[bj][n][j]); }
                    u32x4 w; w.x = cvt_pk_bf16(v[0], v[1]); w.y = cvt_pk_bf16(v[2], v[3]); w.z = cvt_pk_bf16(v[4], v[5]); w.w = cvt_pk_bf16(v[6], v[7]);
                    *(u32x4*)(rowp + bj * HALF) = w; } }
    }
};
struct EpiSwiGLU8i {
    static constexpr bool PERM = true;
    unsigned char* O; int ldc; const float* rowstep; const float* step1; const float* step3; float oscale;
    __device__ __forceinline__ void operator()(const f32x4 (&acc)[2][2][4][2], const Unit& u, int wr, int wc, int fr, int fq) const {
        const int row0 = u.pm * BM + wr * 64 + fr, col0 = u.pn * HALF + wc * 32 + 8 * fq;
        typedef unsigned u32x2 __attribute__((ext_vector_type(2))); typedef float f2 __attribute__((ext_vector_type(2)));
        f32x4 c1[2], c3[2];
#pragma unroll
        for (int n = 0; n < 2; ++n) { c1[n] = *(const f32x4*)(step1 + col0 + 4 * n) * -1.4426950408889634f; c3[n] = *(const f32x4*)(step3 + col0 + 4 * n) * (oscale * -0.6931471805599453f); }
#pragma unroll
        for (int ai = 0; ai < 2; ++ai)
#pragma unroll
            for (int m = 0; m < 4; ++m) { const int row = row0 + ai * HALF + m * 16; unsigned char* rowp = O + (size_t)row * ldc + col0; const float rs = rowstep[row];
                float h[8];
#pragma unroll
                for (int n = 0; n < 2; ++n)
#pragma unroll
                    for (int j = 0; j < 4; j += 2) { const float x0 = acc[ai][0][m][n][j], x1 = acc[ai][0][m][n][j + 1], y0 = acc[ai][1][m][n][j], y1 = acc[ai][1][m][n][j + 1];
                        const f2 t = (f2){(float)__float_as_int(x0), (float)__float_as_int(x1)} * ((f2){c1[n][j], c1[n][j + 1]} * rs);
                        const f2 b = (f2){(float)__float_as_int(y0), (float)__float_as_int(y1)} * ((f2){c3[n][j], c3[n][j + 1]} * rs);
                        f2 d; d.x = __builtin_amdgcn_exp2f(t.x); d.y = __builtin_amdgcn_exp2f(t.y); d = d + 1.0f;
                        f2 rr; rr.x = __builtin_amdgcn_rcpf(d.x); rr.y = __builtin_amdgcn_rcpf(d.y); const f2 hv = (t * b) * rr;
                        h[4 * n + j] = __builtin_amdgcn_fmed3f(hv.x, -448.0f, 448.0f); h[4 * n + j + 1] = __builtin_amdgcn_fmed3f(hv.y, -448.0f, 448.0f); }
                *(u32x2*)rowp = (u32x2){pk4_fp8_raw(h[0], h[1], h[2], h[3]), pk4_fp8_raw(h[4], h[5], h[6], h[7])}; }
    }
};
struct EpiRes {
    static constexpr bool PERM = true;
    const float* srcL; const float* srcC; bf16_t* xres; const float* gate; float oscale;
    __device__ __forceinline__ void operator()(const f32x4 (&acc)[2][2][4][2], const Unit& u, int wr, int wc, int fr, int fq) const {
        const int pm = u.pm; const bool isc = pm >= 128; const int bidx = isc ? 8 : (pm >> 4);
        const float* s = srcL ? (isc ? srcC + (size_t)(pm - 128) * BM * D : srcL + (size_t)pm * BM * D) : nullptr;
        bf16_t* d = xres + (size_t)pm * BM * D;
        const int col0 = u.pn * BM + wc * 32 + 8 * fq; const float* gv = gate + bidx * MOD6 + col0;
        f32x4 g[2][2];
#pragma unroll
        for (int bj = 0; bj < 2; ++bj)
#pragma unroll
            for (int n = 0; n < 2; ++n) g[bj][n] = *(const f32x4*)(gv + bj * HALF + 4 * n) * oscale;
        if (s) {
#pragma unroll
            for (int am = 0; am < 4; ++am) { const int ai = am >> 1, m0 = (am & 1) * 2; f32x4 x[2][2][2];
#pragma unroll
                for (int mm = 0; mm < 2; ++mm)
#pragma unroll
                    for (int bj = 0; bj < 2; ++bj)
#pragma unroll
                        for (int n = 0; n < 2; ++n) x[mm][bj][n] = *(const f32x4*)(s + (size_t)(wr * 64 + fr + ai * HALF + (m0 + mm) * 16) * D + col0 + bj * HALF + 4 * n);
#pragma unroll
                for (int mm = 0; mm < 2; ++mm)
#pragma unroll
                    for (int bj = 0; bj < 2; ++bj) { const int m = m0 + mm; const u32x2_t p0 = f32_to_bf4(x[mm][bj][0] + g[bj][0] * acc[ai][bj][m][0]), p1 = f32_to_bf4(x[mm][bj][1] + g[bj][1] * acc[ai][bj][m][1]);
                        *(u32x4*)(d + (size_t)(wr * 64 + fr + ai * HALF + m * 16) * D + col0 + bj * HALF) = (u32x4){p0.x, p0.y, p1.x, p1.y}; }
                asm volatile("" ::: "memory"); }
        } else {
#pragma unroll
            for (int ai = 0; ai < 2; ++ai) { u32x4 x[4][2];
#pragma unroll
                for (int m = 0; m < 4; ++m)
#pragma unroll
                    for (int bj = 0; bj < 2; ++bj) x[m][bj] = *(const u32x4*)(d + (size_t)(wr * 64 + fr + ai * HALF + m * 16) * D + col0 + bj * HALF);
#pragma unroll
                for (int m = 0; m < 4; ++m)
#pragma unroll
                    for (int bj = 0; bj < 2; ++bj) { const u32x4 xv = x[m][bj];
                        const u32x2_t p0 = f32_to_bf4(bf4_to_f32((u32x2_t){xv.x, xv.y}) + g[bj][0] * acc[ai][bj][m][0]), p1 = f32_to_bf4(bf4_to_f32((u32x2_t){xv.z, xv.w}) + g[bj][1] * acc[ai][bj][m][1]);
                        *(u32x4*)(d + (size_t)(wr * 64 + fr + ai * HALF + m * 16) * D + col0 + bj * HALF) = (u32x4){p0.x, p0.y, p1.x, p1.y}; }
                asm volatile("" ::: "memory"); }
        }
    }
};
struct EpiScatter {
    static constexpr bool PERM = false;
    const int* ridx; const float* rgate; bf16_t* xres; const float* gate; float oscale;
    __device__ __forceinline__ void operator()(const f32x4 (&acc)[2][2][4][2], const Unit& u, int wr, int wc, int fr, int fq) const {
        const int col0 = u.pn * BM + wc * 32 + 4 * fq;
#pragma unroll
        for (int ai = 0; ai < 2; ++ai)
#pragma unroll
            for (int m = 0; m < 4; ++m) { const int rs = u.pm * BM + wr * 64 + fr + ai * HALF + m * 16; const int tok = ridx[rs];
                if (tok >= 0) { const float gt = rgate[rs] * oscale; const float* gv = gate + (tok >> 12) * MOD6 + col0; bf16_t* d = xres + (size_t)tok * D + col0;
#pragma unroll
                    for (int bj = 0; bj < 2; ++bj)
#pragma unroll
                        for (int n = 0; n < 2; ++n) { const f32x4 g = *(const f32x4*)(gv + bj * HALF + n * 16); const f32x4 x = bf4_to_f32(*(const u32x2_t*)(d + bj * HALF + n * 16));
                            *(u32x2_t*)(d + bj * HALF + n * 16) = f32_to_bf4(x + (g * gt) * acc[ai][bj][m][n]); } }
                asm volatile("" ::: "memory"); }
    }
};

struct MoeOrderRM {
    int nwg, G, c; const char* A; const char* Bt; size_t tstepA, tstepB, estride; const int* texp; int nt0, gap;
    __device__ __forceinline__ bool next(int i, Unit& u) const {
        const int wgid = (G & 7) ? i * G + c : i * G + (c & 7) * (G >> 3) + (c >> 3); if (wgid >= nwg) return false;
        int pm = wgid >> 2; const int pn = wgid & 3; pm = pm < nt0 ? pm : pm + gap;
        const int e = __builtin_amdgcn_readfirstlane(__hip_atomic_load(texp + pm, __ATOMIC_RELAXED, __HIP_MEMORY_SCOPE_AGENT));
        u.pm = __builtin_amdgcn_readfirstlane(pm); u.pn = __builtin_amdgcn_readfirstlane(pn); u.a = uptr(A + (size_t)u.pm * tstepA); u.b = uptr(Bt + (size_t)e * estride + (size_t)u.pn * tstepB); u.ridx = nullptr; return true; }
};
typedef unsigned u32x4_t __attribute__((ext_vector_type(4)));
struct EpiY {
    static constexpr bool PERM = true;
    const float* rgate; bf16_t* y0; bf16_t* y1a; bf16_t* y1b; float oscale; int t1, psplit;
    __device__ __forceinline__ void operator()(const f32x4 (&acc)[2][2][4][2], const Unit& u, int wr, int wc, int fr, int fq) const {
        const int col0 = u.pn * BM + wc * 32 + 8 * fq; const bool s1 = u.pm >= t1; const int p = s1 ? u.pm - t1 : u.pm;
        bf16_t* base = (s1 ? (p < psplit ? y1a + (size_t)p * BM * D : y1b + (size_t)(p - psplit) * BM * D) : y0 + (size_t)p * BM * D) + col0;
        float gt[2][4];
#pragma unroll
        for (int ai = 0; ai < 2; ++ai)
#pragma unroll
            for (int m = 0; m < 4; ++m) gt[ai][m] = rgate[u.pm * BM + wr * 64 + fr + ai * HALF + m * 16] * oscale;
#pragma unroll
        for (int ai = 0; ai < 2; ++ai)
#pragma unroll
            for (int m = 0; m < 4; ++m) { bf16_t* d = base + (size_t)(wr * 64 + fr + ai * HALF + m * 16) * D;
#pragma unroll
                for (int bj = 0; bj < 2; ++bj) { const u32x2_t p0 = f32_to_bf4(acc[ai][bj][m][0] * gt[ai][m]), p1 = f32_to_bf4(acc[ai][bj][m][1] * gt[ai][m]);
                    *(u32x4_t*)(d + bj * HALF) = (u32x4_t){p0.x, p0.y, p1.x, p1.y}; } }
    }
};

template <class Epi, class Sched, bool ALIGN_EPI, bool GATHER, int MODE = 0  >
__device__ __forceinline__ void gemm_phase(PG8_LAS unsigned char* lds, const int K, const Sched& S, const Epi& E) {
    constexpr bool FP8 = (MODE == 1);
    const int wid = __builtin_amdgcn_readfirstlane((int)threadIdx.x >> 6), lane = (int)__builtin_amdgcn_mbcnt_hi(~0u, __builtin_amdgcn_mbcnt_lo(~0u, 0u)), tid = wid * 64 + lane, wr = wid >> 2, wc = wid & 3, fr = lane & 15, fq = lane >> 4;
    const int nt = K / BK;
    unsigned voffA[2], voffB[2];
#pragma unroll
    for (int i = 0; i < 2; ++i) { int R, C; stage_rc(tid * 16 + i * 8192, R, C); const int Rb = Epi::PERM ? ((R & ~31) + perm32(R & 31)) : R;
        voffA[i] = (unsigned)(R * K + C) * 2u; voffB[i] = (unsigned)(Rb * K + C) * 2u; }
    const size_t kstep = (size_t)(BK * 2);
    const size_t hstep = (size_t)HALF * K * 2;
    const unsigned ldsw = (unsigned)wid * 1024u;
    const unsigned ldsb = __builtin_amdgcn_readfirstlane((unsigned)(size_t)lds + ldsw);
    const int aoff = lds_byte(wr * 64 + fr, fq * 8), boff = lds_byte(wc * 32 + fr, fq * 8);
    unsigned vAc[2][2], vAn[2][2];
#define PG8_SA(b, h) (((b) * 2 + (h)) * HTB)
#define PG8_SB(b, h) ((4 + (b) * 2 + (h)) * HTB)
#define PG8_STAGE(bufoff, gbase, voff) do { const char* _g = uptr((const char*)(gbase)); _Pragma("unroll") for (int _i = 0; _i < 2; ++_i) \
        glds_s(_g, (voff)[_i], ldsb + (unsigned)((bufoff) + _i * 8192)); } while (0)
#define PG8_STAGE_A(bufoff, NXT, kb, h) do { if constexpr (GATHER) { const char* _ga = uptr(gA + (kb)); _Pragma("unroll") for (int _i = 0; _i < 2; ++_i) { const unsigned _v = (NXT) ? vAn[h][_i] : vAc[h][_i]; \
        glds_s(_ga, _v, ldsb + (unsigned)((bufoff) + _i * 8192)); } } \
        else { const char* _b = ((NXT) ? nA : cA) + (kb) + (h) * hstep; PG8_STAGE(bufoff, _b, voffA); } } while (0)
#define PG8_LDA(dst, b, h) do { if constexpr (FP8) { _Pragma("unroll") for (int m = 0; m < 4; ++m) dst##8[m] = cat8(*(const PG8_LAS bf16x8*)(lds + PG8_SA(b, h) + aoff + m * 2048), *(const PG8_LAS bf16x8*)(lds + PG8_SA(b, h) + aoff + m * 2048 + 1024)); } \
        else { _Pragma("unroll") for (int m = 0; m < 4; ++m) _Pragma("unroll") for (int k = 0; k < 2; ++k) dst[m][k] = *(const PG8_LAS bf16x8*)(lds + PG8_SA(b, h) + aoff + m * 2048 + k * 1024); } } while (0)
#define PG8_LDB(dst, b, h) do { if constexpr (FP8) { _Pragma("unroll") for (int n = 0; n < 2; ++n) dst##8[n] = cat8(*(const PG8_LAS bf16x8*)(lds + PG8_SB(b, h) + boff + n * 2048), *(const PG8_LAS bf16x8*)(lds + PG8_SB(b, h) + boff + n * 2048 + 1024)); } \
        else { _Pragma("unroll") for (int n = 0; n < 2; ++n) _Pragma("unroll") for (int k = 0; k < 2; ++k) dst[n][k] = *(const PG8_LAS bf16x8*)(lds + PG8_SB(b, h) + boff + n * 2048 + k * 1024); } } while (0)
#define PG8_MMA(ai, bj, At, Bt) do { __builtin_amdgcn_s_setprio(1); if constexpr (FP8) { _Pragma("unroll") for (int m = 0; m < 4; ++m) _Pragma("unroll") for (int n = 0; n < 2; ++n) \
        mfma8(acc[ai][bj][m][n], Bt##8[n], At##8[m], sc127); } \
        else if constexpr (MODE == 2) { _Pragma("unroll") for (int m = 0; m < 4; ++m) _Pragma("unroll") for (int n = 0; n < 2; ++n) _Pragma("unroll") for (int k = 0; k < 2; ++k) \
        acc[ai][bj][m][n] = __builtin_bit_cast(f32x4, __builtin_amdgcn_mfma_i32_16x16x64_i8(__builtin_bit_cast(v4i_t, Bt[n][k]), __builtin_bit_cast(v4i_t, At[m][k]), __builtin_bit_cast(v4i_t, acc[ai][bj][m][n]), 0, 0, 0)); } \
        else { _Pragma("unroll") for (int m = 0; m < 4; ++m) _Pragma("unroll") for (int n = 0; n < 2; ++n) _Pragma("unroll") for (int k = 0; k < 2; ++k) \
        acc[ai][bj][m][n] = __builtin_amdgcn_mfma_f32_16x16x32_bf16(Bt[n][k], At[m][k], acc[ai][bj][m][n], 0, 0, 0); } __builtin_amdgcn_s_setprio(0); } while (0)
#define PG8_WAIT_V(n) asm volatile("s_waitcnt vmcnt(" #n ")" ::: "memory")
#define PG8_WAIT_L(n) asm volatile("s_waitcnt lgkmcnt(" #n ")" ::: "memory")
#define PG8_BAR __builtin_amdgcn_s_barrier()
#define PG8_SCHED __builtin_amdgcn_sched_barrier(0)
#define PG8_GOFF(dst, un) do { _Pragma("unroll") for (int _i = 0; _i < 2; ++_i) { int _R, _C; stage_rc(tid * 16 + _i * 8192, _R, _C); _Pragma("unroll") for (int _h = 0; _h < 2; ++_h) { int _r = (un).ridx[_h * HALF + _R]; _r = _r < 0 ? 0 : _r; \
        dst[_h][_i] = (unsigned)(_r * K + _C) * 2u; } } } while (0)
    Unit cur, nxt; int ui = 0;
    if (!S.next(0, cur)) return;
    f32x4 acc[2][2][4][2];
#pragma unroll
    for (int a = 0; a < 2; ++a)
#pragma unroll
        for (int b = 0; b < 2; ++b)
#pragma unroll
            for (int m = 0; m < 4; ++m)
#pragma unroll
                for (int n = 0; n < 2; ++n) acc[a][b][m][n] = (f32x4){0.f, 0.f, 0.f, 0.f};
    int sc127 = 127; if constexpr (FP8) asm volatile("" : "+v"(sc127));
    bf16x8 At[4][2], B0[2][2], B1[2][2]; v8i_t At8[4], B08[2], B18[2];
    const char* gA = cur.a;
    const char* cA = cur.a; const char* cB = cur.b;
    if constexpr (GATHER) { PG8_GOFF(vAc, cur); }
    {   const char* nA = cA;
        PG8_STAGE(PG8_SB(0, 0), cB, voffB); PG8_STAGE(PG8_SB(0, 1), cB + hstep, voffB); PG8_STAGE_A(PG8_SA(0, 0), false, 0, 0); PG8_STAGE_A(PG8_SA(0, 1), false, 0, 1);
        if (wr == 1) PG8_BAR;
        PG8_WAIT_V(2); PG8_BAR;
        PG8_STAGE(PG8_SB(1, 0), cB + kstep, voffB); PG8_STAGE_A(PG8_SA(1, 0), false, kstep, 0); PG8_STAGE(PG8_SB(1, 1), cB + hstep + kstep, voffB);
        PG8_WAIT_V(6); PG8_BAR; }
    for (;;) {
        const bool has_next = S.next(ui + 1, nxt);
        const char* nA = has_next ? nxt.a : cA; const char* nB = has_next ? nxt.b : cB;
        if constexpr (GATHER) { if (has_next) { PG8_GOFF(vAn, nxt); } else {
#pragma unroll
            for (int h = 0; h < 2; ++h)
#pragma unroll
                for (int i = 0; i < 2; ++i) vAn[h][i] = vAc[h][i]; } }
#pragma unroll 1
        for (int t = 0; t < nt; t += 2) {
            const bool last = (t == nt - 2);
            const size_t kb1 = (size_t)(t + 1) * kstep;
            const size_t kb2 = last ? 0 : (size_t)(t + 2) * kstep, kb3 = kb2 + kstep;
            const char* b2 = last ? nB : cB + (size_t)(t + 2) * kstep; const char* b3 = b2 + kstep;
            PG8_LDB(B0, 0, 0); PG8_LDB(B1, 0, 1); PG8_SCHED; PG8_LDA(At, 0, 0); PG8_STAGE_A(PG8_SA(1, 1), false, kb1, 1);
            PG8_WAIT_V(8); PG8_WAIT_L(0); PG8_BAR; PG8_MMA(0, 0, At, B0); PG8_MMA(0, 1, At, B1); PG8_BAR; PG8_SCHED;
            PG8_LDA(At, 0, 1); PG8_STAGE(PG8_SB(0, 0), b2, voffB); PG8_STAGE(PG8_SB(0, 1), b2 + hstep, voffB); PG8_STAGE_A(PG8_SA(0, 0), last, kb2, 0);
            PG8_WAIT_V(8); PG8_WAIT_L(0); PG8_BAR; PG8_MMA(1, 0, At, B0); PG8_MMA(1, 1, At, B1); PG8_BAR; PG8_SCHED;
            PG8_LDB(B0, 1, 0); PG8_LDB(B1, 1, 1); PG8_SCHED; PG8_LDA(At, 1, 0); PG8_STAGE_A(PG8_SA(0, 1), last, kb2, 1);
            PG8_WAIT_V(8); PG8_WAIT_L(0); PG8_BAR; PG8_MMA(0, 0, At, B0); PG8_MMA(0, 1, At, B1); PG8_BAR; PG8_SCHED;
            PG8_LDA(At, 1, 1); PG8_STAGE(PG8_SB(1, 0), b3, voffB); PG8_STAGE(PG8_SB(1, 1), b3 + hstep, voffB); PG8_STAGE_A(PG8_SA(1, 0), last, kb3, 0);
            PG8_WAIT_V(8); PG8_WAIT_L(0); PG8_BAR; PG8_MMA(1, 0, At, B0); PG8_MMA(1, 1, At, B1); PG8_BAR; PG8_SCHED;
        }
        if constexpr (ALIGN_EPI) { if (wr == 0) PG8_BAR; }
        if constexpr (FP8) asm volatile("s_nop 15\n\ts_nop 15" ::: "memory");
        { int efr = fr, efq = fq; asm volatile("" : "+v"(efr), "+v"(efq));
          E(acc, cur, wr, wc, efr, efq); }
        if (!has_next) break;
#pragma unroll
        for (int a = 0; a < 2; ++a)
#pragma unroll
            for (int b = 0; b < 2; ++b)
#pragma unroll
                for (int m = 0; m < 4; ++m)
#pragma unroll
                    for (int n = 0; n < 2; ++n) acc[a][b][m][n] = (f32x4){0.f, 0.f, 0.f, 0.f};
        cur = nxt; cA = nA; cB = nB; ++ui;
        if constexpr (GATHER) {
#pragma unroll
            for (int h = 0; h < 2; ++h)
#pragma unroll
                for (int i = 0; i < 2; ++i) vAc[h][i] = vAn[h][i]; }
        if constexpr (ALIGN_EPI) { if (wr == 1) PG8_BAR; }
    }
    PG8_WAIT_V(0);
    if constexpr (!ALIGN_EPI) { if (wr == 0) PG8_BAR; }
    PG8_BAR;
#undef PG8_SA
#undef PG8_SB
#undef PG8_STAGE
#undef PG8_STAGE_A
#undef PG8_LDA
#undef PG8_LDB
#undef PG8_MMA
#undef PG8_WAIT_V
#undef PG8_WAIT_L
#undef PG8_BAR
#undef PG8_SCHED
#undef PG8_GOFF
}
}

constexpr int NWAVES = 8, NTHR = NWAVES * 64;
constexpr size_t MiB = 1u << 20;
constexpr int RT_TILES_C = 136;
constexpr size_t WS_CTL = 0, CTL_ZERO_BYTES = 1 * MiB;
constexpr size_t WS_MODP = 1 * MiB;
constexpr size_t WS_MODV = 5 * MiB;
constexpr size_t WS_ROUTE = 6 * MiB;
constexpr size_t WS_WIN = 8 * MiB;
constexpr size_t WS_WOUT = 17 * MiB;
constexpr size_t WS_W13 = 21 * MiB;
constexpr size_t WS_W2 = 32 * MiB;
constexpr size_t WS_MW13 = 38 * MiB;
constexpr size_t WS_MW2 = 94 * MiB;
constexpr size_t WS_CTXRES = 122 * MiB;
constexpr size_t WS_HBUF = 130 * MiB;
constexpr size_t WS_PBUF = 198 * MiB;
constexpr size_t WS_MIX = 351 * MiB;
constexpr size_t WS_XRES = 419 * MiB;
constexpr size_t WS_SLOC = 487 * MiB;
constexpr size_t WS_DTOT = 521 * MiB;
constexpr size_t WS_HID = 198 * MiB;
constexpr size_t WS_HID2 = 164 * MiB;
constexpr size_t WS_ZBUF = WS_HBUF;
constexpr size_t WS_XBC = WS_HBUF + 64 * MiB;
constexpr size_t WS_END = 522 * MiB;
static_assert(WS_HID + (size_t)MT * EFF <= WS_XRES && WS_HID + (size_t)MT * DFF * 2 <= WS_XRES && WS_MIX + (size_t)MT * D * 2 <= WS_XRES && WS_PBUF + (size_t)MT * INP * 2 <= WS_MIX && WS_HBUF + (size_t)MT * D * 2 <= WS_PBUF, "ws map");
static_assert(WS_HID2 + (size_t)2 * RT_TILES_C * 256 * EFF <= WS_XRES && WS_HBUF + (size_t)NL * D <= WS_HID2, "MoE hidden");
static_assert(WS_XRES + (size_t)MT * D * 2 <= WS_SLOC && (size_t)MT * 512 * 4 <= (size_t)NL * D * 4 && WS_SLOC + (size_t)64 * 17 * 8192 * 4 <= WS_DTOT && WS_DTOT + (size_t)64 * 17 * 64 * 4 <= WS_END, "GLA scratch");
static_assert(WS_MW2 + (size_t)NE * D * EFF <= WS_CTXRES && WS_MW13 + (size_t)NE * 2 * EFF * D <= WS_MW2 && WS_W13 + (size_t)2 * DFF * D * 2 <= WS_W2 && WS_W2 + (size_t)D * DFF * 2 <= WS_MW13 && WS_CTXRES + (size_t)NC * D * 4 <= WS_HBUF, "ws map 2");
constexpr int RT_TILES = 136;
constexpr size_t RT_TOKE = 0;
constexpr size_t RT_TOKG = 262144;
constexpr size_t RT_RIDX = 524288;
constexpr size_t RT_RGATE = RT_RIDX + 2 * RT_TILES * 256 * 4;
constexpr size_t RT_TEXP = RT_RGATE + 2 * RT_TILES * 256 * 4;
constexpr size_t RT_NT = RT_TEXP + 2 * RT_TILES * 4;
constexpr size_t WS_WCS = WS_ROUTE + 1536 * 1024;
constexpr int WCS_IN = 0, WCS_W1 = 2 * 2304, WCS_W3 = 2 * 2304 + 2816;
constexpr size_t RT_POS = 1664 * 1024;
constexpr size_t WS_RS = WS_ROUTE + 1280 * 1024;
static_assert(RT_NT + 1024 <= 2 * MiB, "route tables");
constexpr int CW_BAR = 4096, CW_Q = 8192, CW_CONVQ = 12288, CW_WABS = 12800, CW_DONE0 = 16384, CW_FINQ = 16448, CW_DONE1 = 16512;
constexpr size_t WS_Y0 = 8 * MiB;
constexpr int Y1_SPLIT = 68;
static_assert((size_t)Y1_SPLIT * 256 * 1024 * 2 <= 34 * MiB && WS_Y0 + (size_t)136 * 256 * 1024 * 2 <= 94 * MiB, "MoE down product buffers");
#define MDN_MERGE 1
constexpr int RING_BYTES = 131072, LDS_BYTES = 163840, LDSCTL_OFF = LDS_BYTES - 1024, MISC_OFF = LDSCTL_OFF + 320;

#define GAS __attribute__((address_space(1)))
#define LAS __attribute__((address_space(3)))
typedef unsigned short bf16;
typedef unsigned v4u __attribute__((ext_vector_type(4)));
typedef unsigned v2u __attribute__((ext_vector_type(2)));
typedef float f32x4 __attribute__((ext_vector_type(4)));
typedef float f32x2 __attribute__((ext_vector_type(2)));
#define LDS_WAIT() asm volatile("s_waitcnt lgkmcnt(0)" ::: "memory")
__device__ __forceinline__ unsigned f2bf(float f) { unsigned u = __builtin_bit_cast(unsigned, f); return (u + 0x7fffu + ((u >> 16) & 1u)) >> 16; }
__device__ __forceinline__ unsigned pk2(float lo, float hi) { return f2bf(lo) | (f2bf(hi) << 16); }
__device__ __forceinline__ float bf2f(unsigned b) { return __builtin_bit_cast(float, b << 16); }
__device__ __forceinline__ float bflo(unsigned w) { return __builtin_bit_cast(float, w << 16); }
__device__ __forceinline__ float bfhi(unsigned w) { return __builtin_bit_cast(float, w & 0xffff0000u); }
typedef short bf16x8 __attribute__((ext_vector_type(8)));
typedef float f32x16 __attribute__((ext_vector_type(16)));
typedef __bf16 bf16x2_t __attribute__((ext_vector_type(2)));
__device__ __forceinline__ unsigned cvtpk(float lo, float hi) { const f32x2 v = {lo, hi}; return __builtin_bit_cast(unsigned, __builtin_convertvector(v, bf16x2_t)); }
__device__ __forceinline__ bf16 bf1(float x) { return (bf16)(cvtpk(x, x) & 0xffffu); }
__device__ __forceinline__ float silu_fast(float a) { return a * __builtin_amdgcn_rcpf(1.0f + __builtin_amdgcn_exp2f(a * -1.4426950408889634f)); }
__device__ __forceinline__ float cosrev(float f) { return __builtin_amdgcn_cosf(f); }
__device__ __forceinline__ float sinrev(float f) { return __builtin_amdgcn_sinf(f); }
__device__ __forceinline__ int crow32(int reg, int h) { return (reg & 3) + 8 * (reg >> 2) + 4 * h; }
#define MFMA32(a, b, c) __builtin_amdgcn_mfma_f32_32x32x16_bf16((a), (b), (c), 0, 0, 0)

#define XB_TMO      128
#define XB_XCNT(j)  (256  + 64 * (j))
#define XB_XSUB(j)  (1280 + 64 * (j))
#define XB_XGEN(j)  (2304 + 64 * (j))
#define XB_TOP      3328
#define XB_TOPGEN   3392
#define XCD_BAR_WORDS 3456
#define XB_SPIN_CAP (1u << 20)
__device__ __forceinline__ unsigned xb_ld(unsigned* p)              { return __hip_atomic_load(p, __ATOMIC_RELAXED, __HIP_MEMORY_SCOPE_AGENT); }
__device__ __forceinline__ unsigned xb_add(unsigned* p, unsigned v) { return __hip_atomic_fetch_add(p, v, __ATOMIC_RELAXED, __HIP_MEMORY_SCOPE_AGENT); }
__device__ __forceinline__ unsigned xb_xcc_id() { return (unsigned)__builtin_amdgcn_s_getreg((3 << 11) | 20) & 0xFu; }
#define XB_SPIN(cond, bar) do { unsigned _sp = 0; while (cond) { __builtin_amdgcn_s_sleep(1); \
    if ((++_sp & 255u) == 0u) { if (xb_ld(&(bar)[XB_TMO])) break; if (_sp > XB_SPIN_CAP) { atomicAdd(&(bar)[XB_TMO], 1u); break; } } } } while (0)
struct XcdBarrier { unsigned* bar; unsigned x; volatile LAS unsigned* st; };
__device__ __forceinline__ XcdBarrier xcd_barrier_post(unsigned* bar, volatile LAS unsigned* st) {
    XcdBarrier b; b.bar = bar; b.x = xb_xcc_id(); b.st = st;
    if (threadIdx.x == 0) (void)xb_add(&bar[XB_XCNT(b.x)], 1u);
    return b;
}
__device__ __forceinline__ void xcd_barrier_complete(unsigned* bar, unsigned x, unsigned& nloc, unsigned& nx) {
    const unsigned G = gridDim.x * gridDim.y * gridDim.z;
    unsigned sum, cnt, mine, sp = 0u;
    for (;;) {
        sum = 0u; cnt = 0u; mine = 0u;
#pragma unroll
        for (unsigned j = 0; j < 16; ++j) { const unsigned c = xb_ld(&bar[XB_XCNT(j)]); sum += c; cnt += (c > 0u) ? 1u : 0u; mine = (j == x) ? c : mine; }
        if (sum == G) break;
        __builtin_amdgcn_s_sleep(1);
        if ((++sp & 255u) == 0u) { if (xb_ld(&bar[XB_TMO])) break; if (sp > XB_SPIN_CAP) { atomicAdd(&bar[XB_TMO], 1u); break; } }
    }
    nloc = mine > 0u ? mine : 1u; nx = cnt > 0u ? cnt : 1u;
}
__device__ __forceinline__ void xcd_barrier(const XcdBarrier& b) {
    asm volatile("s_waitcnt vmcnt(0)" ::: "memory");
    __syncthreads();
    if (threadIdx.x == 0) {
        unsigned* bar = b.bar;
        __builtin_amdgcn_s_waitcnt(0);
        unsigned nloc = b.st[0], nx = b.st[1];
        if (nloc == 0u) { xcd_barrier_complete(bar, b.x, nloc, nx); b.st[0] = nloc; b.st[1] = nx; }
        const unsigned old = xb_add(&bar[XB_XSUB(b.x)], 1u);
        const unsigned gen = old / nloc;
        if (old + 1u == (gen + 1u) * nloc) {
            __builtin_amdgcn_fence(__ATOMIC_RELEASE, "agent");
            asm volatile("s_waitcnt vmcnt(0)" ::: "memory");
            const unsigned og = xb_add(&bar[XB_TOP], 1u);
            const unsigned tg = og / nx;
            if (og + 1u == (tg + 1u) * nx) xb_add(&bar[XB_TOPGEN], 1u);
            else XB_SPIN(xb_ld(&bar[XB_TOPGEN]) == tg, bar);
            __builtin_amdgcn_fence(__ATOMIC_ACQUIRE, "agent");
            xb_add(&bar[XB_XGEN(b.x)], 1u);
            asm volatile("s_waitcnt vmcnt(0)" ::: "memory");
        } else {
            XB_SPIN(xb_ld(&bar[XB_XGEN(b.x)]) == gen, bar);
            __builtin_amdgcn_fence(__ATOMIC_ACQUIRE, "agent");
            asm volatile("s_waitcnt vmcnt(0)" ::: "memory");
        }
    }
    __syncthreads();
}

struct Args { const float* in[23]; float* out; unsigned char* ws; int ph_lo, ph_hi, li, pad; };

__device__ __forceinline__ float wave_sum(float v) {
#pragma unroll
    for (int o = 1; o < 64; o <<= 1) v += __shfl_xor(v, o);
    return v;
}

__device__ __forceinline__ void transpose_item(const float* W, int K, int N, bf16* WT, int row_off, int mode, LAS float* scr, int item, int lane) {
    const int nblk = N / 32, kb = item / nblk, nb = item % nblk, k0 = 64 * kb, n0 = 32 * nb;
    { float tv[32];
#pragma unroll
      for (int i = 0; i < 32; ++i) tv[i] = W[(size_t)(k0 + 2 * i + (lane >> 5)) * N + n0 + (lane & 31)];
#pragma unroll
      for (int i = 0; i < 32; ++i) scr[(2 * i + (lane >> 5)) * 33 + (lane & 31)] = tv[i]; }
    LDS_WAIT(); asm volatile("" ::: "memory");
    const int r0 = mode == 0 ? row_off + n0 : row_off + (n0 >> 7) * 256 + (n0 & 127) + (mode == 2 ? 128 : 0);
    const int c = lane & 7;
#pragma unroll
    for (int j = 0; j < 4; ++j) { const int n = (lane >> 3) + 8 * j; const LAS float* s = scr + (8 * c) * 33 + n;
        v4u o; o.x = cvtpk(s[0 * 33], s[1 * 33]); o.y = cvtpk(s[2 * 33], s[3 * 33]); o.z = cvtpk(s[4 * 33], s[5 * 33]); o.w = cvtpk(s[6 * 33], s[7 * 33]);
        *(GAS v4u*)(WT + (size_t)(r0 + n) * K + k0 + 8 * c) = o; }
    LDS_WAIT(); asm volatile("" ::: "memory");
}

__device__ __forceinline__ void transpose_item8(const float* W, int K, int N, unsigned char* WT, int row_off, int mode, float sc, LAS float* scr, int item, int lane) {
    const int nblk = N / 32, kb = item / nblk, nb = item % nblk, k0 = 64 * kb, n0 = 32 * nb;
    { float tv[32];
#pragma unroll
      for (int i = 0; i < 32; ++i) tv[i] = W[(size_t)(k0 + 2 * i + (lane >> 5)) * N + n0 + (lane & 31)];
#pragma unroll
      for (int i = 0; i < 32; ++i) scr[(2 * i + (lane >> 5)) * 33 + (lane & 31)] = tv[i]; }
    LDS_WAIT(); asm volatile("" ::: "memory");
    const int r0 = mode == 0 ? row_off + n0 : row_off + (n0 >> 7) * 256 + (n0 & 127) + (mode == 2 ? 128 : 0);
    const int c = lane & 7;
#pragma unroll
    for (int j = 0; j < 4; ++j) { const int n = (lane >> 3) + 8 * j; const LAS float* s = scr + (8 * c) * 33 + n;
        v2u o; o.x = pg8::pk4_fp8(s[0 * 33] * sc, s[1 * 33] * sc, s[2 * 33] * sc, s[3 * 33] * sc); o.y = pg8::pk4_fp8(s[4 * 33] * sc, s[5 * 33] * sc, s[6 * 33] * sc, s[7 * 33] * sc);
        *(GAS v2u*)(WT + (size_t)(r0 + n) * K + k0 + 8 * c) = o; }
    LDS_WAIT(); asm volatile("" ::: "memory");
}

__device__ __forceinline__ unsigned pk4_i8(float a, float b, float c, float d) {
    const int ia = (int)__builtin_rintf(__builtin_amdgcn_fmed3f(a, -127.f, 127.f)), ib = (int)__builtin_rintf(__builtin_amdgcn_fmed3f(b, -127.f, 127.f)), ic = (int)__builtin_rintf(__builtin_amdgcn_fmed3f(c, -127.f, 127.f)), id = (int)__builtin_rintf(__builtin_amdgcn_fmed3f(d, -127.f, 127.f));
    return (unsigned)(ia & 0xff) | ((unsigned)(ib & 0xff) << 8) | ((unsigned)(ic & 0xff) << 16) | ((unsigned)id << 24); }
__device__ __forceinline__ void transpose_item_i8(const float* W, int K, int N, unsigned char* WT, int row_off, int mode, const float* steps, LAS float* scr, int item, int lane) {
    const int nblk = N / 32, kb = item / nblk, nb = item % nblk, k0 = 64 * kb, n0 = 32 * nb;
    { float tv[32];
#pragma unroll
      for (int i = 0; i < 32; ++i) tv[i] = W[(size_t)(k0 + 2 * i + (lane >> 5)) * N + n0 + (lane & 31)];
#pragma unroll
      for (int i = 0; i < 32; ++i) scr[(2 * i + (lane >> 5)) * 33 + (lane & 31)] = tv[i]; }
    LDS_WAIT(); asm volatile("" ::: "memory");
    const int r0 = mode == 0 ? row_off + n0 : row_off + (n0 >> 7) * 256 + (n0 & 127) + (mode == 2 ? 128 : 0);
    const int c = lane & 7;
#pragma unroll
    for (int j = 0; j < 4; ++j) { const int n = (lane >> 3) + 8 * j; const LAS float* s = scr + (8 * c) * 33 + n; const float st = steps[n0 + n], sc = st > 0.f ? 1.0f / st : 0.f;
        v2u o; o.x = pk4_i8(s[0 * 33] * sc, s[1 * 33] * sc, s[2 * 33] * sc, s[3 * 33] * sc); o.y = pk4_i8(s[4 * 33] * sc, s[5 * 33] * sc, s[6 * 33] * sc, s[7 * 33] * sc);
        *(GAS v2u*)(WT + (size_t)(r0 + n) * K + k0 + 8 * c) = o; }
    LDS_WAIT(); asm volatile("" ::: "memory");
}
__device__ __forceinline__ void colmax_item(const float* W, int K, int N, float* steps, int blk, LAS float* red, int wave, int lane) {
    const int n = blk * 64 + lane; float m = 0.f;
    if (n < N) { const float* p = W + (size_t)(wave * (K / 8)) * N + n;
#pragma unroll 1
        for (int k0 = 0; k0 < K / 8; k0 += 32) { float tv[32];
#pragma unroll
            for (int k = 0; k < 32; ++k) tv[k] = p[(size_t)(k0 + k) * N];
#pragma unroll
            for (int k = 0; k < 32; ++k) m = fmaxf(m, fabsf(tv[k])); } }
    red[wave * 64 + lane] = m;
    __syncthreads();
    if (wave == 0) { float mm = m;
#pragma unroll
        for (int q = 1; q < 8; ++q) mm = fmaxf(mm, red[q * 64 + lane]);
        if (n < N) steps[n] = mm * (1.0f / 127.0f); }
    __syncthreads();
}
__device__ __forceinline__ void absmax_pass(const float* W, size_t n4, unsigned* dst, int gtid, int gthreads, int lane) {
    float m = 0.f;
    for (size_t i = gtid; i < n4; i += gthreads) { const f32x4 v = ((const f32x4*)W)[i]; m = fmaxf(fmaxf(fmaxf(fabsf(v.x), fabsf(v.y)), fmaxf(fabsf(v.z), fabsf(v.w))), m); }
#pragma unroll
    for (int o = 1; o < 64; o <<= 1) m = fmaxf(m, __shfl_xor(m, o));
    if (lane == 0) atomicMax(dst, __float_as_uint(m));
}

struct Wg { LAS unsigned char* lds; int tid, lane, wave, G, bx, gw, NGW; };
#define WS_PTR(T, off) ((T*)(a.ws + (off)))
__device__ __forceinline__ void conv_in_tail(const Args& a, const Wg& w, const int nunits, const int quota);

__device__ __forceinline__ void ph_prologue(const Args& a, const Wg& w) {
    const int tid = w.tid, lane = w.lane, wave = w.wave;
    const float* c_in = a.in[1]; const float* cctx_in = a.in[3]; const float* w_mod = a.in[4];
    const float* w_in = a.in[8]; const float* w_out = a.in[14]; const float* ffn_w1 = a.in[15]; const float* ffn_w3 = a.in[16]; const float* ffn_w2 = a.in[17];
    float* MODP = WS_PTR(float, WS_MODP); bf16* WIN = WS_PTR(bf16, WS_WIN); bf16* WOUT = WS_PTR(bf16, WS_WOUT); bf16* W13 = WS_PTR(bf16, WS_W13); bf16* W2 = WS_PTR(bf16, WS_W2);
    LAS float* scr = (LAS float*)(w.lds + wave * 8448);
    LAS float* sil = (LAS float*)(w.lds + 69632);
    for (int i = tid; i < 9 * D; i += NTHR) { const float v = i < 8 * D ? c_in[i] : cctx_in[i - 8 * D]; sil[i] = v / (1.0f + __expf(-v)); }
    __syncthreads();
    constexpr int I_IN = 16 * 65, I_OUT = 16 * 32, I_F13 = 16 * 88, I_F2 = 44 * 32, I_MOD = 2 * 8 * 96;
    constexpr int NITEMS = I_MOD + 2 * I_IN + 2 * I_OUT + 2 * I_F13 + I_F2;
    for (int it = w.gw; it < NITEMS; it += w.NGW) {
        int r = it;
        if (r < I_MOD) {
            const int l = r / 768, kc = (r % 768) / 96, nb = r % 96, n = nb * 64 + lane;
            float acc[9];
#pragma unroll
            for (int b = 0; b < 9; ++b) acc[b] = 0.f;
            const float* wp = w_mod + ((size_t)l * D + kc * 128) * MOD6 + n;
#pragma unroll 1
            for (int k0 = 0; k0 < 128; k0 += 32) { float wv[32];
#pragma unroll
                for (int k = 0; k < 32; ++k) wv[k] = wp[(size_t)(k0 + k) * MOD6];
#pragma unroll
                for (int k = 0; k < 32; ++k)
#pragma unroll
                    for (int b = 0; b < 9; ++b) acc[b] += sil[b * D + kc * 128 + k0 + k] * wv[k]; }
#pragma unroll
            for (int b = 0; b < 9; ++b) MODP[(((size_t)l * 8 + kc) * 9 + b) * MOD6 + n] = acc[b];
            continue; }
        r -= I_MOD;
        if (r < 2 * I_IN) { const int l = r / I_IN; if (!I8_GIN) transpose_item(w_in + (size_t)l * D * INW, D, INW, WIN + (size_t)l * INP * D, 0, 0, scr, r % I_IN, lane); continue; } r -= 2 * I_IN;
        if (r < 2 * I_OUT) { const int l = r / I_OUT; transpose_item(w_out + (size_t)l * D * D, D, D, WOUT + (size_t)l * D * D, 0, 0, scr, r % I_OUT, lane); continue; } r -= 2 * I_OUT;
        if (r < I_F13) { if (I8_FUP) {} else if (FP8_FUP) transpose_item8(ffn_w1, D, DFF, (unsigned char*)W13, 0, 1, FP8_SW, scr, r, lane); else transpose_item(ffn_w1, D, DFF, W13, 0, 1, scr, r, lane); continue; } r -= I_F13;
        if (r < I_F13) { if (I8_FUP) {} else if (FP8_FUP) transpose_item8(ffn_w3, D, DFF, (unsigned char*)W13, 0, 2, FP8_SW, scr, r, lane); else transpose_item(ffn_w3, D, DFF, W13, 0, 2, scr, r, lane); continue; } r -= I_F13;
        if (FP8_FDN) transpose_item8(ffn_w2, DFF, D, (unsigned char*)W2, 0, 0, FP8_SW, scr, r, lane); else transpose_item(ffn_w2, DFF, D, W2, 0, 0, scr, r, lane);
    }
    {
        float* WCS = WS_PTR(float, WS_WCS); LAS float* red = (LAS float*)(w.lds + 110 * 1024);
        constexpr int B_IN = (INW + 63) / 64, B_F = DFF / 64, NB = (I8_GIN ? 2 * B_IN : 0) + (I8_FUP ? 2 * B_F : 0);
        __syncthreads();
        for (int it = w.bx; it < NB; it += w.G) { int r = it;
            if (I8_GIN) { if (r < 2 * B_IN) { const int l = r / B_IN; colmax_item(w_in + (size_t)l * D * INW, D, INW, WCS + WCS_IN + l * 2304, r % B_IN, red, wave, lane); continue; } r -= 2 * B_IN; }
            if (r < B_F) colmax_item(ffn_w1, D, DFF, WCS + WCS_W1, r, red, wave, lane); else colmax_item(ffn_w3, D, DFF, WCS + WCS_W3, r - B_F, red, wave, lane); }
        if (I8_GIN) for (int i = w.bx * NTHR + tid; i < 2 * (INP - INW); i += w.G * NTHR) WCS[WCS_IN + (i / (INP - INW)) * 2304 + INW + i % (INP - INW)] = 0.f;
    }
    for (int i = w.bx * NTHR + tid; i < 2 * (INP - INW) * D / 8; i += w.G * NTHR) { const int l = i / ((INP - INW) * D / 8), o = i % ((INP - INW) * D / 8);
        if (I8_GIN) { if (o < (INP - INW) * D / 16) *(GAS v4u*)((unsigned char*)WIN + (size_t)l * INP * D + (size_t)INW * D + (size_t)o * 16) = (v4u){0u, 0u, 0u, 0u}; }
        else *(GAS v4u*)(WIN + (size_t)l * INP * D + (size_t)INW * D + (size_t)o * 8) = (v4u){0u, 0u, 0u, 0u}; }
    __syncthreads();
}
__device__ __forceinline__ void ph_modfin(const Args& a, const Wg& w) {
    const float* b_mod = a.in[5]; const float* MODP = WS_PTR(float, WS_MODP); float* MODV = WS_PTR(float, WS_MODV);
    for (int i = w.bx * NTHR + w.tid; i < 2 * 9 * MOD6; i += w.G * NTHR) { const int l = i / (9 * MOD6), r = i % (9 * MOD6), n = r % MOD6;
        float s = b_mod[l * MOD6 + n];
#pragma unroll
        for (int kc = 0; kc < 8; ++kc) s += MODP[((size_t)l * 8 + kc) * 9 * MOD6 + r];
        MODV[i] = s; }
}
__device__ __forceinline__ void ph_quant(const Args& a, const Wg& w) {
    __syncthreads();
    if (I8_GIN) {
        LAS float* scr = (LAS float*)(w.lds + w.wave * 8448); constexpr int I_IN = 16 * 65;
        for (int it = w.gw; it < 2 * I_IN; it += w.NGW) { const int l = it / I_IN;
            transpose_item_i8(a.in[8] + (size_t)l * D * INW, D, INW, WS_PTR(unsigned char, WS_WIN) + (size_t)l * INP * D, 0, 0, WS_PTR(float, WS_WCS) + WCS_IN + l * 2304, scr, it % I_IN, w.lane); }
        __syncthreads(); }
    if (I8_FUP) {
        LAS float* scr = (LAS float*)(w.lds + w.wave * 8448); constexpr int I_F13 = 16 * 88;
        for (int it = w.gw; it < 2 * I_F13; it += w.NGW) { if (it < I_F13) transpose_item_i8(a.in[15], D, DFF, WS_PTR(unsigned char, WS_W13), 0, 1, WS_PTR(float, WS_WCS) + WCS_W1, scr, it, w.lane); else transpose_item_i8(a.in[16], D, DFF, WS_PTR(unsigned char, WS_W13), 0, 2, WS_PTR(float, WS_WCS) + WCS_W3, scr, it - I_F13, w.lane); }
        __syncthreads(); }
}
__device__ __forceinline__ void ph_norm(const Args& a, const Wg& w, const int l, const int which) {
    const int lane = w.lane;
    const float* modl = WS_PTR(float, WS_MODV) + (size_t)l * 9 * MOD6;
    const bool fin = (l == 0 && which == 0);
    const float* resL = a.in[0]; const float* resC = a.in[2]; const bf16* XRES = WS_PTR(bf16, WS_XRES);
    const float* nw = (which == 0 ? a.in[6] : a.in[7]) + l * D;
    bf16* HBUF = WS_PTR(bf16, WS_HBUF);
    const bool route = (l == 1 && which == 1);
    LAS float* rw = (LAS float*)w.lds;
    if (route) { const float* router_w = a.in[18]; for (int i = w.tid; i < D * NE / 4; i += NTHR) ((LAS f32x4*)rw)[i] = ((const f32x4*)router_w)[i]; }
    __syncthreads();
    int* TOKE = WS_PTR(int, WS_ROUTE + RT_TOKE); float* TOKG = WS_PTR(float, WS_ROUTE + RT_TOKG);
    const int Mrows = (l == 1 && which == 1) ? NL : MT;
    for (int m = w.gw; m < Mrows; m += w.NGW) {
        const bool isc = m >= NL; const int bidx = isc ? 8 : (m >> 12);
        const float* xr = isc ? resC + (size_t)(m - NL) * D : resL + (size_t)m * D;
        const float* sh = modl + bidx * MOD6 + which * 3 * D, *sc = sh + D;
        f32x4 v[4]; float ss = 0.f;
#pragma unroll
        for (int j = 0; j < 4; ++j) { v[j] = fin ? *(const f32x4*)(xr + 4 * lane + 256 * j) : pg8::bf4_to_f32(*(const pg8::u32x2_t*)(XRES + (size_t)m * D + 4 * lane + 256 * j)); ss += (v[j].x * v[j].x + v[j].y * v[j].y) + (v[j].z * v[j].z + v[j].w * v[j].w); }
        const float rstd = 1.0f / sqrtf(wave_sum(ss) * (1.0f / D) + EPS);
        float lg[8];
#pragma unroll
        for (int e = 0; e < 8; ++e) lg[e] = 0.f;
        f32x4 hq[4]; float amax = 0.f;
#pragma unroll
        for (int j = 0; j < 4; ++j) { const int c = 4 * lane + 256 * j; const f32x4 wv = *(const f32x4*)(nw + c), s1 = *(const f32x4*)(sc + c), s0 = *(const f32x4*)(sh + c);
            const f32x4 h = (v[j] * rstd) * wv * (s1 + 1.0f) + s0; hq[j] = h;
            amax = fmaxf(amax, fmaxf(fmaxf(fabsf(h.x), fabsf(h.y)), fmaxf(fabsf(h.z), fabsf(h.w))));
            if (route) {
#pragma unroll
                for (int q = 0; q < 4; ++q) { const f32x4 r0 = *(const LAS f32x4*)(rw + (c + q) * 8), r1 = *(const LAS f32x4*)(rw + (c + q) * 8 + 4); const float hv = h[q];
                    lg[0] += hv * r0.x; lg[1] += hv * r0.y; lg[2] += hv * r0.z; lg[3] += hv * r0.w; lg[4] += hv * r1.x; lg[5] += hv * r1.y; lg[6] += hv * r1.z; lg[7] += hv * r1.w; } } }
        if ((which == 1 && l == 0 && I8_FUP) || (which == 0 && I8_GIN)) {
#pragma unroll
            for (int o = 1; o < 64; o <<= 1) amax = fmaxf(amax, __shfl_xor(amax, o));
            const float qs = amax > 1e-30f ? 127.0f / amax : 0.f;
            if (lane == 0) WS_PTR(float, WS_RS)[m] = amax * (1.0f / 127.0f);
#pragma unroll
            for (int j = 0; j < 4; ++j) *(unsigned*)((unsigned char*)HBUF + (size_t)m * D + 4 * lane + 256 * j) = pk4_i8(hq[j].x * qs, hq[j].y * qs, hq[j].z * qs, hq[j].w * qs);
        } else {
#pragma unroll
            for (int j = 0; j < 4; ++j) { const int c = 4 * lane + 256 * j; const f32x4 h = hq[j];
                if (which == 0 || (l == 0 && !FP8_FUP)) *(v2u*)(HBUF + (size_t)m * D + c) = (v2u){cvtpk(h.x, h.y), cvtpk(h.z, h.w)};
                else *(unsigned*)((unsigned char*)HBUF + (size_t)m * D + c) = pg8::pk4_fp8(h.x * FP8_SH, h.y * FP8_SH, h.z * FP8_SH, h.w * FP8_SH); } }
        if (route) {
#pragma unroll
            for (int e = 0; e < 8; ++e) lg[e] = wave_sum(lg[e]);
            int e0 = 0; float v0 = lg[0];
#pragma unroll
            for (int e = 1; e < 8; ++e) if (lg[e] > v0) { v0 = lg[e]; e0 = e; }
            int e1 = -1; float v1 = -3.0e38f;
#pragma unroll
            for (int e = 0; e < 8; ++e) if (e != e0 && lg[e] > v1) { v1 = lg[e]; e1 = e; }
            const float g0 = 1.0f / (1.0f + __expf(v1 - v0)), g1 = 1.0f - g0;
            if (lane == 0) { TOKE[m] = e0; TOKE[NL + m] = e1; TOKG[m] = g0; TOKG[NL + m] = g1; }
        }
    }
    __syncthreads();
}
__device__ __forceinline__ void ph_gin(const Args& a, const Wg& w, const int l) {
    if constexpr (I8_GIN) { pg8::DenseOrder S; S.init(WS_PTR(bf16, WS_HBUF), (const bf16*)(WS_PTR(unsigned char, WS_WIN) + (size_t)l * INP * D), MT, INP, D / 2, w.G, w.bx);
        pg8::EpiBf16i E{WS_PTR(bf16, WS_PBUF), INP, WS_PTR(float, WS_RS), WS_PTR(float, WS_WCS) + WCS_IN + l * 2304};
        pg8::gemm_phase<pg8::EpiBf16i, pg8::DenseOrder, true, false, 2>(w.lds, D / 2, S, E); }
    else { pg8::DenseOrder S; S.init(WS_PTR(bf16, WS_HBUF), WS_PTR(bf16, WS_WIN) + (size_t)l * INP * D, MT, INP, D, w.G, w.bx); pg8::EpiBf16 E{WS_PTR(bf16, WS_PBUF), INP};
        pg8::gemm_phase<pg8::EpiBf16, pg8::DenseOrder, true, false>(w.lds, D, S, E); }
    conv_in_tail(a, w, (MT / 256) * (INP / 256), CONV_Q_GIN);
}
__device__ __forceinline__ int wq_next(unsigned* ctr, volatile LAS int* slot, int tid) {
    __syncthreads();
    if (tid == 0) *slot = (int)__hip_atomic_fetch_add(ctr, 1u, __ATOMIC_RELAXED, __HIP_MEMORY_SCOPE_AGENT);
    __syncthreads();
    return __builtin_amdgcn_readfirstlane(*slot);
}
__device__ __forceinline__ int wq_claim(unsigned* ctr, int tid) { return tid == 0 ? (int)__hip_atomic_fetch_add(ctr, 1u, __ATOMIC_RELAXED, __HIP_MEMORY_SCOPE_AGENT) : 0; }
__device__ __forceinline__ int wq_take(volatile LAS int* slot, int& par, int claimed, int tid) {
    if (tid == 0) slot[par] = claimed;
    __syncthreads();
    const int v = __builtin_amdgcn_readfirstlane(slot[par]); par ^= 1; return v;
}
#define MFMA16(a, b, c) __builtin_amdgcn_mfma_f32_16x16x32_bf16((a), (b), (c), 0, 0, 0)
constexpr int GL_QE = 0, GL_KE = 18432, GL_KDT = 36864, GL_P = 55296, GL_VT = 73728, GL_OS = 110592, GL_DEC = 144384, GL_SLOT = 160000;
static_assert(GL_DEC + 512 <= GL_SLOT && GL_SLOT + 64 <= LDSCTL_OFF, "GLA LDS map");
#define BB16 1
#if BB16
typedef _Float16 bb_t;
#else
typedef float bb_t;
#endif
constexpr size_t GSCR_OFF = (size_t)72 * MiB;
constexpr int NG1 = 64 * 17;
__device__ __forceinline__ int gla_run_row0(int b, int run) { return run == 0 ? NL + b * CTXL : b * SEQ + (run - 1) * 256; }
__device__ __forceinline__ float log_sigmoid_f(float z) { return fminf(z, 0.f) - log1pf(__expf(-fabsf(z))); }
__device__ __forceinline__ void gla_vt_image(const bf16* PBUF, LAS unsigned char* lds, int row0, int h, int tid) {
    const int dv = tid & 127, t4 = tid >> 7; unsigned pk[8];
    const bf16* p = PBUF + (size_t)(row0 + 16 * t4) * INP + PC_V + h * 128 + dv;
#pragma unroll
    for (int e = 0; e < 8; ++e) pk[e] = (unsigned)p[(size_t)(2 * e) * INP] | ((unsigned)p[(size_t)(2 * e + 1) * INP] << 16);
    *(LAS v4u*)(lds + GL_VT + dv * 144 + 32 * t4) = (v4u){pk[0], pk[1], pk[2], pk[3]};
    *(LAS v4u*)(lds + GL_VT + dv * 144 + 32 * t4 + 16) = (v4u){pk[4], pk[5], pk[6], pk[7]};
}
__device__ __forceinline__ void gla_state_update(f32x4 (&S)[4], LAS unsigned char* lds, int wave, int r, int q, int o_kdt, int o_vt, int o_dec) {
    const LAS float* dec = (const LAS float*)(lds + o_dec);
#pragma unroll
    for (int kt = 0; kt < 4; ++kt) { const f32x4 d = *(const LAS f32x4*)(dec + 16 * kt + 4 * q); S[kt] = S[kt] * d; }
#pragma unroll
    for (int ks = 0; ks < 2; ++ks) { const bf16x8 B = *(const LAS bf16x8*)(lds + o_vt + (16 * wave + r) * 144 + (32 * ks + 8 * q) * 2);
#pragma unroll
        for (int kt = 0; kt < 4; ++kt) { const bf16x8 A = *(const LAS bf16x8*)(lds + o_kdt + (16 * kt + r) * 144 + (32 * ks + 8 * q) * 2); S[kt] = MFMA16(A, B, S[kt]); } }
}
struct G1Raw { v4u lfa[2]; unsigned kq[4]; unsigned vp[8]; };
__device__ __forceinline__ void g1_load(G1Raw& r, const bf16* PBUF, int row0, int h, int dir, int tid) {
    const int k = tid & 63, tg = tid >> 6, dv = tid & 127, t4 = tid >> 7;
    { const int wv = tid >> 6, ln = tid & 63;
#pragma unroll
      for (int t = 0; t < 2; ++t) r.lfa[t] = *(const v4u*)(PBUF + (size_t)(row0 + 16 * (2 * (wv >> 2) + t) + (ln & 15)) * INP + PC_LF + dir * 16 + 8 * ((ln >> 4) & 1)); }
    const bf16* pk = PBUF + (size_t)(row0 + 8 * tg) * INP + PC_K + h * 64 + k;
#pragma unroll
    for (int e = 0; e < 4; ++e) r.kq[e] = (unsigned)pk[(size_t)(2 * e) * INP] | ((unsigned)pk[(size_t)(2 * e + 1) * INP] << 16);
    const bf16* pv = PBUF + (size_t)(row0 + 16 * t4) * INP + PC_V + h * 128 + dv;
#pragma unroll
    for (int e = 0; e < 8; ++e) r.vp[e] = (unsigned)pv[(size_t)(2 * e) * INP] | ((unsigned)pv[(size_t)(2 * e + 1) * INP] << 16);
}
__device__ __forceinline__ float log_sigmoid_fast(float z) { return fminf(z, 0.f) - __logf(1.0f + __expf(-fabsf(z))); }
constexpr int G1_VT = 0, G1_KDT = 36864, G1_LF = 55296, G1_T = 63488, G1_DEC = 67584, G1_Z = 69632;
__device__ __forceinline__ void gla_g1_job(const Args& a, const Wg& w, const int l, const int job, const int var = 0) {
    const int tid = w.tid, lane = w.lane, wave = w.wave, r = lane & 15, q = lane >> 4, k = tid & 63, tg = tid >> 6;
    const int seq = job / 17, step = job - seq * 17, b = seq >> 3, h = (seq >> 1) & 3, dir = seq & 1;
    const int run = step == 0 ? 0 : (dir ? 17 - step : step), rrow0 = gla_run_row0(b, run);
    const bf16* PBUF = WS_PTR(bf16, WS_PBUF); bb_t* BBUF = (bb_t*)a.out; float* SLOC = WS_PTR(float, WS_SLOC); float* DTOT = WS_PTR(float, WS_DTOT);
    LAS unsigned char* lds = w.lds;
    bf16x8 WB;
    { const int kgrp = lane >> 4, r0 = 8 * (kgrp & 1); const float* wgp = (dir ? a.in[11] : a.in[9]) + (size_t)l * 16 * 256 + h * 64 + 16 * (wave & 3) + (lane & 15);
      unsigned pkw[4];
#pragma unroll
      for (int jj = 0; jj < 8; jj += 2) { unsigned hv[2];
#pragma unroll
          for (int u = 0; u < 2; ++u) { const float wv = wgp[(r0 + jj + u) * 256]; const unsigned hb = cvtpk(wv, wv) & 0xffffu; const float lo = wv - __uint_as_float(hb << 16); hv[u] = (kgrp >> 1) ? (cvtpk(lo, lo) & 0xffffu) : hb; }
          pkw[jj >> 1] = hv[0] | (hv[1] << 16); }
      WB = __builtin_bit_cast(bf16x8, (v4u){pkw[0], pkw[1], pkw[2], pkw[3]}); }
    const float bias = (dir ? a.in[12] : a.in[10])[l * 256 + h * 64 + k];
    f32x4 S[4];
#pragma unroll
    for (int kt = 0; kt < 4; ++kt) S[kt] = (f32x4){0.f, 0.f, 0.f, 0.f};
    float logtot = 0.f;
    G1Raw cur; g1_load(cur, PBUF, rrow0 + (dir ? 3 : 0) * 64, h, dir, tid);
    for (int pc = 0; pc < ((var & 8) ? 0 : 4); ++pc) {
        const int par = pc & 1, row0 = rrow0 + (dir ? 3 - pc : pc) * 64;
        LAS unsigned char* VT = lds + G1_VT + par * 18432; LAS unsigned char* KDT = lds + G1_KDT + par * 9216; LAS float* Z = (LAS float*)(lds + G1_Z);
        LAS float* T = (LAS float*)(lds + G1_T + par * 2048); LAS float* DEC = (LAS float*)(lds + G1_DEC + par * 256);
        { f32x4 z0 = (f32x4){0.f, 0.f, 0.f, 0.f}, z1 = z0;
          z0 = MFMA16(__builtin_bit_cast(bf16x8, cur.lfa[0]), WB, z0); z1 = MFMA16(__builtin_bit_cast(bf16x8, cur.lfa[1]), WB, z1);
          LAS float* zp = Z + (32 * (wave >> 2) + 4 * q) * 68 + 16 * (wave & 3) + r;
#pragma unroll
          for (int i = 0; i < 4; ++i) { zp[i * 68] = z0[i]; zp[(16 + i) * 68] = z1[i]; } }
        { const int dv = tid & 127, t4 = tid >> 7;
          *(LAS v4u*)(VT + dv * 144 + 32 * t4) = (v4u){cur.vp[0], cur.vp[1], cur.vp[2], cur.vp[3]}; *(LAS v4u*)(VT + dv * 144 + 32 * t4 + 16) = (v4u){cur.vp[4], cur.vp[5], cur.vp[6], cur.vp[7]}; }
        const unsigned kq0 = cur.kq[0], kq1 = cur.kq[1], kq2 = cur.kq[2], kq3 = cur.kq[3];
        __syncthreads();
        if (pc < 3) g1_load(cur, PBUF, rrow0 + (dir ? 2 - pc : pc + 1) * 64, h, dir, tid);
        float gv[8];
#pragma unroll
        for (int e = 0; e < 8; ++e) { gv[e] = log_sigmoid_fast(Z[(8 * tg + e) * 68 + k] + bias) * (1.0f / 16.0f); if (var & 1) break; }
        if (var & 1) {
#pragma unroll
            for (int e = 1; e < 8; ++e) gv[e] = gv[0]; }
        float runs = 0.f;
        if (!dir) {
#pragma unroll
            for (int e = 0; e < 8; ++e) { runs += gv[e]; gv[e] = runs; } }
        else {
#pragma unroll
            for (int e = 7; e >= 0; --e) { runs += gv[e]; gv[e] = runs; } }
        T[tg * 64 + k] = runs;
        __syncthreads();
        float off = 0.f, tot = 0.f;
#pragma unroll
        for (int t2 = 0; t2 < 8; ++t2) { const float v = T[t2 * 64 + k]; tot += v; const bool before = dir ? (t2 > tg) : (t2 < tg); off += before ? v : 0.f; }
        const unsigned kqa[4] = {kq0, kq1, kq2, kq3}; unsigned pk[4];
#pragma unroll
        for (int e2 = 0; e2 < 4; ++e2) { const float B0 = gv[2 * e2] + off, B1 = gv[2 * e2 + 1] + off; const size_t row = (size_t)(row0 + 8 * tg + 2 * e2);
            if (!(var & 4)) { BBUF[row * 512 + dir * 256 + h * 64 + k] = (bb_t)B0; BBUF[(row + 1) * 512 + dir * 256 + h * 64 + k] = (bb_t)B1; }
            pk[e2] = cvtpk(bflo(kqa[e2]) * __expf(tot - B0), bfhi(kqa[e2]) * __expf(tot - B1)); }
        *(LAS v4u*)(KDT + k * 144 + 16 * tg) = (v4u){pk[0], pk[1], pk[2], pk[3]};
        if (tg == 0) DEC[k] = __expf(tot);
        logtot += tot;
        __syncthreads();
        if (!(var & 2)) {
#pragma unroll
            for (int kt = 0; kt < 4; ++kt) { const f32x4 d = *(const LAS f32x4*)(DEC + 16 * kt + 4 * q); S[kt] = S[kt] * d; }
#pragma unroll
            for (int ks = 0; ks < 2; ++ks) { const bf16x8 Bf = *(const LAS bf16x8*)(VT + (16 * wave + r) * 144 + (32 * ks + 8 * q) * 2);
#pragma unroll
                for (int kt = 0; kt < 4; ++kt) { const bf16x8 Af = *(const LAS bf16x8*)(KDT + (16 * kt + r) * 144 + (32 * ks + 8 * q) * 2); S[kt] = MFMA16(Af, Bf, S[kt]); } }
        }
    }
    const size_t idx = (size_t)seq * 17 + step;
#pragma unroll
    for (int kt = 0; kt < 4; ++kt)
#pragma unroll
        for (int i = 0; i < 4; ++i) SLOC[idx * 8192 + (size_t)(16 * kt + 4 * q + i) * 128 + 16 * wave + r] = S[kt][i];
    if (tg == 0) DTOT[idx * 64 + k] = __expf(logtot);
}
__device__ __forceinline__ void ph_gla_scan(const Args& a, const Wg& w) {
    float* SLOC = WS_PTR(float, WS_SLOC); const float* DTOT = WS_PTR(float, WS_DTOT);
    for (int ge = w.bx * NTHR + w.tid; ge < 64 * 8192; ge += w.G * NTHR) { const int seq = ge >> 13, e = ge & 8191;
        float* p = SLOC + (size_t)seq * 17 * 8192 + e; const float* d = DTOT + (size_t)seq * 17 * 64 + (e >> 7);
        float tv[17], dv[17];
#pragma unroll
        for (int st = 0; st < 17; ++st) { tv[st] = p[(size_t)st * 8192]; dv[st] = d[st * 64]; }
        float s = 0.f;
#pragma unroll
        for (int st = 0; st < 17; ++st) { p[(size_t)st * 8192] = s; s = dv[st] * s + tv[st]; } }
}
struct G3Raw { float Bl; float B[8]; unsigned qk[8]; unsigned vp[8]; };
__device__ __forceinline__ void g3_load(G3Raw& r, const bf16* PBUF, const bb_t* BBUF, int row0, int h, int dir, int tid) {
    const int k = tid & 63, tg = tid >> 6, dv = tid & 127, t4 = tid >> 7;
    r.Bl = (float)BBUF[(size_t)(row0 + (dir ? 0 : 63)) * 512 + dir * 256 + h * 64 + k];
#pragma unroll
    for (int e = 0; e < 8; ++e) { const size_t row = (size_t)(row0 + 8 * tg + e); r.B[e] = (float)BBUF[row * 512 + dir * 256 + h * 64 + k];
        r.qk[e] = (unsigned)PBUF[row * INP + PC_Q + h * 64 + k] | ((unsigned)PBUF[row * INP + PC_K + h * 64 + k] << 16); }
    const bf16* pv = PBUF + (size_t)(row0 + 16 * t4) * INP + PC_V + h * 128 + dv;
#pragma unroll
    for (int e = 0; e < 8; ++e) r.vp[e] = (unsigned)pv[(size_t)(2 * e) * INP] | ((unsigned)pv[(size_t)(2 * e + 1) * INP] << 16);
}
__device__ __forceinline__ void gla_g3_job(const Args& a, const Wg& w, const int l, const int job, const int var = 0) {
    const int tid = w.tid, lane = w.lane, wave = w.wave, r = lane & 15, q = lane >> 4, k = tid & 63, tg = tid >> 6;
    const int b = job / 68, h = (job / 17) & 3, run = job % 17, rrow0 = gla_run_row0(b, run);
    const bf16* PBUF = WS_PTR(bf16, WS_PBUF); const bb_t* BBUF = (const bb_t*)a.out; const float* SLOC = WS_PTR(float, WS_SLOC); bf16* MIX = WS_PTR(bf16, WS_MIX);
    v4u* OFS = (v4u*)((unsigned char*)a.out + GSCR_OFF) + ((size_t)job * 4 * NTHR + tid) * 2;
    const float* gnw = a.in[13] + l * 128 + (tid & 7) * 16;
    f32x4 gw4[4];
#pragma unroll
    for (int j = 0; j < 4; ++j) gw4[j] = *(const f32x4*)(gnw + 4 * j);
    LAS unsigned char* lds = w.lds; LAS float* OS = (LAS float*)(lds + GL_OS);
    f32x4 S[4];
    { const size_t idx = (size_t)((b * 4 + h) * 2 + 0) * 17 + run;
#pragma unroll
      for (int kt = 0; kt < 4; ++kt)
#pragma unroll
          for (int i = 0; i < 4; ++i) S[kt][i] = SLOC[idx * 8192 + (size_t)(16 * kt + 4 * q + i) * 128 + 16 * wave + r]; }
    G3Raw cur; g3_load(cur, PBUF, BBUF, rrow0, h, 0, tid);
    for (int s = 0; s < ((var & 8) ? 0 : 8); ++s) {
        const int dir = s >> 2, pc = s & 3, cidx = dir ? 3 - pc : pc, row0 = rrow0 + cidx * 64, par = s & 1;
        const int oQE = GL_QE + par * 9216, oKE = GL_KE + par * 9216, oKDT = GL_KDT + par * 9216, oP = GL_P + par * 9216, oVT = GL_VT + par * 18432, oDEC = GL_DEC + par * 256;
        if (s == 4) { const size_t idx = (size_t)((b * 4 + h) * 2 + 1) * 17 + (run == 0 ? 0 : 17 - run);
#pragma unroll
            for (int kt = 0; kt < 4; ++kt)
#pragma unroll
                for (int i = 0; i < 4; ++i) S[kt][i] = SLOC[idx * 8192 + (size_t)(16 * kt + 4 * q + i) * 128 + 16 * wave + r]; }
        {
            unsigned pk[4];
#pragma unroll
            for (int e2 = 0; e2 < 4; ++e2) { float kd[2];
#pragma unroll
                for (int u = 0; u < 2; ++u) { const int e = 2 * e2 + u; const float Bv = cur.B[e], qv = bflo(cur.qk[e]), kv = bfhi(cur.qk[e]);
                    const float ke = kv * __expf(-Bv); kd[u] = kv * __expf(cur.Bl - Bv);
                    const unsigned qk2 = cvtpk(qv * 0.125f * __expf(Bv), ke);
                    *(LAS bf16*)(lds + oQE + (8 * tg + e) * 144 + 2 * k) = (bf16)(qk2 & 0xffffu); *(LAS bf16*)(lds + oKE + (8 * tg + e) * 144 + 2 * k) = (bf16)(qk2 >> 16); }
                pk[e2] = cvtpk(kd[0], kd[1]); }
            *(LAS v4u*)(lds + oKDT + k * 144 + 16 * tg) = (v4u){pk[0], pk[1], pk[2], pk[3]};
            if (tg == 0) *(LAS float*)(lds + oDEC + 4 * k) = __expf(cur.Bl);
            const int dv = tid & 127, t4 = tid >> 7;
            *(LAS v4u*)(lds + oVT + dv * 144 + 32 * t4) = (v4u){cur.vp[0], cur.vp[1], cur.vp[2], cur.vp[3]}; *(LAS v4u*)(lds + oVT + dv * 144 + 32 * t4 + 16) = (v4u){cur.vp[4], cur.vp[5], cur.vp[6], cur.vp[7]};
        }
        __syncthreads();
        if (s < 7) { const int s1 = s + 1, d1 = s1 >> 2, p1 = s1 & 3; g3_load(cur, PBUF, BBUF, rrow0 + (d1 ? 3 - p1 : p1) * 64, h, d1, tid); }
        v4u of0 = (v4u){0u, 0u, 0u, 0u}, of1 = of0, gA = of0, gB = of0;
        if (dir) { const v4u* op = OFS + (size_t)cidx * NTHR * 2; of0 = op[0]; of1 = op[1];
            const bf16* pg = PBUF + (size_t)(row0 + (tid >> 3)) * INP + PC_G + h * 128 + (tid & 7) * 16; gA = *(const v4u*)pg; gB = *(const v4u*)(pg + 8); }
#pragma unroll
        for (int t = 0; t < 2; ++t) { const int id = 2 * wave + t, st = id >> 2, tt = id & 3;
            f32x4 pa = (f32x4){0.f, 0.f, 0.f, 0.f};
            if (dir ? (st >= tt) : (st <= tt)) {
#pragma unroll
                for (int ks = 0; ks < 2; ++ks) { const bf16x8 A = *(const LAS bf16x8*)(lds + oKE + (16 * st + r) * 144 + (32 * ks + 8 * q) * 2), B = *(const LAS bf16x8*)(lds + oQE + (16 * tt + r) * 144 + (32 * ks + 8 * q) * 2);
                    pa = MFMA16(A, B, pa); }
                const int tau = 16 * tt + r;
#pragma unroll
                for (int i = 0; i < 4; ++i) { const int sg = 16 * st + 4 * q + i; const bool keep = dir ? (sg >= tau) : (sg <= tau); pa[i] = keep ? pa[i] : 0.f; } }
            *(LAS v2u*)(lds + oP + (16 * tt + r) * 144 + (16 * st + 4 * q) * 2) = (v2u){cvtpk(pa[0], pa[1]), cvtpk(pa[2], pa[3])}; }
        __syncthreads();
        f32x4 o[4];
#pragma unroll
        for (int tt = 0; tt < 4; ++tt) o[tt] = (f32x4){0.f, 0.f, 0.f, 0.f};
#pragma unroll
        for (int ks = 0; ks < 2; ++ks) {
            const bf16x8 Bs = __builtin_bit_cast(bf16x8, (v4u){cvtpk(S[2 * ks][0], S[2 * ks][1]), cvtpk(S[2 * ks][2], S[2 * ks][3]), cvtpk(S[2 * ks + 1][0], S[2 * ks + 1][1]), cvtpk(S[2 * ks + 1][2], S[2 * ks + 1][3])});
#pragma unroll
            for (int tt = 0; tt < 4; ++tt) { const v2u alo = *(const LAS v2u*)(lds + oQE + (16 * tt + r) * 144 + (32 * ks + 4 * q) * 2), ahi = *(const LAS v2u*)(lds + oQE + (16 * tt + r) * 144 + (32 * ks + 16 + 4 * q) * 2);
                o[tt] = MFMA16(__builtin_bit_cast(bf16x8, (v4u){alo.x, alo.y, ahi.x, ahi.y}), Bs, o[tt]); } }
#pragma unroll
        for (int ks = 0; ks < 2; ++ks) { const bf16x8 Bv = *(const LAS bf16x8*)(lds + oVT + (16 * wave + r) * 144 + (32 * ks + 8 * q) * 2);
#pragma unroll
            for (int tt = 0; tt < 4; ++tt) { const bf16x8 A = *(const LAS bf16x8*)(lds + oP + (16 * tt + r) * 144 + (32 * ks + 8 * q) * 2); o[tt] = MFMA16(A, Bv, o[tt]); } }
        gla_state_update(S, lds, wave, r, q, oKDT, oVT, oDEC);
        if (dir == 0) {
            v4u* op = OFS + (size_t)cidx * NTHR * 2;
            op[0] = (v4u){cvtpk(o[0][0], o[0][1]), cvtpk(o[0][2], o[0][3]), cvtpk(o[1][0], o[1][1]), cvtpk(o[1][2], o[1][3])};
            op[1] = (v4u){cvtpk(o[2][0], o[2][1]), cvtpk(o[2][2], o[2][3]), cvtpk(o[3][0], o[3][1]), cvtpk(o[3][2], o[3][3])};
        } else {
            const unsigned ofw[8] = {of0.x, of0.y, of0.z, of0.w, of1.x, of1.y, of1.z, of1.w};
#pragma unroll
            for (int tt = 0; tt < 4; ++tt)
#pragma unroll
                for (int i = 0; i < 4; ++i) { const int tk = 16 * tt + 4 * q + i; const unsigned wv = ofw[2 * tt + (i >> 1)]; OS[tk * 132 + 16 * wave + r] = o[tt][i] + ((i & 1) ? bfhi(wv) : bflo(wv)); }
            __syncthreads();
            const int tk = tid >> 3, dv0 = (tid & 7) * 16; const size_t row = (size_t)(row0 + tk);
            f32x4 ov[4]; float ss = 0.f;
#pragma unroll
            for (int j = 0; j < 4; ++j) { ov[j] = *(const LAS f32x4*)(OS + tk * 132 + dv0 + 4 * j); ss += (ov[j].x * ov[j].x + ov[j].y * ov[j].y) + (ov[j].z * ov[j].z + ov[j].w * ov[j].w); }
            ss += __shfl_xor(ss, 1); ss += __shfl_xor(ss, 2); ss += __shfl_xor(ss, 4);
            const float rstd = __builtin_amdgcn_rsqf(ss * (1.0f / 128.0f) + EPS);
            const unsigned gq[8] = {gA.x, gA.y, gA.z, gA.w, gB.x, gB.y, gB.z, gB.w}; unsigned yo[8];
#pragma unroll
            for (int j = 0; j < 4; ++j) { const f32x4 wv = gw4[j];
                const float ga = bflo(gq[2 * j]), gb = bfhi(gq[2 * j]), gc = bflo(gq[2 * j + 1]), gd = bfhi(gq[2 * j + 1]);
                yo[2 * j] = cvtpk(ov[j].x * rstd * wv.x * silu_fast(ga), ov[j].y * rstd * wv.y * silu_fast(gb));
                yo[2 * j + 1] = cvtpk(ov[j].z * rstd * wv.z * silu_fast(gc), ov[j].w * rstd * wv.w * silu_fast(gd)); }
            bf16* mo = MIX + row * D + 512 + h * 128 + dv0;
            *(v4u*)mo = (v4u){yo[0], yo[1], yo[2], yo[3]}; *(v4u*)(mo + 8) = (v4u){yo[4], yo[5], yo[6], yo[7]};
        }
    }
}
__device__ __forceinline__ void four_t1_setup(const Wg& w, bf16x8 (&T1)[8]) {
    const int lane = w.lane, wave = w.wave, r = lane & 31, h = lane >> 5;
    const int k2c = 32 * wave + r, k2 = k2c & 127;
#pragma unroll
    for (int s = 0; s < 8; ++s) { unsigned pk[4];
#pragma unroll
        for (int j = 0; j < 4; ++j) { const int n0 = 16 * s + 8 * h + 2 * j; const float f0 = (float)((n0 * k2) & 127) * (1.0f / 128.0f), f1 = (float)(((n0 + 1) * k2) & 127) * (1.0f / 128.0f);
            pk[j] = k2c < 128 ? cvtpk(cosrev(f0), cosrev(f1)) : cvtpk(-sinrev(f0), -sinrev(f1)); }
        T1[s] = __builtin_bit_cast(bf16x8, (v4u){pk[0], pk[1], pk[2], pk[3]}); }
}
__device__ __forceinline__ void ctx_dft1_item(const Args& a, const Wg& w, const bf16x8 (&T1)[8], const int item) {
    const int tid = w.tid, lane = w.lane, wave = w.wave, r = lane & 31, h = lane >> 5;
    const bf16* PBUF = WS_PTR(bf16, WS_PBUF); bf16* XB = WS_PTR(bf16, WS_XBC) - (size_t)NL * 4 * 256;
    LAS unsigned char* U = w.lds;
    const int g = item & 3, m0 = NL + (item >> 2) * 64;
    __syncthreads();
#pragma unroll
    for (int i = 0; i < 2; ++i) { const int id = tid + NTHR * i, aa = id >> 4, ch = id & 15;
        const v4u v = *(const v4u*)(PBUF + (size_t)(m0 + aa) * INP + PC_U + g * 128 + ch * 8);
        *(LAS v4u*)(U + aa * 272 + ch * 16) = v; }
    __syncthreads();
    f32x16 x0, x1;
#pragma unroll
    for (int i = 0; i < 16; ++i) { x0[i] = 0.f; x1[i] = 0.f; }
#pragma unroll
    for (int s = 0; s < 8; ++s) { const bf16x8 A0 = *(const LAS bf16x8*)(U + r * 272 + (16 * s + 8 * h) * 2), A1 = *(const LAS bf16x8*)(U + (32 + r) * 272 + (16 * s + 8 * h) * 2);
        x0 = MFMA32(A0, T1[s], x0); x1 = MFMA32(A1, T1[s], x1); }
    bf16* xo = XB + ((size_t)m0 * 4 + g) * 256 + 32 * wave + r;
#pragma unroll
    for (int i = 0; i < 16; ++i) { xo[(size_t)crow32(i, h) * 1024] = bf1(x0[i]); xo[(size_t)(32 + crow32(i, h)) * 1024] = bf1(x1[i]); }
}
__device__ __forceinline__ void ctx_dft2_item(const Args& a, const Wg& w, const int it) {
    const int tid = w.tid, lane = w.lane, wave = w.wave, r = lane & 31, h = lane >> 5, dt = wave >> 2, ct = wave & 3;
    const bf16* XB = WS_PTR(bf16, WS_XBC) - (size_t)NL * 4 * 256; bf16* MIX = WS_PTR(bf16, WS_MIX);
    const int b = it >> 4, g = (it >> 2) & 3, kq = it & 3, row0 = NL + b * CTXL;
    LAS unsigned char* T = w.lds; constexpr int P = 528;
    __syncthreads();
    v4u v[16];
#pragma unroll
    for (int i = 0; i < 16; ++i) { const int id = tid + NTHR * i, row = id >> 5, ch = id & 31; v[i] = *(const v4u*)(XB + ((size_t)(row0 + row) * 4 + g) * 256 + ch * 8); }
#pragma unroll
    for (int i = 0; i < 16; ++i) { const int id = tid + NTHR * i, row = id >> 5, ch = id & 31; *(LAS v4u*)(T + row * P + ch * 16) = v[i]; }
    __syncthreads();
    f32x16 y;
#pragma unroll
    for (int i = 0; i < 16; ++i) y[i] = 0.f;
    const int k1 = kq * 64 + dt * 32 + r;
#pragma unroll 4
    for (int s = 0; s < 32; ++s) { unsigned pa[4], pb[4];
#pragma unroll
        for (int jj = 0; jj < 4; ++jj) { const int n1 = 8 * s + 4 * h + jj; const float f = (float)((k1 * n1) & 255) * (1.0f / 256.0f); pa[jj] = cvtpk(cosrev(f), sinrev(f));
            const LAS unsigned char* p = T + n1 * P + (32 * ct + r) * 2; pb[jj] = (unsigned)*(const LAS bf16*)p | ((unsigned)*(const LAS bf16*)(p + 256) << 16); }
        y = MFMA32(__builtin_bit_cast(bf16x8, (v4u){pa[0], pa[1], pa[2], pa[3]}), __builtin_bit_cast(bf16x8, (v4u){pb[0], pb[1], pb[2], pb[3]}), y); }
    const float sc = 1.0f / sqrtf((float)CTXL * 128.0f);
    bf16* mo = MIX + (size_t)(row0 + kq * 64 + 32 * dt) * D + g * 128 + 32 * ct + r;
#pragma unroll
    for (int i = 0; i < 16; ++i) mo[(size_t)crow32(i, h) * D] = bf1(y[i] * sc);
}
__device__ __forceinline__ void four_a_setup(const Wg& w, bf16x8 (&T1)[8]) {
    const int tid = w.tid;
    LAS unsigned char* M64 = w.lds;
    __syncthreads();
    for (int i = tid; i < 128 * 128; i += NTHR) { const int row = i >> 7, col = i & 127, c = row & 63, ri = row >> 6, aa = col & 63, ri2 = col >> 6;
        const float f = (float)((c * aa) & 63) * (1.0f / 64.0f), cs = cosrev(f), sn = sinrev(f); const float v = (ri == ri2) ? cs : (ri == 0 ? sn : -sn);
        *(LAS bf16*)(M64 + row * 272 + col * 2) = (bf16)f2bf(v); }
    four_t1_setup(w, T1);
    __syncthreads();
}
__device__ __forceinline__ void four_a_item(const Args& a, const Wg& w, const bf16x8 (&T1)[8], const int item) {
    const int tid = w.tid, lane = w.lane, wave = w.wave, r = lane & 31, h = lane >> 5;
    const bf16* PBUF = WS_PTR(bf16, WS_PBUF); bf16* ZB = WS_PTR(bf16, WS_ZBUF);
    LAS unsigned char* M64 = w.lds; LAS unsigned char* U = w.lds + 34816; LAS unsigned char* XT = w.lds + 52224;
    const int b = item >> 8, g = (item >> 6) & 3, bcol = item & 63;
#pragma unroll
    for (int i = 0; i < 2; ++i) { const int id = tid + NTHR * i, aa = id >> 4, ch = id & 15;
        const v4u v = *(const v4u*)(PBUF + (size_t)(b * SEQ + 64 * aa + bcol) * INP + PC_U + g * 128 + ch * 8);
        *(LAS v4u*)(U + aa * 272 + ch * 16) = v; }
    __syncthreads();
    f32x16 x0, x1;
#pragma unroll
    for (int i = 0; i < 16; ++i) { x0[i] = 0.f; x1[i] = 0.f; }
#pragma unroll
    for (int s = 0; s < 8; ++s) { const bf16x8 A0 = *(const LAS bf16x8*)(U + r * 272 + (16 * s + 8 * h) * 2), A1 = *(const LAS bf16x8*)(U + (32 + r) * 272 + (16 * s + 8 * h) * 2);
        x0 = MFMA32(A0, T1[s], x0); x1 = MFMA32(A1, T1[s], x1); }
    { const int k2 = (32 * wave + r) & 127, ri2 = wave >> 2;
#pragma unroll
      for (int qq = 0; qq < 4; ++qq) {
          *(LAS v2u*)(XT + k2 * 272 + (ri2 * 64 + 8 * qq + 4 * h) * 2) = (v2u){cvtpk(x0[4 * qq], x0[4 * qq + 1]), cvtpk(x0[4 * qq + 2], x0[4 * qq + 3])};
          *(LAS v2u*)(XT + k2 * 272 + (ri2 * 64 + 32 + 8 * qq + 4 * h) * 2) = (v2u){cvtpk(x1[4 * qq], x1[4 * qq + 1]), cvtpk(x1[4 * qq + 2], x1[4 * qq + 3])}; } }
    __syncthreads();
    const int ct = wave & 3, rt = wave >> 2;
    f32x16 zr, zi;
#pragma unroll
    for (int i = 0; i < 16; ++i) { zr[i] = 0.f; zi[i] = 0.f; }
#pragma unroll
    for (int s = 0; s < 8; ++s) { const bf16x8 B = *(const LAS bf16x8*)(XT + (32 * ct + r) * 272 + (16 * s + 8 * h) * 2);
        const bf16x8 Ar = *(const LAS bf16x8*)(M64 + (32 * rt + r) * 272 + (16 * s + 8 * h) * 2), Ai = *(const LAS bf16x8*)(M64 + (64 + 32 * rt + r) * 272 + (16 * s + 8 * h) * 2);
        zr = MFMA32(Ar, B, zr); zi = MFMA32(Ai, B, zi); }
    bf16* zo = ZB + ((size_t)((b * 4 + g) * 64) * 64 + bcol) * 256 + 32 * ct + r;
#pragma unroll
    for (int i = 0; i < 16; ++i) { const int c = 32 * rt + crow32(i, h); const float f = (float)((bcol * c) & 4095) * (1.0f / 4096.0f), cs = cosrev(f), sn = sinrev(f);
        const float vr = zr[i] * cs + zi[i] * sn, vi = zi[i] * cs - zr[i] * sn;
        bf16* p = zo + (size_t)c * 64 * 256; const unsigned z2 = cvtpk(vr, vi); p[0] = (bf16)(z2 & 0xffffu); p[128] = (bf16)(z2 >> 16); }
}
__device__ __forceinline__ void four_b_setup(const Wg& w, bf16x8 (&M2)[8]) {
    const int lane = w.lane, wave = w.wave, r = lane & 31, h = lane >> 5, d = 32 * (wave >> 2) + r;
#pragma unroll
    for (int s = 0; s < 8; ++s) { unsigned pk[4];
#pragma unroll
        for (int j = 0; j < 4; ++j) { const int bc = (16 * s + 8 * h + 2 * j) >> 1; const float f = (float)((bc * d) & 63) * (1.0f / 64.0f); pk[j] = cvtpk(cosrev(f), sinrev(f)); }
        M2[s] = __builtin_bit_cast(bf16x8, (v4u){pk[0], pk[1], pk[2], pk[3]}); }
}
constexpr int FB_N = 4;
__device__ __forceinline__ void four_b_item(const Args& a, const Wg& w, const bf16x8 (&M2)[8], const int item) {
    const int tid = w.tid, lane = w.lane, wave = w.wave, r = lane & 31, h = lane >> 5, dt = wave >> 2, ct = wave & 3;
    const bf16* ZB = WS_PTR(bf16, WS_ZBUF); bf16* MIX = WS_PTR(bf16, WS_MIX);
    const float scale = 1.0f / sqrtf(4096.0f * 128.0f);
    const int b = item >> 6, g = (item >> 4) & 3, c0 = (item & 15) * FB_N;
    const bf16* zt = ZB + (size_t)((b * 4 + g) * 64 + c0) * 64 * 256;
    v4u v[FB_N][4];
#pragma unroll
    for (int t = 0; t < FB_N; ++t)
#pragma unroll
        for (int i = 0; i < 4; ++i) v[t][i] = *(const v4u*)(zt + (size_t)t * 64 * 256 + (size_t)(tid + NTHR * i) * 8);
#pragma unroll
    for (int t = 0; t < FB_N; ++t) { LAS unsigned char* ZT = w.lds + t * 33792;
#pragma unroll
        for (int i = 0; i < 4; ++i) { const int id = tid + NTHR * i, row = id >> 4, ch = id & 15;
            *(LAS v2u*)(ZT + row * 264 + ch * 16) = (v2u){v[t][i].x, v[t][i].y}; *(LAS v2u*)(ZT + row * 264 + ch * 16 + 8) = (v2u){v[t][i].z, v[t][i].w}; } }
    __syncthreads();
#pragma unroll
    for (int t = 0; t < FB_N; ++t) { const LAS unsigned char* ZT = w.lds + t * 33792;
        f32x16 y;
#pragma unroll
        for (int i = 0; i < 16; ++i) y[i] = 0.f;
#pragma unroll
        for (int s = 0; s < 8; ++s) { unsigned pk[4];
#pragma unroll
            for (int j = 0; j < 4; ++j) { const LAS unsigned char* p = ZT + (16 * s + 8 * h + 2 * j) * 264 + (32 * ct + r) * 2;
                pk[j] = (unsigned)*(const LAS bf16*)p | ((unsigned)*(const LAS bf16*)(p + 264) << 16); }
            y = MFMA32(M2[s], __builtin_bit_cast(bf16x8, (v4u){pk[0], pk[1], pk[2], pk[3]}), y); }
        bf16* mo = MIX + (size_t)(b * SEQ + c0 + t) * D + g * 128 + 32 * ct + r;
#pragma unroll
        for (int i = 0; i < 16; ++i) { const int d = 32 * dt + crow32(i, h); mo[(size_t)d * 64 * D] = bf1(y[i] * scale); } }
}
__device__ __forceinline__ void ph_mix_a(const Args& a, const Wg& w, const int l, const int rep = 0, const int mask = 7) {
    unsigned* ctr = (unsigned*)(a.ws + WS_CTL) + CW_Q + 64 * (2 * l) + 256 * rep;
    volatile LAS int* slot = (volatile LAS int*)(w.lds + GL_SLOT);
    const int nc1 = (l == 0) ? NC * 4 / 64 : 0;
    int par = 0; int item = wq_next(ctr, slot + 2, w.tid);
    if (item < nc1) {
        bf16x8 T1[8]; four_t1_setup(w, T1);
        while (item < nc1) { const int c = wq_claim(ctr, w.tid); if (mask & 4) ctx_dft1_item(a, w, T1, item); item = wq_take(slot, par, c, w.tid); }
    }
    while (item < nc1 + NG1) { const int c = wq_claim(ctr, w.tid); if (mask & 1) gla_g1_job(a, w, l, item - nc1, rep ? REP_VAR : 0); item = wq_take(slot, par, c, w.tid); }
    if (item < nc1 + NG1 + 2048) {
        bf16x8 T1[8]; four_a_setup(w, T1);
        while (item < nc1 + NG1 + 2048) { const int c = wq_claim(ctr, w.tid); if (mask & 2) four_a_item(a, w, T1, item - nc1 - NG1); item = wq_take(slot, par, c, w.tid); }
    }
}
__device__ __forceinline__ void ph_mix_c(const Args& a, const Wg& w, const int l, const int rep = 0, const int mask = 7) {
    unsigned* ctr = (unsigned*)(a.ws + WS_CTL) + CW_Q + 64 * (2 * l + 1) + 256 * rep;
    volatile LAS int* slot = (volatile LAS int*)(w.lds + GL_SLOT);
    const int ng3 = (l == 0) ? 544 : 512, nctx = (l == 0) ? 128 : 0;
    int par = 0; int item = wq_next(ctr, slot + 2, w.tid);
    if (item < nctx) {
        while (item < nctx) { const int c = wq_claim(ctr, w.tid); if (mask & 4) ctx_dft2_item(a, w, item); item = wq_take(slot, par, c, w.tid); }
    }
    while (item < nctx + ng3) {
        const int it = item - nctx, job = (l == 0) ? it : ((it >> 4) * 17 + (it & 15) + 1);
        const int c = wq_claim(ctr, w.tid); if (mask & 1) gla_g3_job(a, w, l, job, rep ? REP_VAR : 0); item = wq_take(slot, par, c, w.tid); }
    if (item < nctx + ng3 + 2048 / FB_N) {
        bf16x8 M2[8]; four_b_setup(w, M2);
        while (item < nctx + ng3 + 2048 / FB_N) { const int c = wq_claim(ctr, w.tid); __syncthreads(); if (mask & 2) four_b_item(a, w, M2, item - nctx - ng3); item = wq_take(slot, par, c, w.tid); }
    }
}
constexpr int CONV_WAVE_ITEMS = 16 * (16 * 112) + 8 * (56 * 32), CONV_ITEMS = CONV_WAVE_ITEMS / 8;
static_assert(CONV_WAVE_ITEMS % 8 == 0, "conversion items");
__device__ __forceinline__ void conv_items(const Args& a, const Wg& w, const int max_items) {
    const float* moe_w1 = a.in[19]; const float* moe_w3 = a.in[20]; const float* moe_w2 = a.in[21];
    unsigned char* MW13 = WS_PTR(unsigned char, WS_MW13); unsigned char* MW2 = WS_PTR(unsigned char, WS_MW2);
    unsigned* ctr = (unsigned*)(a.ws + WS_CTL) + CW_CONVQ;
    volatile LAS int* slot = (volatile LAS int*)(w.lds + 72 * 1024);
    LAS float* scr = (LAS float*)(w.lds + 1024 + w.wave * 8448);
    constexpr int I_M13 = 16 * 112, I_M2 = 56 * 32;
    for (int n = 0; n < max_items; ++n) {
        const int item = wq_next(ctr, slot, w.tid);
        if (item >= CONV_ITEMS) break;
        int r = item * 8 + w.wave;
        if (r < 8 * I_M13) { const int e = r / I_M13; transpose_item8(moe_w1 + (size_t)e * D * EFF, D, EFF, MW13 + (size_t)e * 2 * EFF * D, 0, 1, FP8_SW, scr, r % I_M13, w.lane); continue; } r -= 8 * I_M13;
        if (r < 8 * I_M13) { const int e = r / I_M13; transpose_item8(moe_w3 + (size_t)e * D * EFF, D, EFF, MW13 + (size_t)e * 2 * EFF * D, 0, 2, FP8_SW, scr, r % I_M13, w.lane); continue; } r -= 8 * I_M13;
        { const int e = r / I_M2; transpose_item8(moe_w2 + (size_t)e * EFF * D, EFF, D, MW2 + (size_t)e * D * EFF, 0, 0, FP8_SW, scr, r % I_M2, w.lane); }
    }
    __syncthreads();
}
__device__ __forceinline__ void conv_in_tail(const Args& a, const Wg& w, const int nunits, const int quota) {
    const int mine = (nunits - w.bx + w.G - 1) / w.G, most = (nunits + w.G - 1) / w.G;
    if (mine < most) conv_items(a, w, quota);
}
__device__ __forceinline__ void ph_gout(const Args& a, const Wg& w, const int l) {
    const float* modl = WS_PTR(float, WS_MODV) + (size_t)l * 9 * MOD6;
    pg8::DenseOrder S; S.init(WS_PTR(bf16, WS_MIX), WS_PTR(bf16, WS_WOUT) + (size_t)l * D * D, l == 0 ? MT : NL, D, D, w.G, w.bx);
    pg8::EpiRes E{l == 0 ? a.in[0] : nullptr, l == 0 ? a.in[2] : nullptr, WS_PTR(bf16, WS_XRES), modl + 2 * D, 1.0f};
    pg8::gemm_phase<pg8::EpiRes, pg8::DenseOrder, true, false>(w.lds, D, S, E);
    if (l == 0) conv_in_tail(a, w, (MT / 256) * (D / 256), CONV_Q_GOUT);
}
__device__ __forceinline__ void ph_fup(const Args& a, const Wg& w) {
    constexpr int KA = (FP8_FUP || I8_FUP) ? D / 2 : D;
    pg8::DenseOrder S; S.init(WS_PTR(bf16, WS_HBUF), WS_PTR(bf16, WS_W13), MT, 2 * DFF, KA, w.G, w.bx);
    constexpr float inv = FP8_FUP ? 1.0f / (FP8_SH * FP8_SW) : 1.0f;
    if constexpr (I8_FUP) { static_assert(FP8_FDN, "the int8 up GEMM writes an fp8 hidden");
        pg8::EpiSwiGLU8i E{WS_PTR(unsigned char, WS_HID), DFF, WS_PTR(float, WS_RS), WS_PTR(float, WS_WCS) + WCS_W1, WS_PTR(float, WS_WCS) + WCS_W3, FP8_SHID}; pg8::gemm_phase<pg8::EpiSwiGLU8i, pg8::DenseOrder, true, false, 2>(w.lds, KA, S, E); }
    else if constexpr (FP8_FDN) { pg8::EpiSwiGLU8 E{WS_PTR(unsigned char, WS_HID), DFF, inv, FP8_SHID, 0}; pg8::gemm_phase<pg8::EpiSwiGLU8, pg8::DenseOrder, true, false, FP8_FUP ? 1 : 0>(w.lds, KA, S, E); }
    else { pg8::EpiSwiGLU E{WS_PTR(bf16, WS_HID), DFF, inv}; pg8::gemm_phase<pg8::EpiSwiGLU, pg8::DenseOrder, true, false, FP8_FUP ? 1 : 0>(w.lds, KA, S, E); }
    conv_in_tail(a, w, (MT / 256) * (2 * DFF / 256), CONV_Q_FUP);
}
__device__ __forceinline__ void ph_fdn(const Args& a, const Wg& w) {
    const float* modl = WS_PTR(float, WS_MODV);
    constexpr int KA = FP8_FDN ? DFF / 2 : DFF;
    pg8::DenseOrder S; S.init(WS_PTR(bf16, WS_HID), WS_PTR(bf16, WS_W2), MT, D, KA, w.G, w.bx); pg8::EpiRes E{nullptr, nullptr, WS_PTR(bf16, WS_XRES), modl + 5 * D, FP8_FDN ? 1.0f / (FP8_SHID * FP8_SW) : 1.0f};
    pg8::gemm_phase<pg8::EpiRes, pg8::DenseOrder, true, false, FP8_FDN ? 1 : 0>(w.lds, KA, S, E);
    conv_in_tail(a, w, (MT / 256) * (D / 256), CONV_Q_FDN);
}
__device__ __forceinline__ void ph_route(const Args& a, const Wg& w) {
    if (w.bx >= 128) return;
    const int tid = w.tid, lane = w.lane, wave = w.wave;
    const int* TOKE = WS_PTR(int, WS_ROUTE + RT_TOKE); const float* TOKG = WS_PTR(float, WS_ROUTE + RT_TOKG);
    int* RIDX = WS_PTR(int, WS_ROUTE + RT_RIDX); float* RGATE = WS_PTR(float, WS_ROUTE + RT_RGATE); int* TEXP = WS_PTR(int, WS_ROUTE + RT_TEXP); int* NTL = WS_PTR(int, WS_ROUTE + RT_NT);
    const int s = w.bx >> 6, e = (w.bx >> 3) & 7, seg = w.bx & 7;
    LAS int* cnt = (LAS int*)w.lds;
    LAS int* wtot = (LAS int*)(w.lds + 64);
    if (tid < 9) cnt[tid] = 0;
    __syncthreads();
    int lc[9];
#pragma unroll
    for (int q = 0; q < 9; ++q) lc[q] = 0;
    for (int t = 4 * tid; t < NL; t += 4 * NTHR) { const int4 te = *(const int4*)(TOKE + s * NL + t); const int bef = t < seg * 4096;
#pragma unroll
        for (int q = 0; q < 8; ++q) lc[q] += (te.x == q) + (te.y == q) + (te.z == q) + (te.w == q);
        lc[8] += bef ? (te.x == e) + (te.y == e) + (te.z == e) + (te.w == e) : 0; }
#pragma unroll
    for (int q = 0; q < 9; ++q) { int v = lc[q];
#pragma unroll
        for (int o = 1; o < 64; o <<= 1) v += __shfl_xor(v, o);
        if (lane == 0) atomicAdd((int*)&cnt[q], v); }
    __syncthreads();
    int base = 0, total = 0, mycnt = 0;
    for (int q = 0; q < 8; ++q) { const int cq = cnt[q], tq = (cq + 255) >> 8; if (q < e) base += tq * 256; if (q == e) mycnt = cq; total += tq; }
    int running = cnt[8];
    for (int t0 = seg * 4096; t0 < seg * 4096 + 4096; t0 += 4 * NTHR) {
        const int t = t0 + 4 * tid; const int4 te = *(const int4*)(TOKE + s * NL + t);
        const int f0 = te.x == e, f1 = te.y == e, f2 = te.z == e, f3 = te.w == e, mine = f0 + f1 + f2 + f3;
        int incl = mine;
#pragma unroll
        for (int o = 1; o < 64; o <<= 1) { const int v = __shfl_up(incl, o); if (lane >= o) incl += v; }
        const int wt = __shfl(incl, 63);
        __syncthreads();
        if (lane == 0) wtot[wave] = wt;
        __syncthreads();
        int woff = 0, ctot = 0;
#pragma unroll
        for (int q = 0; q < 8; ++q) { const int v = wtot[q]; if (q < wave) woff += v; ctot += v; }
        int pos = s * RT_TILES * 256 + base + running + woff + incl - mine;
        int* POS = WS_PTR(int, WS_ROUTE + RT_POS) + s * NL; const int pb = s * RT_TILES * 256;
        if (f0) { RIDX[pos] = t;     RGATE[pos] = TOKG[s * NL + t];     POS[t] = pos - pb;     ++pos; }
        if (f1) { RIDX[pos] = t + 1; RGATE[pos] = TOKG[s * NL + t + 1]; POS[t + 1] = pos - pb; ++pos; }
        if (f2) { RIDX[pos] = t + 2; RGATE[pos] = TOKG[s * NL + t + 2]; POS[t + 2] = pos - pb; ++pos; }
        if (f3) { RIDX[pos] = t + 3; RGATE[pos] = TOKG[s * NL + t + 3]; POS[t + 3] = pos - pb; ++pos; }
        running += ctot; }
    if (seg == 0) {
        const int padend = base + ((mycnt + 255) >> 8) * 256;
        for (int p = base + mycnt + tid; p < padend; p += NTHR) { RIDX[s * RT_TILES * 256 + p] = -1; RGATE[s * RT_TILES * 256 + p] = 0.f; }
        for (int tl = (base >> 8) + tid; tl < (padend >> 8); tl += NTHR) TEXP[s * RT_TILES + tl] = e;
        if (e == 0 && tid == 0) NTL[s * 64] = total;
    }
    __syncthreads();
}
__device__ __forceinline__ void ph_mup(const Args& a, const Wg& w, const int skip = 0) {
    const int nt0 = __builtin_amdgcn_readfirstlane(__hip_atomic_load(WS_PTR(int, WS_ROUTE + RT_NT), __ATOMIC_RELAXED, __HIP_MEMORY_SCOPE_AGENT));
    const int nt1 = __builtin_amdgcn_readfirstlane(__hip_atomic_load(WS_PTR(int, WS_ROUTE + RT_NT) + 64, __ATOMIC_RELAXED, __HIP_MEMORY_SCOPE_AGENT));
    pg8::MoeOrder S; S.oc.init(nt0 + nt1, 2 * EFF / 256, w.G, w.bx); S.A = (const char*)WS_PTR(bf16, WS_HBUF); S.Bt = (const char*)WS_PTR(bf16, WS_MW13); S.tstepA = 0; S.tstepB = (size_t)256 * D; S.estride = (size_t)2 * EFF * D;
    S.texp = WS_PTR(int, WS_ROUTE + RT_TEXP); S.ridx = WS_PTR(int, WS_ROUTE + RT_RIDX); S.nt0 = nt0; S.gap = RT_TILES - nt0;
    pg8::EpiSwiGLU8 E{WS_PTR(unsigned char, WS_HID2), EFF, 1.0f / (FP8_SH * FP8_SW), FP8_SHID, skip};
    pg8::gemm_phase<pg8::EpiSwiGLU8, pg8::MoeOrder, true, true, 1>(w.lds, D / 2, S, E);
}
__device__ __forceinline__ void ph_mdn(const Args& a, const Wg& w, const int s) {
    const int ntl = __builtin_amdgcn_readfirstlane(__hip_atomic_load(WS_PTR(int, WS_ROUTE + RT_NT) + s * 64, __ATOMIC_RELAXED, __HIP_MEMORY_SCOPE_AGENT));
    const float* modl = WS_PTR(float, WS_MODV) + (size_t)9 * MOD6;
    pg8::MoeOrder S; S.oc.init(ntl, D / 256, w.G, w.bx); S.A = (const char*)WS_PTR(unsigned char, WS_HID2) + (size_t)s * RT_TILES * 256 * EFF; S.Bt = (const char*)WS_PTR(bf16, WS_MW2); S.tstepA = (size_t)256 * EFF; S.tstepB = (size_t)256 * EFF; S.estride = (size_t)D * EFF;
    S.texp = WS_PTR(int, WS_ROUTE + RT_TEXP) + s * RT_TILES; S.ridx = WS_PTR(int, WS_ROUTE + RT_RIDX) + s * RT_TILES * 256; S.nt0 = 1 << 30; S.gap = 0;
    pg8::EpiScatter E{WS_PTR(int, WS_ROUTE + RT_RIDX) + s * RT_TILES * 256, WS_PTR(float, WS_ROUTE + RT_RGATE) + s * RT_TILES * 256, WS_PTR(bf16, WS_XRES), modl + 5 * D, 1.0f / (FP8_SHID * FP8_SW)};
    pg8::gemm_phase<pg8::EpiScatter, pg8::MoeOrder, true, false, 1>(w.lds, EFF / 2, S, E);
}
__device__ __forceinline__ void ph_mdn2(const Args& a, const Wg& w) {
    const int nt0 = __builtin_amdgcn_readfirstlane(__hip_atomic_load(WS_PTR(int, WS_ROUTE + RT_NT), __ATOMIC_RELAXED, __HIP_MEMORY_SCOPE_AGENT));
    const int nt1 = __builtin_amdgcn_readfirstlane(__hip_atomic_load(WS_PTR(int, WS_ROUTE + RT_NT) + 64, __ATOMIC_RELAXED, __HIP_MEMORY_SCOPE_AGENT));
    pg8::MoeOrderRM S; S.nwg = (nt0 + nt1) * (D / 256); S.G = w.G; S.c = w.bx; S.A = (const char*)WS_PTR(unsigned char, WS_HID2); S.Bt = (const char*)WS_PTR(bf16, WS_MW2); S.tstepA = (size_t)256 * EFF; S.tstepB = (size_t)256 * EFF; S.estride = (size_t)D * EFF;
    S.texp = WS_PTR(int, WS_ROUTE + RT_TEXP); S.nt0 = nt0; S.gap = RT_TILES - nt0;
    pg8::EpiY E{WS_PTR(float, WS_ROUTE + RT_RGATE), WS_PTR(bf16, WS_Y0), WS_PTR(bf16, WS_HBUF), WS_PTR(bf16, WS_SLOC), 1.0f / (FP8_SHID * FP8_SW), RT_TILES, Y1_SPLIT};
    pg8::gemm_phase<pg8::EpiY, pg8::MoeOrderRM, true, false, 1>(w.lds, EFF / 2, S, E);
}
__device__ __forceinline__ void ph_final2(const Args& a, const Wg& w) {
    const int lane = w.lane; const float* fw = a.in[22]; const bf16* XRES = WS_PTR(bf16, WS_XRES); const bf16* Y0 = WS_PTR(bf16, WS_Y0);
    const bf16* Y1A = WS_PTR(bf16, WS_HBUF); const bf16* Y1B = WS_PTR(bf16, WS_SLOC) - (size_t)Y1_SPLIT * 256 * D;
    const int* POS = WS_PTR(int, WS_ROUTE + RT_POS); const float* gate = WS_PTR(float, WS_MODV) + (size_t)9 * MOD6 + 5 * D;
    f32x4 wv[4];
#pragma unroll
    for (int j = 0; j < 4; ++j) wv[j] = *(const f32x4*)(fw + 4 * lane + 256 * j);
    constexpr int TB = 2;
    int np0[TB], np1[TB];
    { const int m0 = w.gw * TB;
#pragma unroll
      for (int k = 0; k < TB; ++k) { np0[k] = m0 + k < NL ? POS[m0 + k] : 0; np1[k] = m0 + k < NL ? POS[NL + m0 + k] : 0; } }
    for (int m0 = w.gw * TB; m0 < NL; m0 += w.NGW * TB) {
        pg8::u32x2_t xr[TB][4], y0r[TB][4], y1r[TB][4];
#pragma unroll
        for (int k = 0; k < TB; ++k) { const int p0 = __builtin_amdgcn_readfirstlane(np0[k]), p1 = __builtin_amdgcn_readfirstlane(np1[k]);
            const bf16* y1p = (p1 < Y1_SPLIT * 256 ? Y1A : Y1B) + (size_t)p1 * D;
#pragma unroll
            for (int j = 0; j < 4; ++j) { const int c = 4 * lane + 256 * j; xr[k][j] = *(const pg8::u32x2_t*)(XRES + (size_t)(m0 + k) * D + c); y0r[k][j] = *(const pg8::u32x2_t*)(Y0 + (size_t)p0 * D + c); y1r[k][j] = *(const pg8::u32x2_t*)(y1p + c); } }
        { const int mn = m0 + w.NGW * TB;
#pragma unroll
          for (int k = 0; k < TB; ++k) { np0[k] = mn + k < NL ? POS[mn + k] : 0; np1[k] = mn + k < NL ? POS[NL + mn + k] : 0; } }
        const float* gp = gate + (m0 >> 12) * MOD6;
        f32x4 g[4];
#pragma unroll
        for (int j = 0; j < 4; ++j) g[j] = *(const f32x4*)(gp + 4 * lane + 256 * j);
#pragma unroll
        for (int k = 0; k < TB; ++k) {
            f32x4 v[4]; float ss = 0.f;
#pragma unroll
            for (int j = 0; j < 4; ++j) { v[j] = pg8::bf4_to_f32(xr[k][j]) + g[j] * (pg8::bf4_to_f32(y0r[k][j]) + pg8::bf4_to_f32(y1r[k][j])); ss += (v[j].x * v[j].x + v[j].y * v[j].y) + (v[j].z * v[j].z + v[j].w * v[j].w); }
            const float rstd = 1.0f / sqrtf(wave_sum(ss) * (1.0f / D) + EPS);
            float* xo = a.out + (size_t)(m0 + k) * D;
#pragma unroll
            for (int j = 0; j < 4; ++j) *(f32x4*)(xo + 4 * lane + 256 * j) = (v[j] * rstd) * wv[j]; }
    }
}
__device__ __forceinline__ void ph_final(const Args& a, const Wg& w) {
    const int lane = w.lane; const float* fw = a.in[22]; const bf16* XRES = WS_PTR(bf16, WS_XRES);
    for (int m = w.gw; m < NL; m += w.NGW) {
        float* xr = a.out + (size_t)m * D;
        f32x4 v[4]; float ss = 0.f;
#pragma unroll
        for (int j = 0; j < 4; ++j) { v[j] = pg8::bf4_to_f32(*(const pg8::u32x2_t*)(XRES + (size_t)m * D + 4 * lane + 256 * j)); ss += (v[j].x * v[j].x + v[j].y * v[j].y) + (v[j].z * v[j].z + v[j].w * v[j].w); }
        const float rstd = 1.0f / sqrtf(wave_sum(ss) * (1.0f / D) + EPS);
#pragma unroll
        for (int j = 0; j < 4; ++j) { const int c = 4 * lane + 256 * j; *(f32x4*)(xr + c) = (v[j] * rstd) * *(const f32x4*)(fw + c); }
    }
}

constexpr int NPH = 23;
__global__ void __launch_bounds__(NTHR, 2) fwd_kernel(Args args) {
    extern __shared__ __attribute__((aligned(16))) unsigned char lds_raw[];
    Wg w; w.lds = (LAS unsigned char*)lds_raw;
    volatile LAS unsigned* MISC = (volatile LAS unsigned*)(w.lds + MISC_OFF);
    w.wave = __builtin_amdgcn_readfirstlane((int)threadIdx.x >> 6); w.lane = (int)__builtin_amdgcn_mbcnt_hi(~0u, __builtin_amdgcn_mbcnt_lo(~0u, 0u)); w.tid = w.wave * 64 + w.lane;
    w.G = gridDim.x; w.bx = blockIdx.x; w.gw = w.bx * NWAVES + w.wave; w.NGW = w.G * NWAVES;
    unsigned* ctl = (unsigned*)(args.ws + WS_CTL);
    for (int u = w.tid; u < (LDS_BYTES - LDSCTL_OFF) / 4; u += NTHR) ((LAS unsigned*)(w.lds + LDSCTL_OFF))[u] = 0u;
    __syncthreads();
    XcdBarrier bar; bar.bar = ctl + CW_BAR; bar.x = 0; bar.st = nullptr;
    if (!MK_MULTI) bar = xcd_barrier_post(ctl + CW_BAR, MISC + 8);
    const int lo = args.ph_lo, hi = args.ph_hi;
#define PH(id, call) do { if (lo <= (id) && (id) < hi) { call; if (!MK_MULTI && (id) + 1 < hi) xcd_barrier(bar); } } while (0)
#define PHR(n, id, call) do { if ((n) > 1) { call; xcd_barrier(bar); } PH(id, call); } while (0)
    PHR(REP_PRO, 0, ph_prologue(args, w));
    PH(1, ph_modfin(args, w));
    PHR(REP_NORM, 2, (ph_norm(args, w, 0, 0), ph_quant(args, w)));
    PHR(REP_GIN, 3, ph_gin(args, w, 0));
    if (REP_MIXA > 1) { ph_mix_a(args, w, 0, 1, REP_MASK); xcd_barrier(bar); }
    PH(4, ph_mix_a(args, w, 0));
    PH(5, ph_gla_scan(args, w));
    if (REP_MIXC > 1) { ph_mix_c(args, w, 0, 1, REP_MASK); xcd_barrier(bar); }
    PH(6, ph_mix_c(args, w, 0));
    PHR(REP_GOUT, 7, ph_gout(args, w, 0));
    PHR(REP_NORM, 8, ph_norm(args, w, 0, 1));
    PHR(REP_FUP, 9, ph_fup(args, w));
    PH(10, ph_fdn(args, w));
    PHR(REP_NORM, 11, ph_norm(args, w, 1, 0));
    PHR(REP_GIN, 12, ph_gin(args, w, 1));
    if (REP_MIXA > 1) { ph_mix_a(args, w, 1, 1, REP_MASK); xcd_barrier(bar); }
    PH(13, ph_mix_a(args, w, 1));
    PH(14, ph_gla_scan(args, w));
    if (REP_MIXC > 1) { ph_mix_c(args, w, 1, 1, REP_MASK); xcd_barrier(bar); }
    PH(15, ph_mix_c(args, w, 1));
    PH(16, ph_gout(args, w, 1));
    PHR(REP_NORM, 17, ph_norm(args, w, 1, 1));
    PHR(REP_PRO, 18, (ph_route(args, w), conv_items(args, w, 1 << 30)));
    if (REP_MUP > 1) { ph_mup(args, w, REP_VAR); xcd_barrier(bar); } PH(19, ph_mup(args, w));
#if MDN_MERGE
    PH(20, ph_mdn2(args, w));
    PH(21, ph_final2(args, w));
#else
    PH(20, ph_mdn(args, w, 0));
    PH(21, ph_mdn(args, w, 1));
    PH(22, ph_final(args, w));
#endif
#undef PH
#undef PHR
}

extern "C" void kernel_launch(void* const* d_in, const int* in_sizes, int n_in, void* d_out, int out_size, void* d_ws, size_t ws_size, hipStream_t stream) {
    static int grid = 0;
    if (grid == 0) {
        if (n_in != 23 || out_size != NL * D || ws_size < WS_END) { fprintf(stderr, "kernel_launch: unexpected shapes (n_in %d, out %d, ws %zu < %zu); nothing launched\n", n_in, out_size, ws_size, (size_t)WS_END); grid = -1; return; }
        int dev = 0, cus = 0, per_cu = 0;
        if (hipGetDevice(&dev) != hipSuccess || hipDeviceGetAttribute(&cus, hipDeviceAttributeMultiprocessorCount, dev) != hipSuccess) { grid = -1; return; }
        if (hipFuncSetAttribute((const void*)fwd_kernel, hipFuncAttributeMaxDynamicSharedMemorySize, LDS_BYTES) != hipSuccess) { fprintf(stderr, "kernel_launch: hipFuncSetAttribute failed\n"); grid = -1; return; }
        if (hipOccupancyMaxActiveBlocksPerMultiprocessor(&per_cu, (const void*)fwd_kernel, NTHR, LDS_BYTES) != hipSuccess || per_cu < 1) { fprintf(stderr, "kernel_launch: occupancy query says %d blocks per CU\n", per_cu); }
        (void)hipGetLastError();
        grid = cus;
    }
    if (grid < 0) return;
    if (hipMemsetAsync((char*)d_ws + WS_CTL, 0, CTL_ZERO_BYTES, stream) != hipSuccess) { fprintf(stderr, "kernel_launch: memset failed\n"); return; }
    Args a{};
    for (int i = 0; i < 23; ++i) a.in[i] = (const float*)d_in[i];
    a.out = (float*)d_out; a.ws = (unsigned char*)d_ws; a.pad = 0;
#if MK_MULTI
    for (int p = 0; p < NPH; ++p) { a.ph_lo = p; a.ph_hi = p + 1; a.li = p; hipLaunchKernelGGL(fwd_kernel, dim3(grid), dim3(NTHR), LDS_BYTES, stream, a); }
#else
    a.ph_lo = 0; a.ph_hi = MDN_MERGE ? 22 : NPH; a.li = 0;
    hipLaunchKernelGGL(fwd_kernel, dim3(grid), dim3(NTHR), LDS_BYTES, stream, a);
#endif
    const hipError_t le = hipPeekAtLastError();
    if (le != hipSuccess) fprintf(stderr, "kernel_launch: launch failed: %s\n", hipGetErrorName(le));
}
```

```cpp
#include <hip/hip_runtime.h>
#include <cstdio>
#include <cstdint>

#ifndef CONV_Q_GIN
#define CONV_Q_GIN 4
#define CONV_Q_GOUT 8
#define CONV_Q_FUP 4
#define CONV_Q_FDN 7
#endif
#ifndef REP_GIN
#define REP_GIN 1
#endif
#ifndef REP_GOUT
#define REP_GOUT 1
#endif
#ifndef REP_FUP
#define REP_FUP 1
#endif
#ifndef REP_MUP
#define REP_MUP 1
#endif
#ifndef REP_GEMM
#define REP_GEMM 1
#endif
#ifndef REP_NORM
#define REP_NORM 1
#endif
#ifndef REP_MIXA
#define REP_MIXA 1
#endif
#ifndef REP_VAR
#define REP_VAR 0
#endif
#ifndef REP_MASK
#define REP_MASK 7
#endif
#ifndef REP_MIXC
#define REP_MIXC 1
#endif
#ifndef REP_PRO
#define REP_PRO 1
#endif
#ifndef I8_GIN
#define I8_GIN 1
#endif
#ifndef I8_FUP
#define I8_FUP 1
#endif
#ifndef FP8_FUP
#define FP8_FUP 0
#endif
#ifndef FP8_FDN
#define FP8_FDN 1
#endif
#ifndef MK_MULTI
#define MK_MULTI 0
#endif

constexpr int D = 1024, NB = 8, SEQ = 4096, CTXL = 256;
constexpr int NL = NB * SEQ;
constexpr int NC = NB * CTXL;
constexpr int MT = NL + NC;
constexpr int INW = 2080, INP = 2304;
constexpr int DFF = 2816, EFF = 3584, NE = 8;
constexpr int MOD6 = 6 * D;
constexpr float EPS = 1e-6f;
constexpr float FP8_SH = 16.0f, FP8_SW = 512.0f, FP8_SHID = 8.0f;
constexpr int PC_U = 0, PC_Q = 512, PC_K = 768, PC_V = 1024, PC_G = 1536, PC_LF = 2048, PC_LB = 2064;

namespace pg8 {
#define PG8_LAS __attribute__((address_space(3)))
typedef unsigned short bf16_t;
typedef short bf16x8 __attribute__((ext_vector_type(8)));
typedef float f32x4 __attribute__((ext_vector_type(4)));
typedef unsigned u32x4 __attribute__((ext_vector_type(4)));
constexpr int BM = 256, BK = 64, HALF = 128, HTB = HALF * BK * 2, STAGE_BYTES = 8 * HTB, NXCD = 8, WGM = 8;

__host__ __device__ __forceinline__ int lds_byte(int r, int c) { const int st = (r >> 4) * 2 + (c >> 5), rr = r & 15, cc = c & 31, ob = rr * 64 + cc * 2; return st * 1024 + (ob ^ (((ob >> 9) & 1) << 5)); }
__host__ __device__ __forceinline__ void stage_rc(int b, int& R, int& C) { const int st = b / 1024, sb = b % 1024, swz = sb ^ (((sb >> 9) & 1) << 5); R = (st >> 1) * 16 + swz / 64; C = (st & 1) * 32 + (swz % 64) / 2; }
__host__ __device__ __forceinline__ int perm32(int rho) { const int n = rho >> 4, i = rho & 15; return 8 * (i >> 2) + 4 * n + (i & 3); }

struct Unit { int pm, pn; const char* a; const char* b; const int* ridx; };

__device__ __forceinline__ const char* uptr(const char* p) { const unsigned long long v = (unsigned long long)p; const unsigned lo = __builtin_amdgcn_readfirstlane((unsigned)v), hi = __builtin_amdgcn_readfirstlane((unsigned)(v >> 32)); return (const char*)(((unsigned long long)hi << 32) | lo); }
__device__ __forceinline__ void glds_s(const char* base, unsigned voff, unsigned lds_dst) { unsigned keep;
    asm volatile("s_mov_b32 %0, m0\n\ts_mov_b32 m0, %3\n\ts_nop 0\n\tglobal_load_lds_dwordx4 %1, %2\n\ts_mov_b32 m0, %0" : "=&s"(keep) : "v"(voff), "s"((unsigned long long)base), "s"(lds_dst) : "memory"); }
struct OrderCore {
    int nM, nN, nwg, G, c;
    __device__ __forceinline__ void init(int nM_, int nN_, int G_, int c_) { nM = nM_; nN = nN_; nwg = nM * nN; G = G_; c = c_; }
    __device__ __forceinline__ bool tile(int i, int& pm, int& pn) const {
        const long L = (long)i * G + c; if (L >= nwg) return false;
        int wgid = (int)L; { const int q = nwg / NXCD, r = nwg % NXCD, xcd = wgid % NXCD, off = wgid / NXCD; wgid = (xcd < r ? xcd * (q + 1) : r * (q + 1) + (xcd - r) * q) + off; }
        const int nig = WGM * nN, gid = wgid / nig, fm = gid * WGM, gsz = (nM - fm) < WGM ? (nM - fm) : WGM;
        pm = fm + ((wgid % nig) % gsz); pn = (wgid % nig) / gsz; return true;
    }
};
struct DenseOrder {
    OrderCore oc; const char* A; const char* Bt; size_t tstep;
    __device__ __forceinline__ void init(const bf16_t* A_, const bf16_t* Bt_, int M, int N, int K, int G, int c) { oc.init(M / BM, N / BM, G, c); A = (const char*)A_; Bt = (const char*)Bt_; tstep = (size_t)BM * K * 2; }
    __device__ __forceinline__ bool next(int i, Unit& u) const { if (!oc.tile(i, u.pm, u.pn)) return false; u.pm = __builtin_amdgcn_readfirstlane(u.pm); u.pn = __builtin_amdgcn_readfirstlane(u.pn); u.a = uptr(A + (size_t)u.pm * tstep); u.b = uptr(Bt + (size_t)u.pn * tstep); u.ridx = nullptr; return true; }
};
struct MoeOrder {
    OrderCore oc; const char* A; const char* Bt; size_t tstepA, tstepB, estride; const int* texp; const int* ridx; int nt0, gap;
    __device__ __forceinline__ bool next(int i, Unit& u) const { if (!oc.tile(i, u.pm, u.pn)) return false;
        u.pm = u.pm < nt0 ? u.pm : u.pm + gap;
        const int e = __builtin_amdgcn_readfirstlane(__hip_atomic_load(texp + u.pm, __ATOMIC_RELAXED, __HIP_MEMORY_SCOPE_AGENT));
        u.pm = __builtin_amdgcn_readfirstlane(u.pm); u.pn = __builtin_amdgcn_readfirstlane(u.pn); u.a = uptr(A + (size_t)u.pm * tstepA); u.b = uptr(Bt + (size_t)e * estride + (size_t)u.pn * tstepB); u.ridx = (const int*)uptr((const char*)(ridx + u.pm * BM)); return true; }
};

typedef int v4i_t __attribute__((ext_vector_type(4)));
typedef int v8i_t __attribute__((ext_vector_type(8)));
__device__ __forceinline__ v8i_t cat8(const bf16x8 lo, const bf16x8 hi) { const v4i_t a = __builtin_bit_cast(v4i_t, lo), b = __builtin_bit_cast(v4i_t, hi); return __builtin_shufflevector(a, b, 0, 1, 2, 3, 4, 5, 6, 7); }
__device__ __forceinline__ void mfma8(f32x4& acc, const v8i_t a, const v8i_t b, const int sc) {
    asm volatile("v_mfma_scale_f32_16x16x128_f8f6f4 %0, %1, %2, %0, %3, %3 op_sel_hi:[0,0,0]" : "+v"(acc) : "v"(a), "v"(b), "v"(sc)); }
__device__ __forceinline__ unsigned pk4_fp8_raw(float a, float b, float c, float d) { int r = __builtin_amdgcn_cvt_pk_fp8_f32(a, b, 0, false); r = __builtin_amdgcn_cvt_pk_fp8_f32(c, d, r, true); return (unsigned)r; }
__device__ __forceinline__ unsigned pk4_fp8(float a, float b, float c, float d) { return pk4_fp8_raw(__builtin_amdgcn_fmed3f(a, -448.f, 448.f), __builtin_amdgcn_fmed3f(b, -448.f, 448.f), __builtin_amdgcn_fmed3f(c, -448.f, 448.f), __builtin_amdgcn_fmed3f(d, -448.f, 448.f)); }
__device__ __forceinline__ float clamp448(float v) { return __builtin_fminf(__builtin_fmaxf(v, -448.0f), 448.0f); }
__device__ __forceinline__ unsigned cvt_pk_bf16(float lo, float hi) { unsigned r; asm volatile("v_cvt_pk_bf16_f32 %0, %1, %2" : "=v"(r) : "v"(lo), "v"(hi)); return r; }

struct EpiBf16 {
    static constexpr bool PERM = true;
    bf16_t* O; int ldc;
    __device__ __forceinline__ void operator()(const f32x4 (&acc)[2][2][4][2], const Unit& u, int wr, int wc, int fr, int fq) const {
        const int row0 = u.pm * BM + wr * 64 + fr, col0 = u.pn * BM + wc * 32 + 8 * fq;
#pragma unroll
        for (int ai = 0; ai < 2; ++ai)
#pragma unroll
            for (int m = 0; m < 4; ++m) { bf16_t* rowp = O + (size_t)(row0 + ai * HALF + m * 16) * ldc + col0;
#pragma unroll
                for (int bj = 0; bj < 2; ++bj) { const f32x4 v0 = acc[ai][bj][m][0], v1 = acc[ai][bj][m][1];
                    u32x4 w; w.x = cvt_pk_bf16(v0[0], v0[1]); w.y = cvt_pk_bf16(v0[2], v0[3]); w.z = cvt_pk_bf16(v1[0], v1[1]); w.w = cvt_pk_bf16(v1[2], v1[3]);
                    *(u32x4*)(rowp + bj * HALF) = w; } }
    }
};
__device__ __forceinline__ float silu_f(float a) { return a * __builtin_amdgcn_rcpf(1.0f + __builtin_amdgcn_exp2f(a * -1.4426950408889634f)); }
struct EpiSwiGLU {
    static constexpr bool PERM = true;
    bf16_t* O; int ldc; float inv;
    __device__ __forceinline__ void operator()(const f32x4 (&acc)[2][2][4][2], const Unit& u, int wr, int wc, int fr, int fq) const {
        const int row0 = u.pm * BM + wr * 64 + fr, col0 = u.pn * HALF + wc * 32 + 8 * fq;
#pragma unroll
        for (int ai = 0; ai < 2; ++ai)
#pragma unroll
            for (int m = 0; m < 4; ++m) { bf16_t* rowp = O + (size_t)(row0 + ai * HALF + m * 16) * ldc + col0;
                float h[8]; typedef float f2 __attribute__((ext_vector_type(2)));
                const float kexp = inv * -1.4426950408889634f, c0 = 1.0f / (inv * inv), lc0 = __builtin_log2f(c0);
#pragma unroll
                for (int n = 0; n < 2; ++n)
#pragma unroll
                    for (int j = 0; j < 4; j += 2) { const f2 a1 = {acc[ai][0][m][n][j], acc[ai][0][m][n][j + 1]}, a3 = {acc[ai][1][m][n][j], acc[ai][1][m][n][j + 1]};
                        const f2 t = a1 * kexp + lc0; f2 d; d.x = __builtin_amdgcn_exp2f(t.x); d.y = __builtin_amdgcn_exp2f(t.y); d = d + c0;
                        f2 rr; rr.x = __builtin_amdgcn_rcpf(d.x); rr.y = __builtin_amdgcn_rcpf(d.y); const f2 hv = (a1 * a3) * rr; h[4 * n + j] = hv.x; h[4 * n + j + 1] = hv.y; }
                u32x4 w; w.x = cvt_pk_bf16(h[0], h[1]); w.y = cvt_pk_bf16(h[2], h[3]); w.z = cvt_pk_bf16(h[4], h[5]); w.w = cvt_pk_bf16(h[6], h[7]);
                *(u32x4*)rowp = w; }
    }
};
struct EpiSwiGLU8 {
    static constexpr bool PERM = true;
    unsigned char* O; int ldc; float inv, oscale; int skip;
    __device__ __forceinline__ void operator()(const f32x4 (&acc)[2][2][4][2], const Unit& u, int wr, int wc, int fr, int fq) const {
        if (skip) return;
        const int row0 = u.pm * BM + wr * 64 + fr, col0 = u.pn * HALF + wc * 32 + 8 * fq;
        const float kexp = inv * -1.4426950408889634f, c0 = 1.0f / (inv * inv * oscale), lc0 = __builtin_log2f(c0);
        typedef unsigned u32x2 __attribute__((ext_vector_type(2))); typedef float f2 __attribute__((ext_vector_type(2)));
#pragma unroll
        for (int ai = 0; ai < 2; ++ai)
#pragma unroll
            for (int m = 0; m < 4; ++m) { unsigned char* rowp = O + (size_t)(row0 + ai * HALF + m * 16) * ldc + col0;
                float h[8];
#pragma unroll
                for (int n = 0; n < 2; ++n)
#pragma unroll
                    for (int j = 0; j < 4; j += 2) { const f2 a1 = {acc[ai][0][m][n][j], acc[ai][0][m][n][j + 1]}, a3 = {acc[ai][1][m][n][j], acc[ai][1][m][n][j + 1]};
                        const f2 t = a1 * kexp + lc0; f2 d; d.x = __builtin_amdgcn_exp2f(t.x); d.y = __builtin_amdgcn_exp2f(t.y); d = d + c0;
                        f2 rr; rr.x = __builtin_amdgcn_rcpf(d.x); rr.y = __builtin_amdgcn_rcpf(d.y); const f2 hv = (a1 * a3) * rr;
                        h[4 * n + j] = __builtin_amdgcn_fmed3f(hv.x, -448.0f, 448.0f); h[4 * n + j + 1] = __builtin_amdgcn_fmed3f(hv.y, -448.0f, 448.0f); }
                *(u32x2*)rowp = (u32x2){pk4_fp8_raw(h[0], h[1], h[2], h[3]), pk4_fp8_raw(h[4], h[5], h[6], h[7])}; }
    }
};
typedef unsigned u32x2_t __attribute__((ext_vector_type(2)));
__device__ __forceinline__ f32x4 bf4_to_f32(const u32x2_t v) { f32x4 r; r.x = __uint_as_float(v.x << 16); r.y = __uint_as_float(v.x & 0xffff0000u); r.z = __uint_as_float(v.y << 16); r.w = __uint_as_float(v.y & 0xffff0000u); return r; }
__device__ __forceinline__ u32x2_t f32_to_bf4(const f32x4 v) { return (u32x2_t){cvt_pk_bf16(v.x, v.y), cvt_pk_bf16(v.z, v.w)}; }
struct EpiBf16i {
    static constexpr bool PERM = true;
    bf16_t* O; int ldc; const float* rowstep; const float* colstep;
    __device__ __forceinline__ void operator()(const f32x4 (&acc)[2][2][4][2], const Unit& u, int wr, int wc, int fr, int fq) const {
        const int row0 = u.pm * BM + wr * 64 + fr, col0 = u.pn * BM + wc * 32 + 8 * fq;
        f32x4 cs[2][2];
#pragma unroll
        for (int bj = 0; bj < 2; ++bj)
#pragma unroll
            for (int n = 0; n < 2; ++n) cs[bj][n] = *(const f32x4*)(colstep + col0 + bj * HALF + 4 * n);
#pragma unroll
        for (int ai = 0; ai < 2; ++ai)
#pragma unroll
            for (int m = 0; m < 4; ++m) { const int row = row0 + ai * HALF + m * 16; bf16_t* rowp = O + (size_t)row * ldc + col0; const float rs = rowstep[row];
#pragma unroll
                for (int bj = 0; bj < 2; ++bj) { float v[8];
#pragma unroll
                    for (int n = 0; n < 2; ++n)
#pragma unroll
                        for (int j = 0; j < 4; ++j) { const float x = acc[ai][bj][m][n][j]; v[4 * n + j] = (float)__float_as_int(x) * (rs * cs[bj][n][j]); }
                    u32x4 w; w.x = cvt_pk_bf16(v[0], v[1]); w.y = cvt_pk_bf16(v[2], v[3]); w.z = cvt_pk_bf16(v[4], v[5]); w.w = cvt_pk_bf16(v[6], v[7]);
                    *(u32x4*)(rowp + bj * HALF) = w; } }
    }
};
struct EpiSwiGLU8i {
    static constexpr bool PERM = true;
    unsigned char* O; int ldc; const float* rowstep; const float* step1; const float* step3; float oscale;
    __device__ __forceinline__ void operator()(const f32x4 (&acc)[2][2][4][2], const Unit& u, int wr, int wc, int fr, int fq) const {
        const int row0 = u.pm * BM + wr * 64 + fr, col0 = u.pn * HALF + wc * 32 + 8 * fq;
        typedef unsigned u32x2 __attribute__((ext_vector_type(2))); typedef float f2 __attribute__((ext_vector_type(2)));
        f32x4 c1[2], c3[2];
#pragma unroll
        for (int n = 0; n < 2; ++n) { c1[n] = *(const f32x4*)(step1 + col0 + 4 * n) * -1.4426950408889634f; c3[n] = *(const f32x4*)(step3 + col0 + 4 * n) * (oscale * -0.6931471805599453f); }
#pragma unroll
        for (int ai = 0; ai < 2; ++ai)
#pragma unroll
            for (int m = 0; m < 4; ++m) { const int row = row0 + ai * HALF + m * 16; unsigned char* rowp = O + (size_t)row * ldc + col0; const float rs = rowstep[row];
                float h[8];
#pragma unroll
                for (int n = 0; n < 2; ++n)
#pragma unroll
                    for (int j = 0; j < 4; j += 2) { const float x0 = acc[ai][0][m][n][j], x1 = acc[ai][0][m][n][j + 1], y0 = acc[ai][1][m][n][j], y1 = acc[ai][1][m][n][j + 1];
                        const f2 t = (f2){(float)__float_as_int(x0), (float)__float_as_int(x1)} * ((f2){c1[n][j], c1[n][j + 1]} * rs);
                        const f2 b = (f2){(float)__float_as_int(y0), (float)__float_as_int(y1)} * ((f2){c3[n][j], c3[n][j + 1]} * rs);
                        f2 d; d.x = __builtin_amdgcn_exp2f(t.x); d.y = __builtin_amdgcn_exp2f(t.y); d = d + 1.0f;
                        f2 rr; rr.x = __builtin_amdgcn_rcpf(d.x); rr.y = __builtin_amdgcn_rcpf(d.y); const f2 hv = (t * b) * rr;
                        h[4 * n + j] = __builtin_amdgcn_fmed3f(hv.x, -448.0f, 448.0f); h[4 * n + j + 1] = __builtin_amdgcn_fmed3f(hv.y, -448.0f, 448.0f); }
                *(u32x2*)rowp = (u32x2){pk4_fp8_raw(h[0], h[1], h[2], h[3]), pk4_fp8_raw(h[4], h[5], h[6], h[7])}; }
    }
};
struct EpiRes {
    static constexpr bool PERM = true;
    const float* srcL; const float* srcC; bf16_t* xres; const float* gate; float oscale;
    __device__ __forceinline__ void operator()(const f32x4 (&acc)[2][2][4][2], const Unit& u, int wr, int wc, int fr, int fq) const {
        const int pm = u.pm; const bool isc = pm >= 128; const int bidx = isc ? 8 : (pm >> 4);
        const float* s = srcL ? (isc ? srcC + (size_t)(pm - 128) * BM * D : srcL + (size_t)pm * BM * D) : nullptr;
        bf16_t* d = xres + (size_t)pm * BM * D;
        const int col0 = u.pn * BM + wc * 32 + 8 * fq; const float* gv = gate + bidx * MOD6 + col0;
        f32x4 g[2][2];
#pragma unroll
        for (int bj = 0; bj < 2; ++bj)
#pragma unroll
            for (int n = 0; n < 2; ++n) g[bj][n] = *(const f32x4*)(gv + bj * HALF + 4 * n) * oscale;
        if (s) {
#pragma unroll
            for (int am = 0; am < 4; ++am) { const int ai = am >> 1, m0 = (am & 1) * 2; f32x4 x[2][2][2];
#pragma unroll
                for (int mm = 0; mm < 2; ++mm)
#pragma unroll
                    for (int bj = 0; bj < 2; ++bj)
#pragma unroll
                        for (int n = 0; n < 2; ++n) x[mm][bj][n] = *(const f32x4*)(s + (size_t)(wr * 64 + fr + ai * HALF + (m0 + mm) * 16) * D + col0 + bj * HALF + 4 * n);
#pragma unroll
                for (int mm = 0; mm < 2; ++mm)
#pragma unroll
                    for (int bj = 0; bj < 2; ++bj) { const int m = m0 + mm; const u32x2_t p0 = f32_to_bf4(x[mm][bj][0] + g[bj][0] * acc[ai][bj][m][0]), p1 = f32_to_bf4(x[mm][bj][1] + g[bj][1] * acc[ai][bj][m][1]);
                        *(u32x4*)(d + (size_t)(wr * 64 + fr + ai * HALF + m * 16) * D + col0 + bj * HALF) = (u32x4){p0.x, p0.y, p1.x, p1.y}; }
                asm volatile("" ::: "memory"); }
        } else {
#pragma unroll
            for (int ai = 0; ai < 2; ++ai) { u32x4 x[4][2];
#pragma unroll
                for (int m = 0; m < 4; ++m)
#pragma unroll
                    for (int bj = 0; bj < 2; ++bj) x[m][bj] = *(const u32x4*)(d + (size_t)(wr * 64 + fr + ai * HALF + m * 16) * D + col0 + bj * HALF);
#pragma unroll
                for (int m = 0; m < 4; ++m)
#pragma unroll
                    for (int bj = 0; bj < 2; ++bj) { const u32x4 xv = x[m][bj];
                        const u32x2_t p0 = f32_to_bf4(bf4_to_f32((u32x2_t){xv.x, xv.y}) + g[bj][0] * acc[ai][bj][m][0]), p1 = f32_to_bf4(bf4_to_f32((u32x2_t){xv.z, xv.w}) + g[bj][1] * acc[ai][bj][m][1]);
                        *(u32x4*)(d + (size_t)(wr * 64 + fr + ai * HALF + m * 16) * D + col0 + bj * HALF) = (u32x4){p0.x, p0.y, p1.x, p1.y}; }
                asm volatile("" ::: "memory"); }
        }
    }
};
struct EpiScatter {
    static constexpr bool PERM = false;
    const int* ridx; const float* rgate; bf16_t* xres; const float* gate; float oscale;
    __device__ __forceinline__ void operator()(const f32x4 (&acc)[2][2][4][2], const Unit& u, int wr, int wc, int fr, int fq) const {
        const int col0 = u.pn * BM + wc * 32 + 4 * fq;
#pragma unroll
        for (int ai = 0; ai < 2; ++ai)
#pragma unroll
            for (int m = 0; m < 4; ++m) { const int rs = u.pm * BM + wr * 64 + fr + ai * HALF + m * 16; const int tok = ridx[rs];
                if (tok >= 0) { const float gt = rgate[rs] * oscale; const float* gv = gate + (tok >> 12) * MOD6 + col0; bf16_t* d = xres + (size_t)tok * D + col0;
#pragma unroll
                    for (int bj = 0; bj < 2; ++bj)
#pragma unroll
                        for (int n = 0; n < 2; ++n) { const f32x4 g = *(const f32x4*)(gv + bj * HALF + n * 16); const f32x4 x = bf4_to_f32(*(const u32x2_t*)(d + bj * HALF + n * 16));
                            *(u32x2_t*)(d + bj * HALF + n * 16) = f32_to_bf4(x + (g * gt) * acc[ai][bj][m][n]); } }
                asm volatile("" ::: "memory"); }
    }
};

struct MoeOrderRM {
    int nwg, G, c; const char* A; const char* Bt; size_t tstepA, tstepB, estride; const int* texp; int nt0, gap;
    __device__ __forceinline__ bool next(int i, Unit& u) const {
        const int wgid = (G & 7) ? i * G + c : i * G + (c & 7) * (G >> 3) + (c >> 3); if (wgid >= nwg) return false;
        int pm = wgid >> 2; const int pn = wgid & 3; pm = pm < nt0 ? pm : pm + gap;
        const int e = __builtin_amdgcn_readfirstlane(__hip_atomic_load(texp + pm, __ATOMIC_RELAXED, __HIP_MEMORY_SCOPE_AGENT));
        u.pm = __builtin_amdgcn_readfirstlane(pm); u.pn = __builtin_amdgcn_readfirstlane(pn); u.a = uptr(A + (size_t)u.pm * tstepA); u.b = uptr(Bt + (size_t)e * estride + (size_t)u.pn * tstepB); u.ridx = nullptr; return true; }
};
typedef unsigned u32x4_t __attribute__((ext_vector_type(4)));
struct EpiY {
    static constexpr bool PERM = true;
    const float* rgate; bf16_t* y0; bf16_t* y1a; bf16_t* y1b; float oscale; int t1, psplit;
    __device__ __forceinline__ void operator()(const f32x4 (&acc)[2][2][4][2], const Unit& u, int wr, int wc, int fr, int fq) const {
        const int col0 = u.pn * BM + wc * 32 + 8 * fq; const bool s1 = u.pm >= t1; const int p = s1 ? u.pm - t1 : u.pm;
        bf16_t* base = (s1 ? (p < psplit ? y1a + (size_t)p * BM * D : y1b + (size_t)(p - psplit) * BM * D) : y0 + (size_t)p * BM * D) + col0;
        float gt[2][4];
#pragma unroll
        for (int ai = 0; ai < 2; ++ai)
#pragma unroll
            for (int m = 0; m < 4; ++m) gt[ai][m] = rgate[u.pm * BM + wr * 64 + fr + ai * HALF + m * 16] * oscale;
#pragma unroll
        for (int ai = 0; ai < 2; ++ai)
#pragma unroll
            for (int m = 0; m < 4; ++m) { bf16_t* d = base + (size_t)(wr * 64 + fr + ai * HALF + m * 16) * D;
#pragma unroll
                for (int bj = 0; bj < 2; ++bj) { const u32x2_t p0 = f32_to_bf4(acc[ai][bj][m][0] * gt[ai][m]), p1 = f32_to_bf4(acc[ai][bj][m][1] * gt[ai][m]);
                    *(u32x4_t*)(d + bj * HALF) = (u32x4_t){p0.x, p0.y, p1.x, p1.y}; } }
    }
};

template <class Epi, class Sched, bool ALIGN_EPI, bool GATHER, int MODE = 0  >
__device__ __forceinline__ void gemm_phase(PG8_LAS unsigned char* lds, const int K, const Sched& S, const Epi& E) {
    constexpr bool FP8 = (MODE == 1);
    const int wid = __builtin_amdgcn_readfirstlane((int)threadIdx.x >> 6), lane = (int)__builtin_amdgcn_mbcnt_hi(~0u, __builtin_amdgcn_mbcnt_lo(~0u, 0u)), tid = wid * 64 + lane, wr = wid >> 2, wc = wid & 3, fr = lane & 15, fq = lane >> 4;
    const int nt = K / BK;
    unsigned voffA[2], voffB[2];
#pragma unroll
    for (int i = 0; i < 2; ++i) { int R, C; stage_rc(tid * 16 + i * 8192, R, C); const int Rb = Epi::PERM ? ((R & ~31) + perm32(R & 31)) : R;
        voffA[i] = (unsigned)(R * K + C) * 2u; voffB[i] = (unsigned)(Rb * K + C) * 2u; }
    const size_t kstep = (size_t)(BK * 2);
    const size_t hstep = (size_t)HALF * K * 2;
    const unsigned ldsw = (unsigned)wid * 1024u;
    const unsigned ldsb = __builtin_amdgcn_readfirstlane((unsigned)(size_t)lds + ldsw);
    const int aoff = lds_byte(wr * 64 + fr, fq * 8), boff = lds_byte(wc * 32 + fr, fq * 8);
    unsigned vAc[2][2], vAn[2][2];
#define PG8_SA(b, h) (((b) * 2 + (h)) * HTB)
#define PG8_SB(b, h) ((4 + (b) * 2 + (h)) * HTB)
#define PG8_STAGE(bufoff, gbase, voff) do { const char* _g = uptr((const char*)(gbase)); _Pragma("unroll") for (int _i = 0; _i < 2; ++_i) \
        glds_s(_g, (voff)[_i], ldsb + (unsigned)((bufoff) + _i * 8192)); } while (0)
#define PG8_STAGE_A(bufoff, NXT, kb, h) do { if constexpr (GATHER) { const char* _ga = uptr(gA + (kb)); _Pragma("unroll") for (int _i = 0; _i < 2; ++_i) { const unsigned _v = (NXT) ? vAn[h][_i] : vAc[h][_i]; \
        glds_s(_ga, _v, ldsb + (unsigned)((bufoff) + _i * 8192)); } } \
        else { const char* _b = ((NXT) ? nA : cA) + (kb) + (h) * hstep; PG8_STAGE(bufoff, _b, voffA); } } while (0)
#define PG8_LDA(dst, b, h) do { if constexpr (FP8) { _Pragma("unroll") for (int m = 0; m < 4; ++m) dst##8[m] = cat8(*(const PG8_LAS bf16x8*)(lds + PG8_SA(b, h) + aoff + m * 2048), *(const PG8_LAS bf16x8*)(lds + PG8_SA(b, h) + aoff + m * 2048 + 1024)); } \
        else { _Pragma("unroll") for (int m = 0; m < 4; ++m) _Pragma("unroll") for (int k = 0; k < 2; ++k) dst[m][k] = *(const PG8_LAS bf16x8*)(lds + PG8_SA(b, h) + aoff + m * 2048 + k * 1024); } } while (0)
#define PG8_LDB(dst, b, h) do { if constexpr (FP8) { _Pragma("unroll") for (int n = 0; n < 2; ++n) dst##8[n] = cat8(*(const PG8_LAS bf16x8*)(lds + PG8_SB(b, h) + boff + n * 2048), *(const PG8_LAS bf16x8*)(lds + PG8_SB(b, h) + boff + n * 2048 + 1024)); } \
        else { _Pragma("unroll") for (int n = 0; n < 2; ++n) _Pragma("unroll") for (int k = 0; k < 2; ++k) dst[n][k] = *(const PG8_LAS bf16x8*)(lds + PG8_SB(b, h) + boff + n * 2048 + k * 1024); } } while (0)
#define PG8_MMA(ai, bj, At, Bt) do { __builtin_amdgcn_s_setprio(1); if constexpr (FP8) { _Pragma("unroll") for (int m = 0; m < 4; ++m) _Pragma("unroll") for (int n = 0; n < 2; ++n) \
        mfma8(acc[ai][bj][m][n], Bt##8[n], At##8[m], sc127); } \
        else if constexpr (MODE == 2) { _Pragma("unroll") for (int m = 0; m < 4; ++m) _Pragma("unroll") for (int n = 0; n < 2; ++n) _Pragma("unroll") for (int k = 0; k < 2; ++k) \
        acc[ai][bj][m][n] = __builtin_bit_cast(f32x4, __builtin_amdgcn_mfma_i32_16x16x64_i8(__builtin_bit_cast(v4i_t, Bt[n][k]), __builtin_bit_cast(v4i_t, At[m][k]), __builtin_bit_cast(v4i_t, acc[ai][bj][m][n]), 0, 0, 0)); } \
        else { _Pragma("unroll") for (int m = 0; m < 4; ++m) _Pragma("unroll") for (int n = 0; n < 2; ++n) _Pragma("unroll") for (int k = 0; k < 2; ++k) \
        acc[ai][bj][m][n] = __builtin_amdgcn_mfma_f32_16x16x32_bf16(Bt[n][k], At[m][k], acc[ai][bj][m][n], 0, 0, 0); } __builtin_amdgcn_s_setprio(0); } while (0)
#define PG8_WAIT_V(n) asm volatile("s_waitcnt vmcnt(" #n ")" ::: "memory")
#define PG8_WAIT_L(n) asm volatile("s_waitcnt lgkmcnt(" #n ")" ::: "memory")
#define PG8_BAR __builtin_amdgcn_s_barrier()
#define PG8_SCHED __builtin_amdgcn_sched_barrier(0)
#define PG8_GOFF(dst, un) do { _Pragma("unroll") for (int _i = 0; _i < 2; ++_i) { int _R, _C; stage_rc(tid * 16 + _i * 8192, _R, _C); _Pragma("unroll") for (int _h = 0; _h < 2; ++_h) { int _r = (un).ridx[_h * HALF + _R]; _r = _r < 0 ? 0 : _r; \
        dst[_h][_i] = (unsigned)(_r * K + _C) * 2u; } } } while (0)
    Unit cur, nxt; int ui = 0;
    if (!S.next(0, cur)) return;
    f32x4 acc[2][2][4][2];
#pragma unroll
    for (int a = 0; a < 2; ++a)
#pragma unroll
        for (int b = 0; b < 2; ++b)
#pragma unroll
            for (int m = 0; m < 4; ++m)
#pragma unroll
                for (int n = 0; n < 2; ++n) acc[a][b][m][n] = (f32x4){0.f, 0.f, 0.f, 0.f};
    int sc127 = 127; if constexpr (FP8) asm volatile("" : "+v"(sc127));
    bf16x8 At[4][2], B0[2][2], B1[2][2]; v8i_t At8[4], B08[2], B18[2];
    const char* gA = cur.a;
    const char* cA = cur.a; const char* cB = cur.b;
    if constexpr (GATHER) { PG8_GOFF(vAc, cur); }
    {   const char* nA = cA;
        PG8_STAGE(PG8_SB(0, 0), cB, voffB); PG8_STAGE(PG8_SB(0, 1), cB + hstep, voffB); PG8_STAGE_A(PG8_SA(0, 0), false, 0, 0); PG8_STAGE_A(PG8_SA(0, 1), false, 0, 1);
        if (wr == 1) PG8_BAR;
        PG8_WAIT_V(2); PG8_BAR;
        PG8_STAGE(PG8_SB(1, 0), cB + kstep, voffB); PG8_STAGE_A(PG8_SA(1, 0), false, kstep, 0); PG8_STAGE(PG8_SB(1, 1), cB + hstep + kstep, voffB);
        PG8_WAIT_V(6); PG8_BAR; }
    for (;;) {
        const bool has_next = S.next(ui + 1, nxt);
        const char* nA = has_next ? nxt.a : cA; const char* nB = has_next ? nxt.b : cB;
        if constexpr (GATHER) { if (has_next) { PG8_GOFF(vAn, nxt); } else {
#pragma unroll
            for (int h = 0; h < 2; ++h)
#pragma unroll
                for (int i = 0; i < 2; ++i) vAn[h][i] = vAc[h][i]; } }
#pragma unroll 1
        for (int t = 0; t < nt; t += 2) {
            const bool last = (t == nt - 2);
            const size_t kb1 = (size_t)(t + 1) * kstep;
            const size_t kb2 = last ? 0 : (size_t)(t + 2) * kstep, kb3 = kb2 + kstep;
            const char* b2 = last ? nB : cB + (size_t)(t + 2) * kstep; const char* b3 = b2 + kstep;
            PG8_LDB(B0, 0, 0); PG8_LDB(B1, 0, 1); PG8_SCHED; PG8_LDA(At, 0, 0); PG8_STAGE_A(PG8_SA(1, 1), false, kb1, 1);
            PG8_WAIT_V(8); PG8_WAIT_L(0); PG8_BAR; PG8_MMA(0, 0, At, B0); PG8_MMA(0, 1, At, B1); PG8_BAR; PG8_SCHED;
            PG8_LDA(At, 0, 1); PG8_STAGE(PG8_SB(0, 0), b2, voffB); PG8_STAGE(PG8_SB(0, 1), b2 + hstep, voffB); PG8_STAGE_A(PG8_SA(0, 0), last, kb2, 0);
            PG8_WAIT_V(8); PG8_WAIT_L(0); PG8_BAR; PG8_MMA(1, 0, At, B0); PG8_MMA(1, 1, At, B1); PG8_BAR; PG8_SCHED;
            PG8_LDB(B0, 1, 0); PG8_LDB(B1, 1, 1); PG8_SCHED; PG8_LDA(At, 1, 0); PG8_STAGE_A(PG8_SA(0, 1), last, kb2, 1);
            PG8_WAIT_V(8); PG8_WAIT_L(0); PG8_BAR; PG8_MMA(0, 0, At, B0); PG8_MMA(0, 1, At, B1); PG8_BAR; PG8_SCHED;
            PG8_LDA(At, 1, 1); PG8_STAGE(PG8_SB(1, 0), b3, voffB); PG8_STAGE(PG8_SB(1, 1), b3 + hstep, voffB); PG8_STAGE_A(PG8_SA(1, 0), last, kb3, 0);
            PG8_WAIT_V(8); PG8_WAIT_L(0); PG8_BAR; PG8_MMA(1, 0, At, B0); PG8_MMA(1, 1, At, B1); PG8_BAR; PG8_SCHED;
        }
        if constexpr (ALIGN_EPI) { if (wr == 0) PG8_BAR; }
        if constexpr (FP8) asm volatile("s_nop 15\n\ts_nop 15" ::: "memory");
        { int efr = fr, efq = fq; asm volatile("" : "+v"(efr), "+v"(efq));
          E(acc, cur, wr, wc, efr, efq); }
        if (!has_next) break;
#pragma unroll
        for (int a = 0; a < 2; ++a)
#pragma unroll
            for (int b = 0; b < 2; ++b)
#pragma unroll
                for (int m = 0; m < 4; ++m)
#pragma unroll
                    for (int n = 0; n < 2; ++n) acc[a][b][m][n] = (f32x4){0.f, 0.f, 0.f, 0.f};
        cur = nxt; cA = nA; cB = nB; ++ui;
        if constexpr (GATHER) {
#pragma unroll
            for (int h = 0; h < 2; ++h)
#pragma unroll
                for (int i = 0; i < 2; ++i) vAc[h][i] = vAn[h][i]; }
        if constexpr (ALIGN_EPI) { if (wr == 1) PG8_BAR; }
    }
    PG8_WAIT_V(0);
    if constexpr (!ALIGN_EPI) { if (wr == 0) PG8_BAR; }
    PG8_BAR;
#undef PG8_SA
#undef PG8_SB
#undef PG8_STAGE
#undef PG8_STAGE_A
#undef PG8_LDA
#undef PG8_LDB
#undef PG8_MMA
#undef PG8_WAIT_V
#undef PG8_WAIT_L
#undef PG8_BAR
#undef PG8_SCHED
#undef PG8_GOFF
}
}

constexpr int NWAVES = 8, NTHR = NWAVES * 64;
constexpr size_t MiB = 1u << 20;
constexpr int RT_TILES_C = 136;
constexpr size_t WS_CTL = 0, CTL_ZERO_BYTES = 1 * MiB;
constexpr size_t WS_MODP = 1 * MiB;
constexpr size_t WS_MODV = 5 * MiB;
constexpr size_t WS_ROUTE = 6 * MiB;
constexpr size_t WS_WIN = 8 * MiB;
constexpr size_t WS_WOUT = 17 * MiB;
constexpr size_t WS_W13 = 21 * MiB;
constexpr size_t WS_W2 = 32 * MiB;
constexpr size_t WS_MW13 = 38 * MiB;
constexpr size_t WS_MW2 = 94 * MiB;
constexpr size_t WS_CTXRES = 122 * MiB;
constexpr size_t WS_HBUF = 130 * MiB;
constexpr size_t WS_PBUF = 198 * MiB;
constexpr size_t WS_MIX = 351 * MiB;
constexpr size_t WS_XRES = 419 * MiB;
constexpr size_t WS_SLOC = 487 * MiB;
constexpr size_t WS_DTOT = 521 * MiB;
constexpr size_t WS_HID = 198 * MiB;
constexpr size_t WS_HID2 = 164 * MiB;
constexpr size_t WS_ZBUF = WS_HBUF;
constexpr size_t WS_XBC = WS_HBUF + 64 * MiB;
constexpr size_t WS_END = 522 * MiB;
static_assert(WS_HID + (size_t)MT * EFF <= WS_XRES && WS_HID + (size_t)MT * DFF * 2 <= WS_XRES && WS_MIX + (size_t)MT * D * 2 <= WS_XRES && WS_PBUF + (size_t)MT * INP * 2 <= WS_MIX && WS_HBUF + (size_t)MT * D * 2 <= WS_PBUF, "ws map");
static_assert(WS_HID2 + (size_t)2 * RT_TILES_C * 256 * EFF <= WS_XRES && WS_HBUF + (size_t)NL * D <= WS_HID2, "MoE hidden");
static_assert(WS_XRES + (size_t)MT * D * 2 <= WS_SLOC && (size_t)MT * 512 * 4 <= (size_t)NL * D * 4 && WS_SLOC + (size_t)64 * 17 * 8192 * 4 <= WS_DTOT && WS_DTOT + (size_t)64 * 17 * 64 * 4 <= WS_END, "GLA scratch");
static_assert(WS_MW2 + (size_t)NE * D * EFF <= WS_CTXRES && WS_MW13 + (size_t)NE * 2 * EFF * D <= WS_MW2 && WS_W13 + (size_t)2 * DFF * D * 2 <= WS_W2 && WS_W2 + (size_t)D * DFF * 2 <= WS_MW13 && WS_CTXRES + (size_t)NC * D * 4 <= WS_HBUF, "ws map 2");
constexpr int RT_TILES = 136;
constexpr size_t RT_TOKE = 0;
constexpr size_t RT_TOKG = 262144;
constexpr size_t RT_RIDX = 524288;
constexpr size_t RT_RGATE = RT_RIDX + 2 * RT_TILES * 256 * 4;
constexpr size_t RT_TEXP = RT_RGATE + 2 * RT_TILES * 256 * 4;
constexpr size_t RT_NT = RT_TEXP + 2 * RT_TILES * 4;
constexpr size_t WS_WCS = WS_ROUTE + 1536 * 1024;
constexpr int WCS_IN = 0, WCS_W1 = 2 * 2304, WCS_W3 = 2 * 2304 + 2816;
constexpr size_t RT_POS = 1664 * 1024;
constexpr size_t WS_RS = WS_ROUTE + 1280 * 1024;
static_assert(RT_NT + 1024 <= 2 * MiB, "route tables");
constexpr int CW_BAR = 4096, CW_Q = 8192, CW_CONVQ = 12288, CW_WABS = 12800, CW_DONE0 = 16384, CW_FINQ = 16448, CW_DONE1 = 16512;
constexpr size_t WS_Y0 = 8 * MiB;
constexpr int Y1_SPLIT = 68;
static_assert((size_t)Y1_SPLIT * 256 * 1024 * 2 <= 34 * MiB && WS_Y0 + (size_t)136 * 256 * 1024 * 2 <= 94 * MiB, "MoE down product buffers");
#define MDN_MERGE 1
constexpr int RING_BYTES = 131072, LDS_BYTES = 163840, LDSCTL_OFF = LDS_BYTES - 1024, MISC_OFF = LDSCTL_OFF + 320;

#define GAS __attribute__((address_space(1)))
#define LAS __attribute__((address_space(3)))
typedef unsigned short bf16;
typedef unsigned v4u __attribute__((ext_vector_type(4)));
typedef unsigned v2u __attribute__((ext_vector_type(2)));
typedef float f32x4 __attribute__((ext_vector_type(4)));
typedef float f32x2 __attribute__((ext_vector_type(2)));
#define LDS_WAIT() asm volatile("s_waitcnt lgkmcnt(0)" ::: "memory")
__device__ __forceinline__ unsigned f2bf(float f) { unsigned u = __builtin_bit_cast(unsigned, f); return (u + 0x7fffu + ((u >> 16) & 1u)) >> 16; }
__device__ __forceinline__ unsigned pk2(float lo, float hi) { return f2bf(lo) | (f2bf(hi) << 16); }
__device__ __forceinline__ float bf2f(unsigned b) { return __builtin_bit_cast(float, b << 16); }
__device__ __forceinline__ float bflo(unsigned w) { return __builtin_bit_cast(float, w << 16); }
__device__ __forceinline__ float bfhi(unsigned w) { return __builtin_bit_cast(float, w & 0xffff0000u); }
typedef short bf16x8 __attribute__((ext_vector_type(8)));
typedef float f32x16 __attribute__((ext_vector_type(16)));
typedef __bf16 bf16x2_t __attribute__((ext_vector_type(2)));
__device__ __forceinline__ unsigned cvtpk(float lo, float hi) { const f32x2 v = {lo, hi}; return __builtin_bit_cast(unsigned, __builtin_convertvector(v, bf16x2_t)); }
__device__ __forceinline__ bf16 bf1(float x) { return (bf16)(cvtpk(x, x) & 0xffffu); }
__device__ __forceinline__ float silu_fast(float a) { return a * __builtin_amdgcn_rcpf(1.0f + __builtin_amdgcn_exp2f(a * -1.4426950408889634f)); }
__device__ __forceinline__ float cosrev(float f) { return __builtin_amdgcn_cosf(f); }
__device__ __forceinline__ float sinrev(float f) { return __builtin_amdgcn_sinf(f); }
__device__ __forceinline__ int crow32(int reg, int h) { return (reg & 3) + 8 * (reg >> 2) + 4 * h; }
#define MFMA32(a, b, c) __builtin_amdgcn_mfma_f32_32x32x16_bf16((a), (b), (c), 0, 0, 0)

#define XB_TMO      128
#define XB_XCNT(j)  (256  + 64 * (j))
#define XB_XSUB(j)  (1280 + 64 * (j))
#define XB_XGEN(j)  (2304 + 64 * (j))
#define XB_TOP      3328
#define XB_TOPGEN   3392
#define XCD_BAR_WORDS 3456
#define XB_SPIN_CAP (1u << 20)
__device__ __forceinline__ unsigned xb_ld(unsigned* p)              { return __hip_atomic_load(p, __ATOMIC_RELAXED, __HIP_MEMORY_SCOPE_AGENT); }
__device__ __forceinline__ unsigned xb_add(unsigned* p, unsigned v) { return __hip_atomic_fetch_add(p, v, __ATOMIC_RELAXED, __HIP_MEMORY_SCOPE_AGENT); }
__device__ __forceinline__ unsigned xb_xcc_id() { return (unsigned)__builtin_amdgcn_s_getreg((3 << 11) | 20) & 0xFu; }
#define XB_SPIN(cond, bar) do { unsigned _sp = 0; while (cond) { __builtin_amdgcn_s_sleep(1); \
    if ((++_sp & 255u) == 0u) { if (xb_ld(&(bar)[XB_TMO])) break; if (_sp > XB_SPIN_CAP) { atomicAdd(&(bar)[XB_TMO], 1u); break; } } } } while (0)
struct XcdBarrier { unsigned* bar; unsigned x; volatile LAS unsigned* st; };
__device__ __forceinline__ XcdBarrier xcd_barrier_post(unsigned* bar, volatile LAS unsigned* st) {
    XcdBarrier b; b.bar = bar; b.x = xb_xcc_id(); b.st = st;
    if (threadIdx.x == 0) (void)xb_add(&bar[XB_XCNT(b.x)], 1u);
    return b;
}
__device__ __forceinline__ void xcd_barrier_complete(unsigned* bar, unsigned x, unsigned& nloc, unsigned& nx) {
    const unsigned G = gridDim.x * gridDim.y * gridDim.z;
    unsigned sum, cnt, mine, sp = 0u;
    for (;;) {
        sum = 0u; cnt = 0u; mine = 0u;
#pragma unroll
        for (unsigned j = 0; j < 16; ++j) { const unsigned c = xb_ld(&bar[XB_XCNT(j)]); sum += c; cnt += (c > 0u) ? 1u : 0u; mine = (j == x) ? c : mine; }
        if (sum == G) break;
        __builtin_amdgcn_s_sleep(1);
        if ((++sp & 255u) == 0u) { if (xb_ld(&bar[XB_TMO])) break; if (sp > XB_SPIN_CAP) { atomicAdd(&bar[XB_TMO], 1u); break; } }
    }
    nloc = mine > 0u ? mine : 1u; nx = cnt > 0u ? cnt : 1u;
}
__device__ __forceinline__ void xcd_barrier(const XcdBarrier& b) {
    asm volatile("s_waitcnt vmcnt(0)" ::: "memory");
    __syncthreads();
    if (threadIdx.x == 0) {
        unsigned* bar = b.bar;
        __builtin_amdgcn_s_waitcnt(0);
        unsigned nloc = b.st[0], nx = b.st[1];
        if (nloc == 0u) { xcd_barrier_complete(bar, b.x, nloc, nx); b.st[0] = nloc; b.st[1] = nx; }
        const unsigned old = xb_add(&bar[XB_XSUB(b.x)], 1u);
        const unsigned gen = old / nloc;
        if (old + 1u == (gen + 1u) * nloc) {
            __builtin_amdgcn_fence(__ATOMIC_RELEASE, "agent");
            asm volatile("s_waitcnt vmcnt(0)" ::: "memory");
            const unsigned og = xb_add(&bar[XB_TOP], 1u);
            const unsigned tg = og / nx;
            if (og + 1u == (tg + 1u) * nx) xb_add(&bar[XB_TOPGEN], 1u);
            else XB_SPIN(xb_ld(&bar[XB_TOPGEN]) == tg, bar);
            __builtin_amdgcn_fence(__ATOMIC_ACQUIRE, "agent");
            xb_add(&bar[XB_XGEN(b.x)], 1u);
            asm volatile("s_waitcnt vmcnt(0)" ::: "memory");
        } else {
            XB_SPIN(xb_ld(&bar[XB_XGEN(b.x)]) == gen, bar);
            __builtin_amdgcn_fence(__ATOMIC_ACQUIRE, "agent");
            asm volatile("s_waitcnt vmcnt(0)" ::: "memory");
        }
    }
    __syncthreads();
}

struct Args { const float* in[23]; float* out; unsigned char* ws; int ph_lo, ph_hi, li, pad; };

__device__ __forceinline__ float wave_sum(float v) {
#pragma unroll
    for (int o = 1; o < 64; o <<= 1) v += __shfl_xor(v, o);
    return v;
}

__device__ __forceinline__ void transpose_item(const float* W, int K, int N, bf16* WT, int row_off, int mode, LAS float* scr, int item, int lane) {
    const int nblk = N / 32, kb = item / nblk, nb = item % nblk, k0 = 64 * kb, n0 = 32 * nb;
    { float tv[32];
#pragma unroll
      for (int i = 0; i < 32; ++i) tv[i] = W[(size_t)(k0 + 2 * i + (lane >> 5)) * N + n0 + (lane & 31)];
#pragma unroll
      for (int i = 0; i < 32; ++i) scr[(2 * i + (lane >> 5)) * 33 + (lane & 31)] = tv[i]; }
    LDS_WAIT(); asm volatile("" ::: "memory");
    const int r0 = mode == 0 ? row_off + n0 : row_off + (n0 >> 7) * 256 + (n0 & 127) + (mode == 2 ? 128 : 0);
    const int c = lane & 7;
#pragma unroll
    for (int j = 0; j < 4; ++j) { const int n = (lane >> 3) + 8 * j; const LAS float* s = scr + (8 * c) * 33 + n;
        v4u o; o.x = cvtpk(s[0 * 33], s[1 * 33]); o.y = cvtpk(s[2 * 33], s[3 * 33]); o.z = cvtpk(s[4 * 33], s[5 * 33]); o.w = cvtpk(s[6 * 33], s[7 * 33]);
        *(GAS v4u*)(WT + (size_t)(r0 + n) * K + k0 + 8 * c) = o; }
    LDS_WAIT(); asm volatile("" ::: "memory");
}

__device__ __forceinline__ void transpose_item8(const float* W, int K, int N, unsigned char* WT, int row_off, int mode, float sc, LAS float* scr, int item, int lane) {
    const int nblk = N / 32, kb = item / nblk, nb = item % nblk, k0 = 64 * kb, n0 = 32 * nb;
    { float tv[32];
#pragma unroll
      for (int i = 0; i < 32; ++i) tv[i] = W[(size_t)(k0 + 2 * i + (lane >> 5)) * N + n0 + (lane & 31)];
#pragma unroll
      for (int i = 0; i < 32; ++i) scr[(2 * i + (lane >> 5)) * 33 + (lane & 31)] = tv[i]; }
    LDS_WAIT(); asm volatile("" ::: "memory");
    const int r0 = mode == 0 ? row_off + n0 : row_off + (n0 >> 7) * 256 + (n0 & 127) + (mode == 2 ? 128 : 0);
    const int c = lane & 7;
#pragma unroll
    for (int j = 0; j < 4; ++j) { const int n = (lane >> 3) + 8 * j; const LAS float* s = scr + (8 * c) * 33 + n;
        v2u o; o.x = pg8::pk4_fp8(s[0 * 33] * sc, s[1 * 33] * sc, s[2 * 33] * sc, s[3 * 33] * sc); o.y = pg8::pk4_fp8(s[4 * 33] * sc, s[5 * 33] * sc, s[6 * 33] * sc, s[7 * 33] * sc);
        *(GAS v2u*)(WT + (size_t)(r0 + n) * K + k0 + 8 * c) = o; }
    LDS_WAIT(); asm volatile("" ::: "memory");
}

__device__ __forceinline__ unsigned pk4_i8(float a, float b, float c, float d) {
    const int ia = (int)__builtin_rintf(__builtin_amdgcn_fmed3f(a, -127.f, 127.f)), ib = (int)__builtin_rintf(__builtin_amdgcn_fmed3f(b, -127.f, 127.f)), ic = (int)__builtin_rintf(__builtin_amdgcn_fmed3f(c, -127.f, 127.f)), id = (int)__builtin_rintf(__builtin_amdgcn_fmed3f(d, -127.f, 127.f));
    return (unsigned)(ia & 0xff) | ((unsigned)(ib & 0xff) << 8) | ((unsigned)(ic & 0xff) << 16) | ((unsigned)id << 24); }
__device__ __forceinline__ void transpose_item_i8(const float* W, int K, int N, unsigned char* WT, int row_off, int mode, const float* steps, LAS float* scr, int item, int lane) {
    const int nblk = N / 32, kb = item / nblk, nb = item % nblk, k0 = 64 * kb, n0 = 32 * nb;
    { float tv[32];
#pragma unroll
      for (int i = 0; i < 32; ++i) tv[i] = W[(size_t)(k0 + 2 * i + (lane >> 5)) * N + n0 + (lane & 31)];
#pragma unroll
      for (int i = 0; i < 32; ++i) scr[(2 * i + (lane >> 5)) * 33 + (lane & 31)] = tv[i]; }
    LDS_WAIT(); asm volatile("" ::: "memory");
    const int r0 = mode == 0 ? row_off + n0 : row_off + (n0 >> 7) * 256 + (n0 & 127) + (mode == 2 ? 128 : 0);
    const int c = lane & 7;
#pragma unroll
    for (int j = 0; j < 4; ++j) { const int n = (lane >> 3) + 8 * j; const LAS float* s = scr + (8 * c) * 33 + n; const float st = steps[n0 + n], sc = st > 0.f ? 1.0f / st : 0.f;
        v2u o; o.x = pk4_i8(s[0 * 33] * sc, s[1 * 33] * sc, s[2 * 33] * sc, s[3 * 33] * sc); o.y = pk4_i8(s[4 * 33] * sc, s[5 * 33] * sc, s[6 * 33] * sc, s[7 * 33] * sc);
        *(GAS v2u*)(WT + (size_t)(r0 + n) * K + k0 + 8 * c) = o; }
    LDS_WAIT(); asm volatile("" ::: "memory");
}
__device__ __forceinline__ void colmax_item(const float* W, int K, int N, float* steps, int blk, LAS float* red, int wave, int lane) {
    const int n = blk * 64 + lane; float m = 0.f;
    if (n < N) { const float* p = W + (size_t)(wave * (K / 8)) * N + n;
#pragma unroll 1
        for (int k0 = 0; k0 < K / 8; k0 += 32) { float tv[32];
#pragma unroll
            for (int k = 0; k < 32; ++k) tv[k] = p[(size_t)(k0 + k) * N];
#pragma unroll
            for (int k = 0; k < 32; ++k) m = fmaxf(m, fabsf(tv[k])); } }
    red[wave * 64 + lane] = m;
    __syncthreads();
    if (wave == 0) { float mm = m;
#pragma unroll
        for (int q = 1; q < 8; ++q) mm = fmaxf(mm, red[q * 64 + lane]);
        if (n < N) steps[n] = mm * (1.0f / 127.0f); }
    __syncthreads();
}
__device__ __forceinline__ void absmax_pass(const float* W, size_t n4, unsigned* dst, int gtid, int gthreads, int lane) {
    float m = 0.f;
    for (size_t i = gtid; i < n4; i += gthreads) { const f32x4 v = ((const f32x4*)W)[i]; m = fmaxf(fmaxf(fmaxf(fabsf(v.x), fabsf(v.y)), fmaxf(fabsf(v.z), fabsf(v.w))), m); }
#pragma unroll
    for (int o = 1; o < 64; o <<= 1) m = fmaxf(m, __shfl_xor(m, o));
    if (lane == 0) atomicMax(dst, __float_as_uint(m));
}

struct Wg { LAS unsigned char* lds; int tid, lane, wave, G, bx, gw, NGW; };
#define WS_PTR(T, off) ((T*)(a.ws + (off)))
__device__ __forceinline__ void conv_in_tail(const Args& a, const Wg& w, const int nunits, const int quota);

__device__ __forceinline__ void ph_prologue(const Args& a, const Wg& w) {
    const int tid = w.tid, lane = w.lane, wave = w.wave;
    const float* c_in = a.in[1]; const float* cctx_in = a.in[3]; const float* w_mod = a.in[4];
    const float* w_in = a.in[8]; const float* w_out = a.in[14]; const float* ffn_w1 = a.in[15]; const float* ffn_w3 = a.in[16]; const float* ffn_w2 = a.in[17];
    float* MODP = WS_PTR(float, WS_MODP); bf16* WIN = WS_PTR(bf16, WS_WIN); bf16* WOUT = WS_PTR(bf16, WS_WOUT); bf16* W13 = WS_PTR(bf16, WS_W13); bf16* W2 = WS_PTR(bf16, WS_W2);
    LAS float* scr = (LAS float*)(w.lds + wave * 8448);
    LAS float* sil = (LAS float*)(w.lds + 69632);
    for (int i = tid; i < 9 * D; i += NTHR) { const float v = i < 8 * D ? c_in[i] : cctx_in[i - 8 * D]; sil[i] = v / (1.0f + __expf(-v)); }
    __syncthreads();
    constexpr int I_IN = 16 * 65, I_OUT = 16 * 32, I_F13 = 16 * 88, I_F2 = 44 * 32, I_MOD = 2 * 8 * 96;
    constexpr int NITEMS = I_MOD + 2 * I_IN + 2 * I_OUT + 2 * I_F13 + I_F2;
    for (int it = w.gw; it < NITEMS; it += w.NGW) {
        int r = it;
        if (r < I_MOD) {
            const int l = r / 768, kc = (r % 768) / 96, nb = r % 96, n = nb * 64 + lane;
            float acc[9];
#pragma unroll
            for (int b = 0; b < 9; ++b) acc[b] = 0.f;
            const float* wp = w_mod + ((size_t)l * D + kc * 128) * MOD6 + n;
#pragma unroll 1
            for (int k0 = 0; k0 < 128; k0 += 32) { float wv[32];
#pragma unroll
                for (int k = 0; k < 32; ++k) wv[k] = wp[(size_t)(k0 + k) * MOD6];
#pragma unroll
                for (int k = 0; k < 32; ++k)
#pragma unroll
                    for (int b = 0; b < 9; ++b) acc[b] += sil[b * D + kc * 128 + k0 + k] * wv[k]; }
#pragma unroll
            for (int b = 0; b < 9; ++b) MODP[(((size_t)l * 8 + kc) * 9 + b) * MOD6 + n] = acc[b];
            continue; }
        r -= I_MOD;
        if (r < 2 * I_IN) { const int l = r / I_IN; if (!I8_GIN) transpose_item(w_in + (size_t)l * D * INW, D, INW, WIN + (size_t)l * INP * D, 0, 0, scr, r % I_IN, lane); continue; } r -= 2 * I_IN;
        if (r < 2 * I_OUT) { const int l = r / I_OUT; transpose_item(w_out + (size_t)l * D * D, D, D, WOUT + (size_t)l * D * D, 0, 0, scr, r % I_OUT, lane); continue; } r -= 2 * I_OUT;
        if (r < I_F13) { if (I8_FUP) {} else if (FP8_FUP) transpose_item8(ffn_w1, D, DFF, (unsigned char*)W13, 0, 1, FP8_SW, scr, r, lane); else transpose_item(ffn_w1, D, DFF, W13, 0, 1, scr, r, lane); continue; } r -= I_F13;
        if (r < I_F13) { if (I8_FUP) {} else if (FP8_FUP) transpose_item8(ffn_w3, D, DFF, (unsigned char*)W13, 0, 2, FP8_SW, scr, r, lane); else transpose_item(ffn_w3, D, DFF, W13, 0, 2, scr, r, lane); continue; } r -= I_F13;
        if (FP8_FDN) transpose_item8(ffn_w2, DFF, D, (unsigned char*)W2, 0, 0, FP8_SW, scr, r, lane); else transpose_item(ffn_w2, DFF, D, W2, 0, 0, scr, r, lane);
    }
    {
        float* WCS = WS_PTR(float, WS_WCS); LAS float* red = (LAS float*)(w.lds + 110 * 1024);
        constexpr int B_IN = (INW + 63) / 64, B_F = DFF / 64, NB = (I8_GIN ? 2 * B_IN : 0) + (I8_FUP ? 2 * B_F : 0);
        __syncthreads();
        for (int it = w.bx; it < NB; it += w.G) { int r = it;
            if (I8_GIN) { if (r < 2 * B_IN) { const int l = r / B_IN; colmax_item(w_in + (size_t)l * D * INW, D, INW, WCS + WCS_IN + l * 2304, r % B_IN, red, wave, lane); continue; } r -= 2 * B_IN; }
            if (r < B_F) colmax_item(ffn_w1, D, DFF, WCS + WCS_W1, r, red, wave, lane); else colmax_item(ffn_w3, D, DFF, WCS + WCS_W3, r - B_F, red, wave, lane); }
        if (I8_GIN) for (int i = w.bx * NTHR + tid; i < 2 * (INP - INW); i += w.G * NTHR) WCS[WCS_IN + (i / (INP - INW)) * 2304 + INW + i % (INP - INW)] = 0.f;
    }
    for (int i = w.bx * NTHR + tid; i < 2 * (INP - INW) * D / 8; i += w.G * NTHR) { const int l = i / ((INP - INW) * D / 8), o = i % ((INP - INW) * D / 8);
        if (I8_GIN) { if (o < (INP - INW) * D / 16) *(GAS v4u*)((unsigned char*)WIN + (size_t)l * INP * D + (size_t)INW * D + (size_t)o * 16) = (v4u){0u, 0u, 0u, 0u}; }
        else *(GAS v4u*)(WIN + (size_t)l * INP * D + (size_t)INW * D + (size_t)o * 8) = (v4u){0u, 0u, 0u, 0u}; }
    __syncthreads();
}
__device__ __forceinline__ void ph_modfin(const Args& a, const Wg& w) {
    const float* b_mod = a.in[5]; const float* MODP = WS_PTR(float, WS_MODP); float* MODV = WS_PTR(float, WS_MODV);
    for (int i = w.bx * NTHR + w.tid; i < 2 * 9 * MOD6; i += w.G * NTHR) { const int l = i / (9 * MOD6), r = i % (9 * MOD6), n = r % MOD6;
        float s = b_mod[l * MOD6 + n];
#pragma unroll
        for (int kc = 0; kc < 8; ++kc) s += MODP[((size_t)l * 8 + kc) * 9 * MOD6 + r];
        MODV[i] = s; }
}
__device__ __forceinline__ void ph_quant(const Args& a, const Wg& w) {
    __syncthreads();
    if (I8_GIN) {
        LAS float* scr = (LAS float*)(w.lds + w.wave * 8448); constexpr int I_IN = 16 * 65;
        for (int it = w.gw; it < 2 * I_IN; it += w.NGW) { const int l = it / I_IN;
            transpose_item_i8(a.in[8] + (size_t)l * D * INW, D, INW, WS_PTR(unsigned char, WS_WIN) + (size_t)l * INP * D, 0, 0, WS_PTR(float, WS_WCS) + WCS_IN + l * 2304, scr, it % I_IN, w.lane); }
        __syncthreads(); }
    if (I8_FUP) {
        LAS float* scr = (LAS float*)(w.lds + w.wave * 8448); constexpr int I_F13 = 16 * 88;
        for (int it = w.gw; it < 2 * I_F13; it += w.NGW) { if (it < I_F13) transpose_item_i8(a.in[15], D, DFF, WS_PTR(unsigned char, WS_W13), 0, 1, WS_PTR(float, WS_WCS) + WCS_W1, scr, it, w.lane); else transpose_item_i8(a.in[16], D, DFF, WS_PTR(unsigned char, WS_W13), 0, 2, WS_PTR(float, WS_WCS) + WCS_W3, scr, it - I_F13, w.lane); }
        __syncthreads(); }
}
__device__ __forceinline__ void ph_norm(const Args& a, const Wg& w, const int l, const int which) {
    const int lane = w.lane;
    const float* modl = WS_PTR(float, WS_MODV) + (size_t)l * 9 * MOD6;
    const bool fin = (l == 0 && which == 0);
    const float* resL = a.in[0]; const float* resC = a.in[2]; const bf16* XRES = WS_PTR(bf16, WS_XRES);
    const float* nw = (which == 0 ? a.in[6] : a.in[7]) + l * D;
    bf16* HBUF = WS_PTR(bf16, WS_HBUF);
    const bool route = (l == 1 && which == 1);
    LAS float* rw = (LAS float*)w.lds;
    if (route) { const float* router_w = a.in[18]; for (int i = w.tid; i < D * NE / 4; i += NTHR) ((LAS f32x4*)rw)[i] = ((const f32x4*)router_w)[i]; }
    __syncthreads();
    int* TOKE = WS_PTR(int, WS_ROUTE + RT_TOKE); float* TOKG = WS_PTR(float, WS_ROUTE + RT_TOKG);
    const int Mrows = (l == 1 && which == 1) ? NL : MT;
    for (int m = w.gw; m < Mrows; m += w.NGW) {
        const bool isc = m >= NL; const int bidx = isc ? 8 : (m >> 12);
        const float* xr = isc ? resC + (size_t)(m - NL) * D : resL + (size_t)m * D;
        const float* sh = modl + bidx * MOD6 + which * 3 * D, *sc = sh + D;
        f32x4 v[4]; float ss = 0.f;
#pragma unroll
        for (int j = 0; j < 4; ++j) { v[j] = fin ? *(const f32x4*)(xr + 4 * lane + 256 * j) : pg8::bf4_to_f32(*(const pg8::u32x2_t*)(XRES + (size_t)m * D + 4 * lane + 256 * j)); ss += (v[j].x * v[j].x + v[j].y * v[j].y) + (v[j].z * v[j].z + v[j].w * v[j].w); }
        const float rstd = 1.0f / sqrtf(wave_sum(ss) * (1.0f / D) + EPS);
        float lg[8];
#pragma unroll
        for (int e = 0; e < 8; ++e) lg[e] = 0.f;
        f32x4 hq[4]; float amax = 0.f;
#pragma unroll
        for (int j = 0; j < 4; ++j) { const int c = 4 * lane + 256 * j; const f32x4 wv = *(const f32x4*)(nw + c), s1 = *(const f32x4*)(sc + c), s0 = *(const f32x4*)(sh + c);
            const f32x4 h = (v[j] * rstd) * wv * (s1 + 1.0f) + s0; hq[j] = h;
            amax = fmaxf(amax, fmaxf(fmaxf(fabsf(h.x), fabsf(h.y)), fmaxf(fabsf(h.z), fabsf(h.w))));
            if (route) {
#pragma unroll
                for (int q = 0; q < 4; ++q) { const f32x4 r0 = *(const LAS f32x4*)(rw + (c + q) * 8), r1 = *(const LAS f32x4*)(rw + (c + q) * 8 + 4); const float hv = h[q];
                    lg[0] += hv * r0.x; lg[1] += hv * r0.y; lg[2] += hv * r0.z; lg[3] += hv * r0.w; lg[4] += hv * r1.x; lg[5] += hv * r1.y; lg[6] += hv * r1.z; lg[7] += hv * r1.w; } } }
        if ((which == 1 && l == 0 && I8_FUP) || (which == 0 && I8_GIN)) {
#pragma unroll
            for (int o = 1; o < 64; o <<= 1) amax = fmaxf(amax, __shfl_xor(amax, o));
            const float qs = amax > 1e-30f ? 127.0f / amax : 0.f;
            if (lane == 0) WS_PTR(float, WS_RS)[m] = amax * (1.0f / 127.0f);
#pragma unroll
            for (int j = 0; j < 4; ++j) *(unsigned*)((unsigned char*)HBUF + (size_t)m * D + 4 * lane + 256 * j) = pk4_i8(hq[j].x * qs, hq[j].y * qs, hq[j].z * qs, hq[j].w * qs);
        } else {
#pragma unroll
            for (int j = 0; j < 4; ++j) { const int c = 4 * lane + 256 * j; const f32x4 h = hq[j];
                if (which == 0 || (l == 0 && !FP8_FUP)) *(v2u*)(HBUF + (size_t)m * D + c) = (v2u){cvtpk(h.x, h.y), cvtpk(h.z, h.w)};
                else *(unsigned*)((unsigned char*)HBUF + (size_t)m * D + c) = pg8::pk4_fp8(h.x * FP8_SH, h.y * FP8_SH, h.z * FP8_SH, h.w * FP8_SH); } }
        if (route) {
#pragma unroll
            for (int e = 0; e < 8; ++e) lg[e] = wave_sum(lg[e]);
            int e0 = 0; float v0 = lg[0];
#pragma unroll
            for (int e = 1; e < 8; ++e) if (lg[e] > v0) { v0 = lg[e]; e0 = e; }
            int e1 = -1; float v1 = -3.0e38f;
#pragma unroll
            for (int e = 0; e < 8; ++e) if (e != e0 && lg[e] > v1) { v1 = lg[e]; e1 = e; }
            const float g0 = 1.0f / (1.0f + __expf(v1 - v0)), g1 = 1.0f - g0;
            if (lane == 0) { TOKE[m] = e0; TOKE[NL + m] = e1; TOKG[m] = g0; TOKG[NL + m] = g1; }
        }
    }
    __syncthreads();
}
__device__ __forceinline__ void ph_gin(const Args& a, const Wg& w, const int l) {
    if constexpr (I8_GIN) { pg8::DenseOrder S; S.init(WS_PTR(bf16, WS_HBUF), (const bf16*)(WS_PTR(unsigned char, WS_WIN) + (size_t)l * INP * D), MT, INP, D / 2, w.G, w.bx);
        pg8::EpiBf16i E{WS_PTR(bf16, WS_PBUF), INP, WS_PTR(float, WS_RS), WS_PTR(float, WS_WCS) + WCS_IN + l * 2304};
        pg8::gemm_phase<pg8::EpiBf16i, pg8::DenseOrder, true, false, 2>(w.lds, D / 2, S, E); }
    else { pg8::DenseOrder S; S.init(WS_PTR(bf16, WS_HBUF), WS_PTR(bf16, WS_WIN) + (size_t)l * INP * D, MT, INP, D, w.G, w.bx); pg8::EpiBf16 E{WS_PTR(bf16, WS_PBUF), INP};
        pg8::gemm_phase<pg8::EpiBf16, pg8::DenseOrder, true, false>(w.lds, D, S, E); }
    conv_in_tail(a, w, (MT / 256) * (INP / 256), CONV_Q_GIN);
}
__device__ __forceinline__ int wq_next(unsigned* ctr, volatile LAS int* slot, int tid) {
    __syncthreads();
    if (tid == 0) *slot = (int)__hip_atomic_fetch_add(ctr, 1u, __ATOMIC_RELAXED, __HIP_MEMORY_SCOPE_AGENT);
    __syncthreads();
    return __builtin_amdgcn_readfirstlane(*slot);
}
__device__ __forceinline__ int wq_claim(unsigned* ctr, int tid) { return tid == 0 ? (int)__hip_atomic_fetch_add(ctr, 1u, __ATOMIC_RELAXED, __HIP_MEMORY_SCOPE_AGENT) : 0; }
__device__ __forceinline__ int wq_take(volatile LAS int* slot, int& par, int claimed, int tid) {
    if (tid == 0) slot[par] = claimed;
    __syncthreads();
    const int v = __builtin_amdgcn_readfirstlane(slot[par]); par ^= 1; return v;
}
#define MFMA16(a, b, c) __builtin_amdgcn_mfma_f32_16x16x32_bf16((a), (b), (c), 0, 0, 0)
constexpr int GL_QE = 0, GL_KE = 18432, GL_KDT = 36864, GL_P = 55296, GL_VT = 73728, GL_OS = 110592, GL_DEC = 144384, GL_SLOT = 160000;
static_assert(GL_DEC + 512 <= GL_SLOT && GL_SLOT + 64 <= LDSCTL_OFF, "GLA LDS map");
#define BB16 1
#if BB16
typedef _Float16 bb_t;
#else
typedef float bb_t;
#endif
constexpr size_t GSCR_OFF = (size_t)72 * MiB;
constexpr int NG1 = 64 * 17;
__device__ __forceinline__ int gla_run_row0(int b, int run) { return run == 0 ? NL + b * CTXL : b * SEQ + (run - 1) * 256; }
__device__ __forceinline__ float log_sigmoid_f(float z) { return fminf(z, 0.f) - log1pf(__expf(-fabsf(z))); }
__device__ __forceinline__ void gla_vt_image(const bf16* PBUF, LAS unsigned char* lds, int row0, int h, int tid) {
    const int dv = tid & 127, t4 = tid >> 7; unsigned pk[8];
    const bf16* p = PBUF + (size_t)(row0 + 16 * t4) * INP + PC_V + h * 128 + dv;
#pragma unroll
    for (int e = 0; e < 8; ++e) pk[e] = (unsigned)p[(size_t)(2 * e) * INP] | ((unsigned)p[(size_t)(2 * e + 1) * INP] << 16);
    *(LAS v4u*)(lds + GL_VT + dv * 144 + 32 * t4) = (v4u){pk[0], pk[1], pk[2], pk[3]};
    *(LAS v4u*)(lds + GL_VT + dv * 144 + 32 * t4 + 16) = (v4u){pk[4], pk[5], pk[6], pk[7]};
}
__device__ __forceinline__ void gla_state_update(f32x4 (&S)[4], LAS unsigned char* lds, int wave, int r, int q, int o_kdt, int o_vt, int o_dec) {
    const LAS float* dec = (const LAS float*)(lds + o_dec);
#pragma unroll
    for (int kt = 0; kt < 4; ++kt) { const f32x4 d = *(const LAS f32x4*)(dec + 16 * kt + 4 * q); S[kt] = S[kt] * d; }
#pragma unroll
    for (int ks = 0; ks < 2; ++ks) { const bf16x8 B = *(const LAS bf16x8*)(lds + o_vt + (16 * wave + r) * 144 + (32 * ks + 8 * q) * 2);
#pragma unroll
        for (int kt = 0; kt < 4; ++kt) { const bf16x8 A = *(const LAS bf16x8*)(lds + o_kdt + (16 * kt + r) * 144 + (32 * ks + 8 * q) * 2); S[kt] = MFMA16(A, B, S[kt]); } }
}
struct G1Raw { v4u lfa[2]; unsigned kq[4]; unsigned vp[8]; };
__device__ __forceinline__ void g1_load(G1Raw& r, const bf16* PBUF, int row0, int h, int dir, int tid) {
    const int k = tid & 63, tg = tid >> 6, dv = tid & 127, t4 = tid >> 7;
    { const int wv = tid >> 6, ln = tid & 63;
#pragma unroll
      for (int t = 0; t < 2; ++t) r.lfa[t] = *(const v4u*)(PBUF + (size_t)(row0 + 16 * (2 * (wv >> 2) + t) + (ln & 15)) * INP + PC_LF + dir * 16 + 8 * ((ln >> 4) & 1)); }
    const bf16* pk = PBUF + (size_t)(row0 + 8 * tg) * INP + PC_K + h * 64 + k;
#pragma unroll
    for (int e = 0; e < 4; ++e) r.kq[e] = (unsigned)pk[(size_t)(2 * e) * INP] | ((unsigned)pk[(size_t)(2 * e + 1) * INP] << 16);
    const bf16* pv = PBUF + (size_t)(row0 + 16 * t4) * INP + PC_V + h * 128 + dv;
#pragma unroll
    for (int e = 0; e < 8; ++e) r.vp[e] = (unsigned)pv[(size_t)(2 * e) * INP] | ((unsigned)pv[(size_t)(2 * e + 1) * INP] << 16);
}
__device__ __forceinline__ float log_sigmoid_fast(float z) { return fminf(z, 0.f) - 0.6931471805599453f * __builtin_amdgcn_logf(1.0f + __builtin_amdgcn_exp2f(fabsf(z) * -1.4426950408889634f)); }
constexpr int G1_VT = 0, G1_KDT = 36864, G1_LF = 55296, G1_T = 63488, G1_DEC = 67584, G1_Z = 69632;
__device__ __forceinline__ void gla_g1_job(const Args& a, const Wg& w, const int l, const int job, const int var = 0) {
    const int tid = w.tid, lane = w.lane, wave = w.wave, r = lane & 15, q = lane >> 4, k = tid & 63, tg = tid >> 6;
    const int seq = job / 17, step = job - seq * 17, b = seq >> 3, h = (seq >> 1) & 3, dir = seq & 1;
    const int run = step == 0 ? 0 : (dir ? 17 - step : step), rrow0 = gla_run_row0(b, run);
    const bf16* PBUF = WS_PTR(bf16, WS_PBUF); bb_t* BBUF = (bb_t*)a.out; float* SLOC = WS_PTR(float, WS_SLOC); float* DTOT = WS_PTR(float, WS_DTOT);
    LAS unsigned char* lds = w.lds;
    bf16x8 WB;
    { const int kgrp = lane >> 4, r0 = 8 * (kgrp & 1); const float* wgp = (dir ? a.in[11] : a.in[9]) + (size_t)l * 16 * 256 + h * 64 + 16 * (wave & 3) + (lane & 15);
      unsigned pkw[4];
#pragma unroll
      for (int jj = 0; jj < 8; jj += 2) { unsigned hv[2];
#pragma unroll
          for (int u = 0; u < 2; ++u) { const float wv = wgp[(r0 + jj + u) * 256]; const unsigned hb = cvtpk(wv, wv) & 0xffffu; const float lo = wv - __uint_as_float(hb << 16); hv[u] = (kgrp >> 1) ? (cvtpk(lo, lo) & 0xffffu) : hb; }
          pkw[jj >> 1] = hv[0] | (hv[1] << 16); }
      WB = __builtin_bit_cast(bf16x8, (v4u){pkw[0], pkw[1], pkw[2], pkw[3]}); }
    const float bias = (dir ? a.in[12] : a.in[10])[l * 256 + h * 64 + k];
    f32x4 S[4];
#pragma unroll
    for (int kt = 0; kt < 4; ++kt) S[kt] = (f32x4){0.f, 0.f, 0.f, 0.f};
    float logtot = 0.f;
    G1Raw cur; g1_load(cur, PBUF, rrow0 + (dir ? 3 : 0) * 64, h, dir, tid);
    for (int pc = 0; pc < ((var & 8) ? 0 : 4); ++pc) {
        const int par = pc & 1, row0 = rrow0 + (dir ? 3 - pc : pc) * 64;
        LAS unsigned char* VT = lds + G1_VT + par * 18432; LAS unsigned char* KDT = lds + G1_KDT + par * 9216; LAS float* Z = (LAS float*)(lds + G1_Z);
        LAS float* T = (LAS float*)(lds + G1_T + par * 2048); LAS float* DEC = (LAS float*)(lds + G1_DEC + par * 256);
        { f32x4 z0 = (f32x4){0.f, 0.f, 0.f, 0.f}, z1 = z0;
          z0 = MFMA16(__builtin_bit_cast(bf16x8, cur.lfa[0]), WB, z0); z1 = MFMA16(__builtin_bit_cast(bf16x8, cur.lfa[1]), WB, z1);
          LAS float* zp = Z + (32 * (wave >> 2) + 4 * q) * 68 + 16 * (wave & 3) + r;
#pragma unroll
          for (int i = 0; i < 4; ++i) { zp[i * 68] = z0[i]; zp[(16 + i) * 68] = z1[i]; } }
        { const int dv = tid & 127, t4 = tid >> 7;
          *(LAS v4u*)(VT + dv * 144 + 32 * t4) = (v4u){cur.vp[0], cur.vp[1], cur.vp[2], cur.vp[3]}; *(LAS v4u*)(VT + dv * 144 + 32 * t4 + 16) = (v4u){cur.vp[4], cur.vp[5], cur.vp[6], cur.vp[7]}; }
        const unsigned kq0 = cur.kq[0], kq1 = cur.kq[1], kq2 = cur.kq[2], kq3 = cur.kq[3];
        __syncthreads();
        if (pc < 3) g1_load(cur, PBUF, rrow0 + (dir ? 2 - pc : pc + 1) * 64, h, dir, tid);
        float gv[8];
#pragma unroll
        for (int e = 0; e < 8; ++e) { gv[e] = log_sigmoid_fast(Z[(8 * tg + e) * 68 + k] + bias) * (1.0f / 16.0f); if (var & 1) break; }
        if (var & 1) {
#pragma unroll
            for (int e = 1; e < 8; ++e) gv[e] = gv[0]; }
        float runs = 0.f;
        if (!dir) {
#pragma unroll
            for (int e = 0; e < 8; ++e) { runs += gv[e]; gv[e] = runs; } }
        else {
#pragma unroll
            for (int e = 7; e >= 0; --e) { runs += gv[e]; gv[e] = runs; } }
        T[tg * 64 + k] = runs;
        __syncthreads();
        float off = 0.f, tot = 0.f;
#pragma unroll
        for (int t2 = 0; t2 < 8; ++t2) { const float v = T[t2 * 64 + k]; tot += v; const bool before = dir ? (t2 > tg) : (t2 < tg); off += before ? v : 0.f; }
        const unsigned kqa[4] = {kq0, kq1, kq2, kq3}; unsigned pk[4];
#pragma unroll
        for (int e2 = 0; e2 < 4; ++e2) { const float B0 = gv[2 * e2] + off, B1 = gv[2 * e2 + 1] + off; const size_t row = (size_t)(row0 + 8 * tg + 2 * e2);
            if (!(var & 4)) { BBUF[row * 512 + dir * 256 + h * 64 + k] = (bb_t)B0; BBUF[(row + 1) * 512 + dir * 256 + h * 64 + k] = (bb_t)B1; }
            pk[e2] = cvtpk(bflo(kqa[e2]) * __expf(tot - B0), bfhi(kqa[e2]) * __expf(tot - B1)); }
        *(LAS v4u*)(KDT + k * 144 + 16 * tg) = (v4u){pk[0], pk[1], pk[2], pk[3]};
        if (tg == 0) DEC[k] = __expf(tot);
        logtot += tot;
        __syncthreads();
        if (!(var & 2)) {
#pragma unroll
            for (int kt = 0; kt < 4; ++kt) { const f32x4 d = *(const LAS f32x4*)(DEC + 16 * kt + 4 * q); S[kt] = S[kt] * d; }
#pragma unroll
            for (int ks = 0; ks < 2; ++ks) { const bf16x8 Bf = *(const LAS bf16x8*)(VT + (16 * wave + r) * 144 + (32 * ks + 8 * q) * 2);
#pragma unroll
                for (int kt = 0; kt < 4; ++kt) { const bf16x8 Af = *(const LAS bf16x8*)(KDT + (16 * kt + r) * 144 + (32 * ks + 8 * q) * 2); S[kt] = MFMA16(Af, Bf, S[kt]); } }
        }
    }
    const size_t idx = (size_t)seq * 17 + step;
#pragma unroll
    for (int kt = 0; kt < 4; ++kt)
#pragma unroll
        for (int i = 0; i < 4; ++i) SLOC[idx * 8192 + (size_t)(16 * kt + 4 * q + i) * 128 + 16 * wave + r] = S[kt][i];
    if (tg == 0) DTOT[idx * 64 + k] = __expf(logtot);
}
__device__ __forceinline__ void ph_gla_scan(const Args& a, const Wg& w) {
    float* SLOC = WS_PTR(float, WS_SLOC); const float* DTOT = WS_PTR(float, WS_DTOT);
    for (int ge = w.bx * NTHR + w.tid; ge < 64 * 8192; ge += w.G * NTHR) { const int seq = ge >> 13, e = ge & 8191;
        float* p = SLOC + (size_t)seq * 17 * 8192 + e; const float* d = DTOT + (size_t)seq * 17 * 64 + (e >> 7);
        float tv[17], dv[17];
#pragma unroll
        for (int st = 0; st < 17; ++st) { tv[st] = p[(size_t)st * 8192]; dv[st] = d[st * 64]; }
        float s = 0.f;
#pragma unroll
        for (int st = 0; st < 17; ++st) { p[(size_t)st * 8192] = s; s = dv[st] * s + tv[st]; } }
}
struct G3Raw { float Bl; float B[8]; unsigned qk[8]; unsigned vp[8]; };
__device__ __forceinline__ void g3_load(G3Raw& r, const bf16* PBUF, const bb_t* BBUF, int row0, int h, int dir, int tid) {
    const int k = tid & 63, tg = tid >> 6, dv = tid & 127, t4 = tid >> 7;
    r.Bl = (float)BBUF[(size_t)(row0 + (dir ? 0 : 63)) * 512 + dir * 256 + h * 64 + k];
#pragma unroll
    for (int e = 0; e < 8; ++e) { const size_t row = (size_t)(row0 + 8 * tg + e); r.B[e] = (float)BBUF[row * 512 + dir * 256 + h * 64 + k];
        r.qk[e] = (unsigned)PBUF[row * INP + PC_Q + h * 64 + k] | ((unsigned)PBUF[row * INP + PC_K + h * 64 + k] << 16); }
    const bf16* pv = PBUF + (size_t)(row0 + 16 * t4) * INP + PC_V + h * 128 + dv;
#pragma unroll
    for (int e = 0; e < 8; ++e) r.vp[e] = (unsigned)pv[(size_t)(2 * e) * INP] | ((unsigned)pv[(size_t)(2 * e + 1) * INP] << 16);
}
__device__ __forceinline__ void gla_g3_job(const Args& a, const Wg& w, const int l, const int job, const int var = 0) {
    const int tid = w.tid, lane = w.lane, wave = w.wave, r = lane & 15, q = lane >> 4, k = tid & 63, tg = tid >> 6;
    const int b = job / 68, h = (job / 17) & 3, run = job % 17, rrow0 = gla_run_row0(b, run);
    const bf16* PBUF = WS_PTR(bf16, WS_PBUF); const bb_t* BBUF = (const bb_t*)a.out; const float* SLOC = WS_PTR(float, WS_SLOC); bf16* MIX = WS_PTR(bf16, WS_MIX);
    v4u* OFS = (v4u*)((unsigned char*)a.out + GSCR_OFF) + ((size_t)job * 4 * NTHR + tid) * 2;
    const float* gnw = a.in[13] + l * 128 + (tid & 7) * 16;
    f32x4 gw4[4];
#pragma unroll
    for (int j = 0; j < 4; ++j) gw4[j] = *(const f32x4*)(gnw + 4 * j);
    LAS unsigned char* lds = w.lds; LAS float* OS = (LAS float*)(lds + GL_OS);
    f32x4 S[4];
    { const size_t idx = (size_t)((b * 4 + h) * 2 + 0) * 17 + run;
#pragma unroll
      for (int kt = 0; kt < 4; ++kt)
#pragma unroll
          for (int i = 0; i < 4; ++i) S[kt][i] = SLOC[idx * 8192 + (size_t)(16 * kt + 4 * q + i) * 128 + 16 * wave + r]; }
    G3Raw cur; g3_load(cur, PBUF, BBUF, rrow0, h, 0, tid);
    for (int s = 0; s < ((var & 8) ? 0 : 8); ++s) {
        const int dir = s >> 2, pc = s & 3, cidx = dir ? 3 - pc : pc, row0 = rrow0 + cidx * 64, par = s & 1;
        const int oQE = GL_QE + par * 9216, oKE = GL_KE + par * 9216, oKDT = GL_KDT + par * 9216, oP = GL_P + par * 9216, oVT = GL_VT + par * 18432, oDEC = GL_DEC + par * 256;
        if (s == 4) { const size_t idx = (size_t)((b * 4 + h) * 2 + 1) * 17 + (run == 0 ? 0 : 17 - run);
#pragma unroll
            for (int kt = 0; kt < 4; ++kt)
#pragma unroll
                for (int i = 0; i < 4; ++i) S[kt][i] = SLOC[idx * 8192 + (size_t)(16 * kt + 4 * q + i) * 128 + 16 * wave + r]; }
        {
            unsigned pk[4];
#pragma unroll
            for (int e2 = 0; e2 < 4; ++e2) { float kd[2];
#pragma unroll
                for (int u = 0; u < 2; ++u) { const int e = 2 * e2 + u; const float Bv = cur.B[e], qv = bflo(cur.qk[e]), kv = bfhi(cur.qk[e]);
                    const float ke = kv * __expf(-Bv); kd[u] = kv * __expf(cur.Bl - Bv);
                    const unsigned qk2 = cvtpk(qv * 0.125f * __expf(Bv), ke);
                    *(LAS bf16*)(lds + oQE + (8 * tg + e) * 144 + 2 * k) = (bf16)(qk2 & 0xffffu); *(LAS bf16*)(lds + oKE + (8 * tg + e) * 144 + 2 * k) = (bf16)(qk2 >> 16); }
                pk[e2] = cvtpk(kd[0], kd[1]); }
            *(LAS v4u*)(lds + oKDT + k * 144 + 16 * tg) = (v4u){pk[0], pk[1], pk[2], pk[3]};
            if (tg == 0) *(LAS float*)(lds + oDEC + 4 * k) = __expf(cur.Bl);
            const int dv = tid & 127, t4 = tid >> 7;
            *(LAS v4u*)(lds + oVT + dv * 144 + 32 * t4) = (v4u){cur.vp[0], cur.vp[1], cur.vp[2], cur.vp[3]}; *(LAS v4u*)(lds + oVT + dv * 144 + 32 * t4 + 16) = (v4u){cur.vp[4], cur.vp[5], cur.vp[6], cur.vp[7]};
        }
        __syncthreads();
        if (s < 7) { const int s1 = s + 1, d1 = s1 >> 2, p1 = s1 & 3; g3_load(cur, PBUF, BBUF, rrow0 + (d1 ? 3 - p1 : p1) * 64, h, d1, tid); }
        v4u of0 = (v4u){0u, 0u, 0u, 0u}, of1 = of0, gA = of0, gB = of0;
        if (dir) { const v4u* op = OFS + (size_t)cidx * NTHR * 2; of0 = op[0]; of1 = op[1];
            const bf16* pg = PBUF + (size_t)(row0 + (tid >> 3)) * INP + PC_G + h * 128 + (tid & 7) * 16; gA = *(const v4u*)pg; gB = *(const v4u*)(pg + 8); }
#pragma unroll
        for (int t = 0; t < 2; ++t) { const int id = 2 * wave + t, st = id >> 2, tt = id & 3;
            f32x4 pa = (f32x4){0.f, 0.f, 0.f, 0.f};
            if (dir ? (st >= tt) : (st <= tt)) {
#pragma unroll
                for (int ks = 0; ks < 2; ++ks) { const bf16x8 A = *(const LAS bf16x8*)(lds + oKE + (16 * st + r) * 144 + (32 * ks + 8 * q) * 2), B = *(const LAS bf16x8*)(lds + oQE + (16 * tt + r) * 144 + (32 * ks + 8 * q) * 2);
                    pa = MFMA16(A, B, pa); }
                const int tau = 16 * tt + r;
#pragma unroll
                for (int i = 0; i < 4; ++i) { const int sg = 16 * st + 4 * q + i; const bool keep = dir ? (sg >= tau) : (sg <= tau); pa[i] = keep ? pa[i] : 0.f; } }
            *(LAS v2u*)(lds + oP + (16 * tt + r) * 144 + (16 * st + 4 * q) * 2) = (v2u){cvtpk(pa[0], pa[1]), cvtpk(pa[2], pa[3])}; }
        __syncthreads();
        f32x4 o[4];
#pragma unroll
        for (int tt = 0; tt < 4; ++tt) o[tt] = (f32x4){0.f, 0.f, 0.f, 0.f};
#pragma unroll
        for (int ks = 0; ks < 2; ++ks) {
            const bf16x8 Bs = __builtin_bit_cast(bf16x8, (v4u){cvtpk(S[2 * ks][0], S[2 * ks][1]), cvtpk(S[2 * ks][2], S[2 * ks][3]), cvtpk(S[2 * ks + 1][0], S[2 * ks + 1][1]), cvtpk(S[2 * ks + 1][2], S[2 * ks + 1][3])});
#pragma unroll
            for (int tt = 0; tt < 4; ++tt) { const v2u alo = *(const LAS v2u*)(lds + oQE + (16 * tt + r) * 144 + (32 * ks + 4 * q) * 2), ahi = *(const LAS v2u*)(lds + oQE + (16 * tt + r) * 144 + (32 * ks + 16 + 4 * q) * 2);
                o[tt] = MFMA16(__builtin_bit_cast(bf16x8, (v4u){alo.x, alo.y, ahi.x, ahi.y}), Bs, o[tt]); } }
#pragma unroll
        for (int ks = 0; ks < 2; ++ks) { const bf16x8 Bv = *(const LAS bf16x8*)(lds + oVT + (16 * wave + r) * 144 + (32 * ks + 8 * q) * 2);
#pragma unroll
            for (int tt = 0; tt < 4; ++tt) { const bf16x8 A = *(const LAS bf16x8*)(lds + oP + (16 * tt + r) * 144 + (32 * ks + 8 * q) * 2); o[tt] = MFMA16(A, Bv, o[tt]); } }
        gla_state_update(S, lds, wave, r, q, oKDT, oVT, oDEC);
        if (dir == 0) {
            v4u* op = OFS + (size_t)cidx * NTHR * 2;
            op[0] = (v4u){cvtpk(o[0][0], o[0][1]), cvtpk(o[0][2], o[0][3]), cvtpk(o[1][0], o[1][1]), cvtpk(o[1][2], o[1][3])};
            op[1] = (v4u){cvtpk(o[2][0], o[2][1]), cvtpk(o[2][2], o[2][3]), cvtpk(o[3][0], o[3][1]), cvtpk(o[3][2], o[3][3])};
        } else {
            const unsigned ofw[8] = {of0.x, of0.y, of0.z, of0.w, of1.x, of1.y, of1.z, of1.w};
#pragma unroll
            for (int tt = 0; tt < 4; ++tt)
#pragma unroll
                for (int i = 0; i < 4; ++i) { const int tk = 16 * tt + 4 * q + i; const unsigned wv = ofw[2 * tt + (i >> 1)]; OS[tk * 132 + 16 * wave + r] = o[tt][i] + ((i & 1) ? bfhi(wv) : bflo(wv)); }
            __syncthreads();
            const int tk = tid >> 3, dv0 = (tid & 7) * 16; const size_t row = (size_t)(row0 + tk);
            f32x4 ov[4]; float ss = 0.f;
#pragma unroll
            for (int j = 0; j < 4; ++j) { ov[j] = *(const LAS f32x4*)(OS + tk * 132 + dv0 + 4 * j); ss += (ov[j].x * ov[j].x + ov[j].y * ov[j].y) + (ov[j].z * ov[j].z + ov[j].w * ov[j].w); }
            ss += __shfl_xor(ss, 1); ss += __shfl_xor(ss, 2); ss += __shfl_xor(ss, 4);
            const float rstd = __builtin_amdgcn_rsqf(ss * (1.0f / 128.0f) + EPS);
            const unsigned gq[8] = {gA.x, gA.y, gA.z, gA.w, gB.x, gB.y, gB.z, gB.w}; unsigned yo[8];
#pragma unroll
            for (int j = 0; j < 4; ++j) { const f32x4 wv = gw4[j];
                const float ga = bflo(gq[2 * j]), gb = bfhi(gq[2 * j]), gc = bflo(gq[2 * j + 1]), gd = bfhi(gq[2 * j + 1]);
                yo[2 * j] = cvtpk(ov[j].x * rstd * wv.x * silu_fast(ga), ov[j].y * rstd * wv.y * silu_fast(gb));
                yo[2 * j + 1] = cvtpk(ov[j].z * rstd * wv.z * silu_fast(gc), ov[j].w * rstd * wv.w * silu_fast(gd)); }
            bf16* mo = MIX + row * D + 512 + h * 128 + dv0;
            *(v4u*)mo = (v4u){yo[0], yo[1], yo[2], yo[3]}; *(v4u*)(mo + 8) = (v4u){yo[4], yo[5], yo[6], yo[7]};
        }
    }
}
__device__ __forceinline__ void four_t1_setup(const Wg& w, bf16x8 (&T1)[8]) {
    const int lane = w.lane, wave = w.wave, r = lane & 31, h = lane >> 5;
    const int k2c = 32 * wave + r, k2 = k2c & 127;
#pragma unroll
    for (int s = 0; s < 8; ++s) { unsigned pk[4];
#pragma unroll
        for (int j = 0; j < 4; ++j) { const int n0 = 16 * s + 8 * h + 2 * j; const float f0 = (float)((n0 * k2) & 127) * (1.0f / 128.0f), f1 = (float)(((n0 + 1) * k2) & 127) * (1.0f / 128.0f);
            pk[j] = k2c < 128 ? cvtpk(cosrev(f0), cosrev(f1)) : cvtpk(-sinrev(f0), -sinrev(f1)); }
        T1[s] = __builtin_bit_cast(bf16x8, (v4u){pk[0], pk[1], pk[2], pk[3]}); }
}
__device__ __forceinline__ void ctx_dft1_item(const Args& a, const Wg& w, const bf16x8 (&T1)[8], const int item) {
    const int tid = w.tid, lane = w.lane, wave = w.wave, r = lane & 31, h = lane >> 5;
    const bf16* PBUF = WS_PTR(bf16, WS_PBUF); bf16* XB = WS_PTR(bf16, WS_XBC) - (size_t)NL * 4 * 256;
    LAS unsigned char* U = w.lds;
    const int g = item & 3, m0 = NL + (item >> 2) * 64;
    __syncthreads();
#pragma unroll
    for (int i = 0; i < 2; ++i) { const int id = tid + NTHR * i, aa = id >> 4, ch = id & 15;
        const v4u v = *(const v4u*)(PBUF + (size_t)(m0 + aa) * INP + PC_U + g * 128 + ch * 8);
        *(LAS v4u*)(U + aa * 272 + ch * 16) = v; }
    __syncthreads();
    f32x16 x0, x1;
#pragma unroll
    for (int i = 0; i < 16; ++i) { x0[i] = 0.f; x1[i] = 0.f; }
#pragma unroll
    for (int s = 0; s < 8; ++s) { const bf16x8 A0 = *(const LAS bf16x8*)(U + r * 272 + (16 * s + 8 * h) * 2), A1 = *(const LAS bf16x8*)(U + (32 + r) * 272 + (16 * s + 8 * h) * 2);
        x0 = MFMA32(A0, T1[s], x0); x1 = MFMA32(A1, T1[s], x1); }
    bf16* xo = XB + ((size_t)m0 * 4 + g) * 256 + 32 * wave + r;
#pragma unroll
    for (int i = 0; i < 16; ++i) { xo[(size_t)crow32(i, h) * 1024] = bf1(x0[i]); xo[(size_t)(32 + crow32(i, h)) * 1024] = bf1(x1[i]); }
}
__device__ __forceinline__ void ctx_dft2_item(const Args& a, const Wg& w, const int it) {
    const int tid = w.tid, lane = w.lane, wave = w.wave, r = lane & 31, h = lane >> 5, dt = wave >> 2, ct = wave & 3;
    const bf16* XB = WS_PTR(bf16, WS_XBC) - (size_t)NL * 4 * 256; bf16* MIX = WS_PTR(bf16, WS_MIX);
    const int b = it >> 4, g = (it >> 2) & 3, kq = it & 3, row0 = NL + b * CTXL;
    LAS unsigned char* T = w.lds; constexpr int P = 528;
    __syncthreads();
    v4u v[16];
#pragma unroll
    for (int i = 0; i < 16; ++i) { const int id = tid + NTHR * i, row = id >> 5, ch = id & 31; v[i] = *(const v4u*)(XB + ((size_t)(row0 + row) * 4 + g) * 256 + ch * 8); }
#pragma unroll
    for (int i = 0; i < 16; ++i) { const int id = tid + NTHR * i, row = id >> 5, ch = id & 31; *(LAS v4u*)(T + row * P + ch * 16) = v[i]; }
    __syncthreads();
    f32x16 y;
#pragma unroll
    for (int i = 0; i < 16; ++i) y[i] = 0.f;
    const int k1 = kq * 64 + dt * 32 + r;
#pragma unroll 4
    for (int s = 0; s < 32; ++s) { unsigned pa[4], pb[4];
#pragma unroll
        for (int jj = 0; jj < 4; ++jj) { const int n1 = 8 * s + 4 * h + jj; const float f = (float)((k1 * n1) & 255) * (1.0f / 256.0f); pa[jj] = cvtpk(cosrev(f), sinrev(f));
            const LAS unsigned char* p = T + n1 * P + (32 * ct + r) * 2; pb[jj] = (unsigned)*(const LAS bf16*)p | ((unsigned)*(const LAS bf16*)(p + 256) << 16); }
        y = MFMA32(__builtin_bit_cast(bf16x8, (v4u){pa[0], pa[1], pa[2], pa[3]}), __builtin_bit_cast(bf16x8, (v4u){pb[0], pb[1], pb[2], pb[3]}), y); }
    const float sc = 1.0f / sqrtf((float)CTXL * 128.0f);
    bf16* mo = MIX + (size_t)(row0 + kq * 64 + 32 * dt) * D + g * 128 + 32 * ct + r;
#pragma unroll
    for (int i = 0; i < 16; ++i) mo[(size_t)crow32(i, h) * D] = bf1(y[i] * sc);
}
__device__ __forceinline__ void four_a_setup(const Wg& w, bf16x8 (&T1)[8]) {
    const int tid = w.tid;
    LAS unsigned char* M64 = w.lds;
    __syncthreads();
    for (int i = tid; i < 128 * 128; i += NTHR) { const int row = i >> 7, col = i & 127, c = row & 63, ri = row >> 6, aa = col & 63, ri2 = col >> 6;
        const float f = (float)((c * aa) & 63) * (1.0f / 64.0f), cs = cosrev(f), sn = sinrev(f); const float v = (ri == ri2) ? cs : (ri == 0 ? sn : -sn);
        *(LAS bf16*)(M64 + row * 272 + col * 2) = (bf16)f2bf(v); }
    four_t1_setup(w, T1);
    __syncthreads();
}
__device__ __forceinline__ void four_a_item(const Args& a, const Wg& w, const bf16x8 (&T1)[8], const int item) {
    const int tid = w.tid, lane = w.lane, wave = w.wave, r = lane & 31, h = lane >> 5;
    const bf16* PBUF = WS_PTR(bf16, WS_PBUF); bf16* ZB = WS_PTR(bf16, WS_ZBUF);
    LAS unsigned char* M64 = w.lds; LAS unsigned char* U = w.lds + 34816; LAS unsigned char* XT = w.lds + 52224;
    const int b = item >> 8, g = (item >> 6) & 3, bcol = item & 63;
#pragma unroll
    for (int i = 0; i < 2; ++i) { const int id = tid + NTHR * i, aa = id >> 4, ch = id & 15;
        const v4u v = *(const v4u*)(PBUF + (size_t)(b * SEQ + 64 * aa + bcol) * INP + PC_U + g * 128 + ch * 8);
        *(LAS v4u*)(U + aa * 272 + ch * 16) = v; }
    __syncthreads();
    f32x16 x0, x1;
#pragma unroll
    for (int i = 0; i < 16; ++i) { x0[i] = 0.f; x1[i] = 0.f; }
#pragma unroll
    for (int s = 0; s < 8; ++s) { const bf16x8 A0 = *(const LAS bf16x8*)(U + r * 272 + (16 * s + 8 * h) * 2), A1 = *(const LAS bf16x8*)(U + (32 + r) * 272 + (16 * s + 8 * h) * 2);
        x0 = MFMA32(A0, T1[s], x0); x1 = MFMA32(A1, T1[s], x1); }
    { const int k2 = (32 * wave + r) & 127, ri2 = wave >> 2;
#pragma unroll
      for (int qq = 0; qq < 4; ++qq) {
          *(LAS v2u*)(XT + k2 * 272 + (ri2 * 64 + 8 * qq + 4 * h) * 2) = (v2u){cvtpk(x0[4 * qq], x0[4 * qq + 1]), cvtpk(x0[4 * qq + 2], x0[4 * qq + 3])};
          *(LAS v2u*)(XT + k2 * 272 + (ri2 * 64 + 32 + 8 * qq + 4 * h) * 2) = (v2u){cvtpk(x1[4 * qq], x1[4 * qq + 1]), cvtpk(x1[4 * qq + 2], x1[4 * qq + 3])}; } }
    __syncthreads();
    const int ct = wave & 3, rt = wave >> 2;
    f32x16 zr, zi;
#pragma unroll
    for (int i = 0; i < 16; ++i) { zr[i] = 0.f; zi[i] = 0.f; }
#pragma unroll
    for (int s = 0; s < 8; ++s) { const bf16x8 B = *(const LAS bf16x8*)(XT + (32 * ct + r) * 272 + (16 * s + 8 * h) * 2);
        const bf16x8 Ar = *(const LAS bf16x8*)(M64 + (32 * rt + r) * 272 + (16 * s + 8 * h) * 2), Ai = *(const LAS bf16x8*)(M64 + (64 + 32 * rt + r) * 272 + (16 * s + 8 * h) * 2);
        zr = MFMA32(Ar, B, zr); zi = MFMA32(Ai, B, zi); }
    bf16* zo = ZB + ((size_t)((b * 4 + g) * 64) * 64 + bcol) * 256 + 32 * ct + r;
#pragma unroll
    for (int i = 0; i < 16; ++i) { const int c = 32 * rt + crow32(i, h); const float f = (float)((bcol * c) & 4095) * (1.0f / 4096.0f), cs = cosrev(f), sn = sinrev(f);
        const float vr = zr[i] * cs + zi[i] * sn, vi = zi[i] * cs - zr[i] * sn;
        bf16* p = zo + (size_t)c * 64 * 256; const unsigned z2 = cvtpk(vr, vi); p[0] = (bf16)(z2 & 0xffffu); p[128] = (bf16)(z2 >> 16); }
}
__device__ __forceinline__ void four_b_setup(const Wg& w, bf16x8 (&M2)[8]) {
    const int lane = w.lane, wave = w.wave, r = lane & 31, h = lane >> 5, d = 32 * (wave >> 2) + r;
#pragma unroll
    for (int s = 0; s < 8; ++s) { unsigned pk[4];
#pragma unroll
        for (int j = 0; j < 4; ++j) { const int bc = (16 * s + 8 * h + 2 * j) >> 1; const float f = (float)((bc * d) & 63) * (1.0f / 64.0f); pk[j] = cvtpk(cosrev(f), sinrev(f)); }
        M2[s] = __builtin_bit_cast(bf16x8, (v4u){pk[0], pk[1], pk[2], pk[3]}); }
}
constexpr int FB_N = 4;
__device__ __forceinline__ void four_b_item(const Args& a, const Wg& w, const bf16x8 (&M2)[8], const int item) {
    const int tid = w.tid, lane = w.lane, wave = w.wave, r = lane & 31, h = lane >> 5, dt = wave >> 2, ct = wave & 3;
    const bf16* ZB = WS_PTR(bf16, WS_ZBUF); bf16* MIX = WS_PTR(bf16, WS_MIX);
    const float scale = 1.0f / sqrtf(4096.0f * 128.0f);
    const int b = item >> 6, g = (item >> 4) & 3, c0 = (item & 15) * FB_N;
    const bf16* zt = ZB + (size_t)((b * 4 + g) * 64 + c0) * 64 * 256;
    v4u v[FB_N][4];
#pragma unroll
    for (int t = 0; t < FB_N; ++t)
#pragma unroll
        for (int i = 0; i < 4; ++i) v[t][i] = *(const v4u*)(zt + (size_t)t * 64 * 256 + (size_t)(tid + NTHR * i) * 8);
#pragma unroll
    for (int t = 0; t < FB_N; ++t) { LAS unsigned char* ZT = w.lds + t * 33792;
#pragma unroll
        for (int i = 0; i < 4; ++i) { const int id = tid + NTHR * i, row = id >> 4, ch = id & 15;
            *(LAS v2u*)(ZT + row * 264 + ch * 16) = (v2u){v[t][i].x, v[t][i].y}; *(LAS v2u*)(ZT + row * 264 + ch * 16 + 8) = (v2u){v[t][i].z, v[t][i].w}; } }
    __syncthreads();
#pragma unroll
    for (int t = 0; t < FB_N; ++t) { const LAS unsigned char* ZT = w.lds + t * 33792;
        f32x16 y;
#pragma unroll
        for (int i = 0; i < 16; ++i) y[i] = 0.f;
#pragma unroll
        for (int s = 0; s < 8; ++s) { unsigned pk[4];
#pragma unroll
            for (int j = 0; j < 4; ++j) { const LAS unsigned char* p = ZT + (16 * s + 8 * h + 2 * j) * 264 + (32 * ct + r) * 2;
                pk[j] = (unsigned)*(const LAS bf16*)p | ((unsigned)*(const LAS bf16*)(p + 264) << 16); }
            y = MFMA32(M2[s], __builtin_bit_cast(bf16x8, (v4u){pk[0], pk[1], pk[2], pk[3]}), y); }
        bf16* mo = MIX + (size_t)(b * SEQ + c0 + t) * D + g * 128 + 32 * ct + r;
#pragma unroll
        for (int i = 0; i < 16; ++i) { const int d = 32 * dt + crow32(i, h); mo[(size_t)d * 64 * D] = bf1(y[i] * scale); } }
}
__device__ __forceinline__ void ph_mix_a(const Args& a, const Wg& w, const int l, const int rep = 0, const int mask = 7) {
    unsigned* ctr = (unsigned*)(a.ws + WS_CTL) + CW_Q + 64 * (2 * l) + 256 * rep;
    volatile LAS int* slot = (volatile LAS int*)(w.lds + GL_SLOT);
    const int nc1 = (l == 0) ? NC * 4 / 64 : 0;
    int par = 0; int item = wq_next(ctr, slot + 2, w.tid);
    if (item < nc1) {
        bf16x8 T1[8]; four_t1_setup(w, T1);
        while (item < nc1) { const int c = wq_claim(ctr, w.tid); if (mask & 4) ctx_dft1_item(a, w, T1, item); item = wq_take(slot, par, c, w.tid); }
    }
    while (item < nc1 + NG1) { const int c = wq_claim(ctr, w.tid); if (mask & 1) gla_g1_job(a, w, l, item - nc1, rep ? REP_VAR : 0); item = wq_take(slot, par, c, w.tid); }
    if (item < nc1 + NG1 + 2048) {
        bf16x8 T1[8]; four_a_setup(w, T1);
        while (item < nc1 + NG1 + 2048) { const int c = wq_claim(ctr, w.tid); if (mask & 2) four_a_item(a, w, T1, item - nc1 - NG1); item = wq_take(slot, par, c, w.tid); }
    }
}
__device__ __forceinline__ void ph_mix_c(const Args& a, const Wg& w, const int l, const int rep = 0, const int mask = 7) {
    unsigned* ctr = (unsigned*)(a.ws + WS_CTL) + CW_Q + 64 * (2 * l + 1) + 256 * rep;
    volatile LAS int* slot = (volatile LAS int*)(w.lds + GL_SLOT);
    const int ng3 = (l == 0) ? 544 : 512, nctx = (l == 0) ? 128 : 0;
    int par = 0; int item = wq_next(ctr, slot + 2, w.tid);
    if (item < nctx) {
        while (item < nctx) { const int c = wq_claim(ctr, w.tid); if (mask & 4) ctx_dft2_item(a, w, item); item = wq_take(slot, par, c, w.tid); }
    }
    while (item < nctx + ng3) {
        const int it = item - nctx, job = (l == 0) ? it : ((it >> 4) * 17 + (it & 15) + 1);
        const int c = wq_claim(ctr, w.tid); if (mask & 1) gla_g3_job(a, w, l, job, rep ? REP_VAR : 0); item = wq_take(slot, par, c, w.tid); }
    if (item < nctx + ng3 + 2048 / FB_N) {
        bf16x8 M2[8]; four_b_setup(w, M2);
        while (item < nctx + ng3 + 2048 / FB_N) { const int c = wq_claim(ctr, w.tid); __syncthreads(); if (mask & 2) four_b_item(a, w, M2, item - nctx - ng3); item = wq_take(slot, par, c, w.tid); }
    }
}
constexpr int CONV_WAVE_ITEMS = 16 * (16 * 112) + 8 * (56 * 32), CONV_ITEMS = CONV_WAVE_ITEMS / 8;
static_assert(CONV_WAVE_ITEMS % 8 == 0, "conversion items");
__device__ __forceinline__ void conv_items(const Args& a, const Wg& w, const int max_items) {
    const float* moe_w1 = a.in[19]; const float* moe_w3 = a.in[20]; const float* moe_w2 = a.in[21];
    unsigned char* MW13 = WS_PTR(unsigned char, WS_MW13); unsigned char* MW2 = WS_PTR(unsigned char, WS_MW2);
    unsigned* ctr = (unsigned*)(a.ws + WS_CTL) + CW_CONVQ;
    volatile LAS int* slot = (volatile LAS int*)(w.lds + 72 * 1024);
    LAS float* scr = (LAS float*)(w.lds + 1024 + w.wave * 8448);
    constexpr int I_M13 = 16 * 112, I_M2 = 56 * 32;
    for (int n = 0; n < max_items; ++n) {
        const int item = wq_next(ctr, slot, w.tid);
        if (item >= CONV_ITEMS) break;
        int r = item * 8 + w.wave;
        if (r < 8 * I_M13) { const int e = r / I_M13; transpose_item8(moe_w1 + (size_t)e * D * EFF, D, EFF, MW13 + (size_t)e * 2 * EFF * D, 0, 1, FP8_SW, scr, r % I_M13, w.lane); continue; } r -= 8 * I_M13;
        if (r < 8 * I_M13) { const int e = r / I_M13; transpose_item8(moe_w3 + (size_t)e * D * EFF, D, EFF, MW13 + (size_t)e * 2 * EFF * D, 0, 2, FP8_SW, scr, r % I_M13, w.lane); continue; } r -= 8 * I_M13;
        { const int e = r / I_M2; transpose_item8(moe_w2 + (size_t)e * EFF * D, EFF, D, MW2 + (size_t)e * D * EFF, 0, 0, FP8_SW, scr, r % I_M2, w.lane); }
    }
    __syncthreads();
}
__device__ __forceinline__ void conv_in_tail(const Args& a, const Wg& w, const int nunits, const int quota) {
    const int mine = (nunits - w.bx + w.G - 1) / w.G, most = (nunits + w.G - 1) / w.G;
    if (mine < most) conv_items(a, w, quota);
}
__device__ __forceinline__ void ph_gout(const Args& a, const Wg& w, const int l) {
    const float* modl = WS_PTR(float, WS_MODV) + (size_t)l * 9 * MOD6;
    pg8::DenseOrder S; S.init(WS_PTR(bf16, WS_MIX), WS_PTR(bf16, WS_WOUT) + (size_t)l * D * D, l == 0 ? MT : NL, D, D, w.G, w.bx);
    pg8::EpiRes E{l == 0 ? a.in[0] : nullptr, l == 0 ? a.in[2] : nullptr, WS_PTR(bf16, WS_XRES), modl + 2 * D, 1.0f};
    pg8::gemm_phase<pg8::EpiRes, pg8::DenseOrder, true, false>(w.lds, D, S, E);
    if (l == 0) conv_in_tail(a, w, (MT / 256) * (D / 256), CONV_Q_GOUT);
}
__device__ __forceinline__ void ph_fup(const Args& a, const Wg& w) {
    constexpr int KA = (FP8_FUP || I8_FUP) ? D / 2 : D;
    pg8::DenseOrder S; S.init(WS_PTR(bf16, WS_HBUF), WS_PTR(bf16, WS_W13), MT, 2 * DFF, KA, w.G, w.bx);
    constexpr float inv = FP8_FUP ? 1.0f / (FP8_SH * FP8_SW) : 1.0f;
    if constexpr (I8_FUP) { static_assert(FP8_FDN, "the int8 up GEMM writes an fp8 hidden");
        pg8::EpiSwiGLU8i E{WS_PTR(unsigned char, WS_HID), DFF, WS_PTR(float, WS_RS), WS_PTR(float, WS_WCS) + WCS_W1, WS_PTR(float, WS_WCS) + WCS_W3, FP8_SHID}; pg8::gemm_phase<pg8::EpiSwiGLU8i, pg8::DenseOrder, true, false, 2>(w.lds, KA, S, E); }
    else if constexpr (FP8_FDN) { pg8::EpiSwiGLU8 E{WS_PTR(unsigned char, WS_HID), DFF, inv, FP8_SHID, 0}; pg8::gemm_phase<pg8::EpiSwiGLU8, pg8::DenseOrder, true, false, FP8_FUP ? 1 : 0>(w.lds, KA, S, E); }
    else { pg8::EpiSwiGLU E{WS_PTR(bf16, WS_HID), DFF, inv}; pg8::gemm_phase<pg8::EpiSwiGLU, pg8::DenseOrder, true, false, FP8_FUP ? 1 : 0>(w.lds, KA, S, E); }
    conv_in_tail(a, w, (MT / 256) * (2 * DFF / 256), CONV_Q_FUP);
}
__device__ __forceinline__ void ph_fdn(const Args& a, const Wg& w) {
    const float* modl = WS_PTR(float, WS_MODV);
    constexpr int KA = FP8_FDN ? DFF / 2 : DFF;
    pg8::DenseOrder S; S.init(WS_PTR(bf16, WS_HID), WS_PTR(bf16, WS_W2), MT, D, KA, w.G, w.bx); pg8::EpiRes E{nullptr, nullptr, WS_PTR(bf16, WS_XRES), modl + 5 * D, FP8_FDN ? 1.0f / (FP8_SHID * FP8_SW) : 1.0f};
    pg8::gemm_phase<pg8::EpiRes, pg8::DenseOrder, true, false, FP8_FDN ? 1 : 0>(w.lds, KA, S, E);
    conv_in_tail(a, w, (MT / 256) * (D / 256), CONV_Q_FDN);
}
__device__ __forceinline__ void ph_route(const Args& a, const Wg& w) {
    if (w.bx >= 128) return;
    const int tid = w.tid, lane = w.lane, wave = w.wave;
    const int* TOKE = WS_PTR(int, WS_ROUTE + RT_TOKE); const float* TOKG = WS_PTR(float, WS_ROUTE + RT_TOKG);
    int* RIDX = WS_PTR(int, WS_ROUTE + RT_RIDX); float* RGATE = WS_PTR(float, WS_ROUTE + RT_RGATE); int* TEXP = WS_PTR(int, WS_ROUTE + RT_TEXP); int* NTL = WS_PTR(int, WS_ROUTE + RT_NT);
    const int s = w.bx >> 6, e = (w.bx >> 3) & 7, seg = w.bx & 7;
    LAS int* cnt = (LAS int*)w.lds;
    LAS int* wtot = (LAS int*)(w.lds + 64);
    if (tid < 9) cnt[tid] = 0;
    __syncthreads();
    int lc[9];
#pragma unroll
    for (int q = 0; q < 9; ++q) lc[q] = 0;
    for (int t = 4 * tid; t < NL; t += 4 * NTHR) { const int4 te = *(const int4*)(TOKE + s * NL + t); const int bef = t < seg * 4096;
#pragma unroll
        for (int q = 0; q < 8; ++q) lc[q] += (te.x == q) + (te.y == q) + (te.z == q) + (te.w == q);
        lc[8] += bef ? (te.x == e) + (te.y == e) + (te.z == e) + (te.w == e) : 0; }
#pragma unroll
    for (int q = 0; q < 9; ++q) { int v = lc[q];
#pragma unroll
        for (int o = 1; o < 64; o <<= 1) v += __shfl_xor(v, o);
        if (lane == 0) atomicAdd((int*)&cnt[q], v); }
    __syncthreads();
    int base = 0, total = 0, mycnt = 0;
    for (int q = 0; q < 8; ++q) { const int cq = cnt[q], tq = (cq + 255) >> 8; if (q < e) base += tq * 256; if (q == e) mycnt = cq; total += tq; }
    int running = cnt[8];
    for (int t0 = seg * 4096; t0 < seg * 4096 + 4096; t0 += 4 * NTHR) {
        const int t = t0 + 4 * tid; const int4 te = *(const int4*)(TOKE + s * NL + t);
        const int f0 = te.x == e, f1 = te.y == e, f2 = te.z == e, f3 = te.w == e, mine = f0 + f1 + f2 + f3;
        int incl = mine;
#pragma unroll
        for (int o = 1; o < 64; o <<= 1) { const int v = __shfl_up(incl, o); if (lane >= o) incl += v; }
        const int wt = __shfl(incl, 63);
        __syncthreads();
        if (lane == 0) wtot[wave] = wt;
        __syncthreads();
        int woff = 0, ctot = 0;
#pragma unroll
        for (int q = 0; q < 8; ++q) { const int v = wtot[q]; if (q < wave) woff += v; ctot += v; }
        int pos = s * RT_TILES * 256 + base + running + woff + incl - mine;
        int* POS = WS_PTR(int, WS_ROUTE + RT_POS) + s * NL; const int pb = s * RT_TILES * 256;
        if (f0) { RIDX[pos] = t;     RGATE[pos] = TOKG[s * NL + t];     POS[t] = pos - pb;     ++pos; }
        if (f1) { RIDX[pos] = t + 1; RGATE[pos] = TOKG[s * NL + t + 1]; POS[t + 1] = pos - pb; ++pos; }
        if (f2) { RIDX[pos] = t + 2; RGATE[pos] = TOKG[s * NL + t + 2]; POS[t + 2] = pos - pb; ++pos; }
        if (f3) { RIDX[pos] = t + 3; RGATE[pos] = TOKG[s * NL + t + 3]; POS[t + 3] = pos - pb; ++pos; }
        running += ctot; }
    if (seg == 0) {
        const int padend = base + ((mycnt + 255) >> 8) * 256;
        for (int p = base + mycnt + tid; p < padend; p += NTHR) { RIDX[s * RT_TILES * 256 + p] = -1; RGATE[s * RT_TILES * 256 + p] = 0.f; }
        for (int tl = (base >> 8) + tid; tl < (padend >> 8); tl += NTHR) TEXP[s * RT_TILES + tl] = e;
        if (e == 0 && tid == 0) NTL[s * 64] = total;
    }
    __syncthreads();
}
__device__ __forceinline__ void ph_mup(const Args& a, const Wg& w, const int skip = 0) {
    const int nt0 = __builtin_amdgcn_readfirstlane(__hip_atomic_load(WS_PTR(int, WS_ROUTE + RT_NT), __ATOMIC_RELAXED, __HIP_MEMORY_SCOPE_AGENT));
    const int nt1 = __builtin_amdgcn_readfirstlane(__hip_atomic_load(WS_PTR(int, WS_ROUTE + RT_NT) + 64, __ATOMIC_RELAXED, __HIP_MEMORY_SCOPE_AGENT));
    pg8::MoeOrder S; S.oc.init(nt0 + nt1, 2 * EFF / 256, w.G, w.bx); S.A = (const char*)WS_PTR(bf16, WS_HBUF); S.Bt = (const char*)WS_PTR(bf16, WS_MW13); S.tstepA = 0; S.tstepB = (size_t)256 * D; S.estride = (size_t)2 * EFF * D;
    S.texp = WS_PTR(int, WS_ROUTE + RT_TEXP); S.ridx = WS_PTR(int, WS_ROUTE + RT_RIDX); S.nt0 = nt0; S.gap = RT_TILES - nt0;
    pg8::EpiSwiGLU8 E{WS_PTR(unsigned char, WS_HID2), EFF, 1.0f / (FP8_SH * FP8_SW), FP8_SHID, skip};
    pg8::gemm_phase<pg8::EpiSwiGLU8, pg8::MoeOrder, true, true, 1>(w.lds, D / 2, S, E);
}
__device__ __forceinline__ void ph_mdn(const Args& a, const Wg& w, const int s) {
    const int ntl = __builtin_amdgcn_readfirstlane(__hip_atomic_load(WS_PTR(int, WS_ROUTE + RT_NT) + s * 64, __ATOMIC_RELAXED, __HIP_MEMORY_SCOPE_AGENT));
    const float* modl = WS_PTR(float, WS_MODV) + (size_t)9 * MOD6;
    pg8::MoeOrder S; S.oc.init(ntl, D / 256, w.G, w.bx); S.A = (const char*)WS_PTR(unsigned char, WS_HID2) + (size_t)s * RT_TILES * 256 * EFF; S.Bt = (const char*)WS_PTR(bf16, WS_MW2); S.tstepA = (size_t)256 * EFF; S.tstepB = (size_t)256 * EFF; S.estride = (size_t)D * EFF;
    S.texp = WS_PTR(int, WS_ROUTE + RT_TEXP) + s * RT_TILES; S.ridx = WS_PTR(int, WS_ROUTE + RT_RIDX) + s * RT_TILES * 256; S.nt0 = 1 << 30; S.gap = 0;
    pg8::EpiScatter E{WS_PTR(int, WS_ROUTE + RT_RIDX) + s * RT_TILES * 256, WS_PTR(float, WS_ROUTE + RT_RGATE) + s * RT_TILES * 256, WS_PTR(bf16, WS_XRES), modl + 5 * D, 1.0f / (FP8_SHID * FP8_SW)};
    pg8::gemm_phase<pg8::EpiScatter, pg8::MoeOrder, true, false, 1>(w.lds, EFF / 2, S, E);
}
__device__ __forceinline__ void ph_mdn2(const Args& a, const Wg& w) {
    const int nt0 = __builtin_amdgcn_readfirstlane(__hip_atomic_load(WS_PTR(int, WS_ROUTE + RT_NT), __ATOMIC_RELAXED, __HIP_MEMORY_SCOPE_AGENT));
    const int nt1 = __builtin_amdgcn_readfirstlane(__hip_atomic_load(WS_PTR(int, WS_ROUTE + RT_NT) + 64, __ATOMIC_RELAXED, __HIP_MEMORY_SCOPE_AGENT));
    pg8::MoeOrderRM S; S.nwg = (nt0 + nt1) * (D / 256); S.G = w.G; S.c = w.bx; S.A = (const char*)WS_PTR(unsigned char, WS_HID2); S.Bt = (const char*)WS_PTR(bf16, WS_MW2); S.tstepA = (size_t)256 * EFF; S.tstepB = (size_t)256 * EFF; S.estride = (size_t)D * EFF;
    S.texp = WS_PTR(int, WS_ROUTE + RT_TEXP); S.nt0 = nt0; S.gap = RT_TILES - nt0;
    pg8::EpiY E{WS_PTR(float, WS_ROUTE + RT_RGATE), WS_PTR(bf16, WS_Y0), WS_PTR(bf16, WS_HBUF), WS_PTR(bf16, WS_SLOC), 1.0f / (FP8_SHID * FP8_SW), RT_TILES, Y1_SPLIT};
    pg8::gemm_phase<pg8::EpiY, pg8::MoeOrderRM, true, false, 1>(w.lds, EFF / 2, S, E);
}
__device__ __forceinline__ void ph_final2(const Args& a, const Wg& w) {
    const int lane = w.lane; const float* fw = a.in[22]; const bf16* XRES = WS_PTR(bf16, WS_XRES); const bf16* Y0 = WS_PTR(bf16, WS_Y0);
    const bf16* Y1A = WS_PTR(bf16, WS_HBUF); const bf16* Y1B = WS_PTR(bf16, WS_SLOC) - (size_t)Y1_SPLIT * 256 * D;
    const int* POS = WS_PTR(int, WS_ROUTE + RT_POS); const float* gate = WS_PTR(float, WS_MODV) + (size_t)9 * MOD6 + 5 * D;
    f32x4 wv[4];
#pragma unroll
    for (int j = 0; j < 4; ++j) wv[j] = *(const f32x4*)(fw + 4 * lane + 256 * j);
    constexpr int TB = 2;
    int np0[TB], np1[TB];
    { const int m0 = w.gw * TB;
#pragma unroll
      for (int k = 0; k < TB; ++k) { np0[k] = m0 + k < NL ? POS[m0 + k] : 0; np1[k] = m0 + k < NL ? POS[NL + m0 + k] : 0; } }
    for (int m0 = w.gw * TB; m0 < NL; m0 += w.NGW * TB) {
        pg8::u32x2_t xr[TB][4], y0r[TB][4], y1r[TB][4];
#pragma unroll
        for (int k = 0; k < TB; ++k) { const int p0 = __builtin_amdgcn_readfirstlane(np0[k]), p1 = __builtin_amdgcn_readfirstlane(np1[k]);
            const bf16* y1p = (p1 < Y1_SPLIT * 256 ? Y1A : Y1B) + (size_t)p1 * D;
#pragma unroll
            for (int j = 0; j < 4; ++j) { const int c = 4 * lane + 256 * j; xr[k][j] = *(const pg8::u32x2_t*)(XRES + (size_t)(m0 + k) * D + c); y0r[k][j] = *(const pg8::u32x2_t*)(Y0 + (size_t)p0 * D + c); y1r[k][j] = *(const pg8::u32x2_t*)(y1p + c); } }
        { const int mn = m0 + w.NGW * TB;
#pragma unroll
          for (int k = 0; k < TB; ++k) { np0[k] = mn + k < NL ? POS[mn + k] : 0; np1[k] = mn + k < NL ? POS[NL + mn + k] : 0; } }
        const float* gp = gate + (m0 >> 12) * MOD6;
        f32x4 g[4];
#pragma unroll
        for (int j = 0; j < 4; ++j) g[j] = *(const f32x4*)(gp + 4 * lane + 256 * j);
#pragma unroll
        for (int k = 0; k < TB; ++k) {
            f32x4 v[4]; float ss = 0.f;
#pragma unroll
            for (int j = 0; j < 4; ++j) { v[j] = pg8::bf4_to_f32(xr[k][j]) + g[j] * (pg8::bf4_to_f32(y0r[k][j]) + pg8::bf4_to_f32(y1r[k][j])); ss += (v[j].x * v[j].x + v[j].y * v[j].y) + (v[j].z * v[j].z + v[j].w * v[j].w); }
            const float rstd = 1.0f / sqrtf(wave_sum(ss) * (1.0f / D) + EPS);
            float* xo = a.out + (size_t)(m0 + k) * D;
#pragma unroll
            for (int j = 0; j < 4; ++j) *(f32x4*)(xo + 4 * lane + 256 * j) = (v[j] * rstd) * wv[j]; }
    }
}
__device__ __forceinline__ void ph_final(const Args& a, const Wg& w) {
    const int lane = w.lane; const float* fw = a.in[22]; const bf16* XRES = WS_PTR(bf16, WS_XRES);
    for (int m = w.gw; m < NL; m += w.NGW) {
        float* xr = a.out + (size_t)m * D;
        f32x4 v[4]; float ss = 0.f;
#pragma unroll
        for (int j = 0; j < 4; ++j) { v[j] = pg8::bf4_to_f32(*(const pg8::u32x2_t*)(XRES + (size_t)m * D + 4 * lane + 256 * j)); ss += (v[j].x * v[j].x + v[j].y * v[j].y) + (v[j].z * v[j].z + v[j].w * v[j].w); }
        const float rstd = 1.0f / sqrtf(wave_sum(ss) * (1.0f / D) + EPS);
#pragma unroll
        for (int j = 0; j < 4; ++j) { const int c = 4 * lane + 256 * j; *(f32x4*)(xr + c) = (v[j] * rstd) * *(const f32x4*)(fw + c); }
    }
}

constexpr int NPH = 23;
__global__ void __launch_bounds__(NTHR, 2) fwd_kernel(Args args) {
    extern __shared__ __attribute__((aligned(16))) unsigned char lds_raw[];
    Wg w; w.lds = (LAS unsigned char*)lds_raw;
    volatile LAS unsigned* MISC = (volatile LAS unsigned*)(w.lds + MISC_OFF);
    w.wave = __builtin_amdgcn_readfirstlane((int)threadIdx.x >> 6); w.lane = (int)__builtin_amdgcn_mbcnt_hi(~0u, __builtin_amdgcn_mbcnt_lo(~0u, 0u)); w.tid = w.wave * 64 + w.lane;
    w.G = gridDim.x; w.bx = blockIdx.x; w.gw = w.bx * NWAVES + w.wave; w.NGW = w.G * NWAVES;
    unsigned* ctl = (unsigned*)(args.ws + WS_CTL);
    for (int u = w.tid; u < (LDS_BYTES - LDSCTL_OFF) / 4; u += NTHR) ((LAS unsigned*)(w.lds + LDSCTL_OFF))[u] = 0u;
    __syncthreads();
    XcdBarrier bar; bar.bar = ctl + CW_BAR; bar.x = 0; bar.st = nullptr;
    if (!MK_MULTI) bar = xcd_barrier_post(ctl + CW_BAR, MISC + 8);
    const int lo = args.ph_lo, hi = args.ph_hi;
#define PH(id, call) do { if (lo <= (id) && (id) < hi) { call; if (!MK_MULTI && (id) + 1 < hi) xcd_barrier(bar); } } while (0)
#define PHR(n, id, call) do { if ((n) > 1) { call; xcd_barrier(bar); } PH(id, call); } while (0)
    PHR(REP_PRO, 0, ph_prologue(args, w));
    PH(1, ph_modfin(args, w));
    PHR(REP_NORM, 2, (ph_norm(args, w, 0, 0), ph_quant(args, w)));
    PHR(REP_GIN, 3, ph_gin(args, w, 0));
    if (REP_MIXA > 1) { ph_mix_a(args, w, 0, 1, REP_MASK); xcd_barrier(bar); }
    PH(4, ph_mix_a(args, w, 0));
    PH(5, ph_gla_scan(args, w));
    if (REP_MIXC > 1) { ph_mix_c(args, w, 0, 1, REP_MASK); xcd_barrier(bar); }
    PH(6, ph_mix_c(args, w, 0));
    PHR(REP_GOUT, 7, ph_gout(args, w, 0));
    PHR(REP_NORM, 8, ph_norm(args, w, 0, 1));
    PHR(REP_FUP, 9, ph_fup(args, w));
    PH(10, ph_fdn(args, w));
    PHR(REP_NORM, 11, ph_norm(args, w, 1, 0));
    PHR(REP_GIN, 12, ph_gin(args, w, 1));
    if (REP_MIXA > 1) { ph_mix_a(args, w, 1, 1, REP_MASK); xcd_barrier(bar); }
    PH(13, ph_mix_a(args, w, 1));
    PH(14, ph_gla_scan(args, w));
    if (REP_MIXC > 1) { ph_mix_c(args, w, 1, 1, REP_MASK); xcd_barrier(bar); }
    PH(15, ph_mix_c(args, w, 1));
    PH(16, ph_gout(args, w, 1));
    PHR(REP_NORM, 17, ph_norm(args, w, 1, 1));
    PHR(REP_PRO, 18, (ph_route(args, w), conv_items(args, w, 1 << 30)));
    if (REP_MUP > 1) { ph_mup(args, w, REP_VAR); xcd_barrier(bar); } PH(19, ph_mup(args, w));
#if MDN_MERGE
    PH(20, ph_mdn2(args, w));
    PH(21, ph_final2(args, w));
#else
    PH(20, ph_mdn(args, w, 0));
    PH(21, ph_mdn(args, w, 1));
    PH(22, ph_final(args, w));
#endif
#undef PH
#undef PHR
}

extern "C" void kernel_launch(void* const* d_in, const int* in_sizes, int n_in, void* d_out, int out_size, void* d_ws, size_t ws_size, hipStream_t stream) {
    static int grid = 0;
    if (grid == 0) {
        if (n_in != 23 || out_size != NL * D || ws_size < WS_END) { fprintf(stderr, "kernel_launch: unexpected shapes (n_in %d, out %d, ws %zu < %zu); nothing launched\n", n_in, out_size, ws_size, (size_t)WS_END); grid = -1; return; }
        int dev = 0, cus = 0, per_cu = 0;
        if (hipGetDevice(&dev) != hipSuccess || hipDeviceGetAttribute(&cus, hipDeviceAttributeMultiprocessorCount, dev) != hipSuccess) { grid = -1; return; }
        if (hipFuncSetAttribute((const void*)fwd_kernel, hipFuncAttributeMaxDynamicSharedMemorySize, LDS_BYTES) != hipSuccess) { fprintf(stderr, "kernel_launch: hipFuncSetAttribute failed\n"); grid = -1; return; }
        if (hipOccupancyMaxActiveBlocksPerMultiprocessor(&per_cu, (const void*)fwd_kernel, NTHR, LDS_BYTES) != hipSuccess || per_cu < 1) { fprintf(stderr, "kernel_launch: occupancy query says %d blocks per CU\n", per_cu); }
        (void)hipGetLastError();
        grid = cus;
    }
    if (grid < 0) return;
    if (hipMemsetAsync((char*)d_ws + WS_CTL, 0, CTL_ZERO_BYTES, stream) != hipSuccess) { fprintf(stderr, "kernel_launch: memset failed\n"); return; }
    Args a{};
    for (int i = 0; i < 23; ++i) a.in[i] = (const float*)d_in[i];
    a.out = (float*)d_out; a.ws = (unsigned char*)d_ws; a.pad = 0;
#if MK_MULTI
    for (int p = 0; p < NPH; ++p) { a.ph_lo = p; a.ph_hi = p + 1; a.li = p; hipLaunchKernelGGL(fwd_kernel, dim3(grid), dim3(NTHR), LDS_BYTES, stream, a); }
#else
    a.ph_lo = 0; a.ph_hi = MDN_MERGE ? 22 : NPH; a.li = 0;
    hipLaunchKernelGGL(fwd_kernel, dim3(grid), dim3(NTHR), LDS_BYTES, stream, a);
#endif
    const hipError_t le = hipPeekAtLastError();
    if (le != hipSuccess) fprintf(stderr, "kernel_launch: launch failed: %s\n", hipGetErrorName(le));
}
```

```cpp
#include <hip/hip_runtime.h>
#include <cstdio>
#include <cstdint>

#ifndef CONV_Q_GIN
#define CONV_Q_GIN 4
#define CONV_Q_GOUT 8
#define CONV_Q_FUP 4
#define CONV_Q_FDN 7
#endif
#ifndef REP_GIN
#define REP_GIN 1
#endif
#ifndef REP_GOUT
#define REP_GOUT 1
#endif
#ifndef REP_FUP
#define REP_FUP 1
#endif
#ifndef REP_MUP
#define REP_MUP 1
#endif
#ifndef REP_GEMM
#define REP_GEMM 1
#endif
#ifndef REP_NORM
#define REP_NORM 1
#endif
#ifndef REP_MIXA
#define REP_MIXA 1
#endif
#ifndef REP_VAR
#define REP_VAR 0
#endif
#ifndef REP_MASK
#define REP_MASK 7
#endif
#ifndef REP_MIXC
#define REP_MIXC 1
#endif
#ifndef REP_PRO
#define REP_PRO 1
#endif
#ifndef I8_GIN
#define I8_GIN 1
#endif
#ifndef I8_FUP
#define I8_FUP 1
#endif
#ifndef FP8_FUP
#define FP8_FUP 0
#endif
#ifndef FP8_FDN
#define FP8_FDN 1
#endif
#ifndef MK_MULTI
#define MK_MULTI 0
#endif

constexpr int D = 1024, NB = 8, SEQ = 4096, CTXL = 256;
constexpr int NL = NB * SEQ;
constexpr int NC = NB * CTXL;
constexpr int MT = NL + NC;
constexpr int INW = 2080, INP = 2304;
constexpr int DFF = 2816, EFF = 3584, NE = 8;
constexpr int MOD6 = 6 * D;
constexpr float EPS = 1e-6f;
constexpr float FP8_SH = 16.0f, FP8_SW = 512.0f, FP8_SHID = 8.0f;
constexpr int PC_U = 0, PC_Q = 512, PC_K = 768, PC_V = 1024, PC_G = 1536, PC_LF = 2048, PC_LB = 2064;

namespace pg8 {
#define PG8_LAS __attribute__((address_space(3)))
typedef unsigned short bf16_t;
typedef short bf16x8 __attribute__((ext_vector_type(8)));
typedef float f32x4 __attribute__((ext_vector_type(4)));
typedef unsigned u32x4 __attribute__((ext_vector_type(4)));
constexpr int BM = 256, BK = 64, HALF = 128, HTB = HALF * BK * 2, STAGE_BYTES = 8 * HTB, NXCD = 8, WGM = 8;

__host__ __device__ __forceinline__ int lds_byte(int r, int c) { const int st = (r >> 4) * 2 + (c >> 5), rr = r & 15, cc = c & 31, ob = rr * 64 + cc * 2; return st * 1024 + (ob ^ (((ob >> 9) & 1) << 5)); }
__host__ __device__ __forceinline__ void stage_rc(int b, int& R, int& C) { const int st = b / 1024, sb = b % 1024, swz = sb ^ (((sb >> 9) & 1) << 5); R = (st >> 1) * 16 + swz / 64; C = (st & 1) * 32 + (swz % 64) / 2; }
__host__ __device__ __forceinline__ int perm32(int rho) { const int n = rho >> 4, i = rho & 15; return 8 * (i >> 2) + 4 * n + (i & 3); }

struct Unit { int pm, pn; const char* a; const char* b; const int* ridx; };

__device__ __forceinline__ const char* uptr(const char* p) { const unsigned long long v = (unsigned long long)p; const unsigned lo = __builtin_amdgcn_readfirstlane((unsigned)v), hi = __builtin_amdgcn_readfirstlane((unsigned)(v >> 32)); return (const char*)(((unsigned long long)hi << 32) | lo); }
__device__ __forceinline__ void glds_s(const char* base, unsigned voff, unsigned lds_dst) { unsigned keep;
    asm volatile("s_mov_b32 %0, m0\n\ts_mov_b32 m0, %3\n\ts_nop 0\n\tglobal_load_lds_dwordx4 %1, %2\n\ts_mov_b32 m0, %0" : "=&s"(keep) : "v"(voff), "s"((unsigned long long)base), "s"(lds_dst) : "memory"); }
struct OrderCore {
    int nM, nN, nwg, G, c;
    __device__ __forceinline__ void init(int nM_, int nN_, int G_, int c_) { nM = nM_; nN = nN_; nwg = nM * nN; G = G_; c = c_; }
    __device__ __forceinline__ bool tile(int i, int& pm, int& pn) const {
        const long L = (long)i * G + c; if (L >= nwg) return false;
        int wgid = (int)L; { const int q = nwg / NXCD, r = nwg % NXCD, xcd = wgid % NXCD, off = wgid / NXCD; wgid = (xcd < r ? xcd * (q + 1) : r * (q + 1) + (xcd - r) * q) + off; }
        const int nig = WGM * nN, gid = wgid / nig, fm = gid * WGM, gsz = (nM - fm) < WGM ? (nM - fm) : WGM;
        pm = fm + ((wgid % nig) % gsz); pn = (wgid % nig) / gsz; return true;
    }
};
struct DenseOrder {
    OrderCore oc; const char* A; const char* Bt; size_t tstep;
    __device__ __forceinline__ void init(const bf16_t* A_, const bf16_t* Bt_, int M, int N, int K, int G, int c) { oc.init(M / BM, N / BM, G, c); A = (const char*)A_; Bt = (const char*)Bt_; tstep = (size_t)BM * K * 2; }
    __device__ __forceinline__ bool next(int i, Unit& u) const { if (!oc.tile(i, u.pm, u.pn)) return false; u.pm = __builtin_amdgcn_readfirstlane(u.pm); u.pn = __builtin_amdgcn_readfirstlane(u.pn); u.a = uptr(A + (size_t)u.pm * tstep); u.b = uptr(Bt + (size_t)u.pn * tstep); u.ridx = nullptr; return true; }
};
struct MoeOrder {
    OrderCore oc; const char* A; const char* Bt; size_t tstepA, tstepB, estride; const int* texp; const int* ridx; int nt0, gap;
    __device__ __forceinline__ bool next(int i, Unit& u) const { if (!oc.tile(i, u.pm, u.pn)) return false;
        u.pm = u.pm < nt0 ? u.pm : u.pm + gap;
        const int e = __builtin_amdgcn_readfirstlane(__hip_atomic_load(texp + u.pm, __ATOMIC_RELAXED, __HIP_MEMORY_SCOPE_AGENT));
        u.pm = __builtin_amdgcn_readfirstlane(u.pm); u.pn = __builtin_amdgcn_readfirstlane(u.pn); u.a = uptr(A + (size_t)u.pm * tstepA); u.b = uptr(Bt + (size_t)e * estride + (size_t)u.pn * tstepB); u.ridx = (const int*)uptr((const char*)(ridx + u.pm * BM)); return true; }
};

typedef int v4i_t __attribute__((ext_vector_type(4)));
typedef int v8i_t __attribute__((ext_vector_type(8)));
__device__ __forceinline__ v8i_t cat8(const bf16x8 lo, const bf16x8 hi) { const v4i_t a = __builtin_bit_cast(v4i_t, lo), b = __builtin_bit_cast(v4i_t, hi); return __builtin_shufflevector(a, b, 0, 1, 2, 3, 4, 5, 6, 7); }
__device__ __forceinline__ void mfma8(f32x4& acc, const v8i_t a, const v8i_t b, const int sc) {
    asm volatile("v_mfma_scale_f32_16x16x128_f8f6f4 %0, %1, %2, %0, %3, %3 op_sel_hi:[0,0,0]" : "+v"(acc) : "v"(a), "v"(b), "v"(sc)); }
__device__ __forceinline__ unsigned pk4_fp8_raw(float a, float b, float c, float d) { int r = __builtin_amdgcn_cvt_pk_fp8_f32(a, b, 0, false); r = __builtin_amdgcn_cvt_pk_fp8_f32(c, d, r, true); return (unsigned)r; }
__device__ __forceinline__ unsigned pk4_fp8(float a, float b, float c, float d) { return pk4_fp8_raw(__builtin_amdgcn_fmed3f(a, -448.f, 448.f), __builtin_amdgcn_fmed3f(b, -448.f, 448.f), __builtin_amdgcn_fmed3f(c, -448.f, 448.f), __builtin_amdgcn_fmed3f(d, -448.f, 448.f)); }
__device__ __forceinline__ float clamp448(float v) { return __builtin_fminf(__builtin_fmaxf(v, -448.0f), 448.0f); }
__device__ __forceinline__ unsigned cvt_pk_bf16(float lo, float hi) { unsigned r; asm volatile("v_cvt_pk_bf16_f32 %0, %1, %2" : "=v"(r) : "v"(lo), "v"(hi)); return r; }

struct EpiBf16 {
    static constexpr bool PERM = true;
    bf16_t* O; int ldc;
    __device__ __forceinline__ void operator()(const f32x4 (&acc)[2][2][4][2], const Unit& u, int wr, int wc, int fr, int fq) const {
        const int row0 = u.pm * BM + wr * 64 + fr, col0 = u.pn * BM + wc * 32 + 8 * fq;
#pragma unroll
        for (int ai = 0; ai < 2; ++ai)
#pragma unroll
            for (int m = 0; m < 4; ++m) { bf16_t* rowp = O + (size_t)(row0 + ai * HALF + m * 16) * ldc + col0;
#pragma unroll
                for (int bj = 0; bj < 2; ++bj) { const f32x4 v0 = acc[ai][bj][m][0], v1 = acc[ai][bj][m][1];
                    u32x4 w; w.x = cvt_pk_bf16(v0[0], v0[1]); w.y = cvt_pk_bf16(v0[2], v0[3]); w.z = cvt_pk_bf16(v1[0], v1[1]); w.w = cvt_pk_bf16(v1[2], v1[3]);
                    *(u32x4*)(rowp + bj * HALF) = w; } }
    }
};
__device__ __forceinline__ float silu_f(float a) { return a * __builtin_amdgcn_rcpf(1.0f + __builtin_amdgcn_exp2f(a * -1.4426950408889634f)); }
struct EpiSwiGLU {
    static constexpr bool PERM = true;
    bf16_t* O; int ldc; float inv;
    __device__ __forceinline__ void operator()(const f32x4 (&acc)[2][2][4][2], const Unit& u, int wr, int wc, int fr, int fq) const {
        const int row0 = u.pm * BM + wr * 64 + fr, col0 = u.pn * HALF + wc * 32 + 8 * fq;
#pragma unroll
        for (int ai = 0; ai < 2; ++ai)
#pragma unroll
            for (int m = 0; m < 4; ++m) { bf16_t* rowp = O + (size_t)(row0 + ai * HALF + m * 16) * ldc + col0;
                float h[8]; typedef float f2 __attribute__((ext_vector_type(2)));
                const float kexp = inv * -1.4426950408889634f, c0 = 1.0f / (inv * inv), lc0 = __builtin_log2f(c0);
#pragma unroll
                for (int n = 0; n < 2; ++n)
#pragma unroll
                    for (int j = 0; j < 4; j += 2) { const f2 a1 = {acc[ai][0][m][n][j], acc[ai][0][m][n][j + 1]}, a3 = {acc[ai][1][m][n][j], acc[ai][1][m][n][j + 1]};
                        const f2 t = a1 * kexp + lc0; f2 d; d.x = __builtin_amdgcn_exp2f(t.x); d.y = __builtin_amdgcn_exp2f(t.y); d = d + c0;
                        f2 rr; rr.x = __builtin_amdgcn_rcpf(d.x); rr.y = __builtin_amdgcn_rcpf(d.y); const f2 hv = (a1 * a3) * rr; h[4 * n + j] = hv.x; h[4 * n + j + 1] = hv.y; }
                u32x4 w; w.x = cvt_pk_bf16(h[0], h[1]); w.y = cvt_pk_bf16(h[2], h[3]); w.z = cvt_pk_bf16(h[4], h[5]); w.w = cvt_pk_bf16(h[6], h[7]);
                *(u32x4*)rowp = w; }
    }
};
struct EpiSwiGLU8 {
    static constexpr bool PERM = true;
    unsigned char* O; int ldc; float inv, oscale; int skip;
    __device__ __forceinline__ void operator()(const f32x4 (&acc)[2][2][4][2], const Unit& u, int wr, int wc, int fr, int fq) const {
        if (skip) return;
        const int row0 = u.pm * BM + wr * 64 + fr, col0 = u.pn * HALF + wc * 32 + 8 * fq;
        const float kexp = inv * -1.4426950408889634f, c0 = 1.0f / (inv * inv * oscale), lc0 = __builtin_log2f(c0);
        typedef unsigned u32x2 __attribute__((ext_vector_type(2))); typedef float f2 __attribute__((ext_vector_type(2)));
#pragma unroll
        for (int ai = 0; ai < 2; ++ai)
#pragma unroll
            for (int m = 0; m < 4; ++m) { unsigned char* rowp = O + (size_t)(row0 + ai * HALF + m * 16) * ldc + col0;
                float h[8];
#pragma unroll
                for (int n = 0; n < 2; ++n)
#pragma unroll
                    for (int j = 0; j < 4; j += 2) { const f2 a1 = {acc[ai][0][m][n][j], acc[ai][0][m][n][j + 1]}, a3 = {acc[ai][1][m][n][j], acc[ai][1][m][n][j + 1]};
                        const f2 t = a1 * kexp + lc0; f2 d; d.x = __builtin_amdgcn_exp2f(t.x); d.y = __builtin_amdgcn_exp2f(t.y); d = d + c0;
                        f2 rr; rr.x = __builtin_amdgcn_rcpf(d.x); rr.y = __builtin_amdgcn_rcpf(d.y); const f2 hv = (a1 * a3) * rr;
                        h[4 * n + j] = __builtin_amdgcn_fmed3f(hv.x, -448.0f, 448.0f); h[4 * n + j + 1] = __builtin_amdgcn_fmed3f(hv.y, -448.0f, 448.0f); }
                *(u32x2*)rowp = (u32x2){pk4_fp8_raw(h[0], h[1], h[2], h[3]), pk4_fp8_raw(h[4], h[5], h[6], h[7])}; }
    }
};
typedef unsigned u32x2_t __attribute__((ext_vector_type(2)));
__device__ __forceinline__ f32x4 bf4_to_f32(const u32x2_t v) { f32x4 r; r.x = __uint_as_float(v.x << 16); r.y = __uint_as_float(v.x & 0xffff0000u); r.z = __uint_as_float(v.y << 16); r.w = __uint_as_float(v.y & 0xffff0000u); return r; }
__device__ __forceinline__ u32x2_t f32_to_bf4(const f32x4 v) { return (u32x2_t){cvt_pk_bf16(v.x, v.y), cvt_pk_bf16(v.z, v.w)}; }
struct EpiBf16i {
    static constexpr bool PERM = true;
    bf16_t* O; int ldc; const float* rowstep; const float* colstep;
    __device__ __forceinline__ void operator()(const f32x4 (&acc)[2][2][4][2], const Unit& u, int wr, int wc, int fr, int fq) const {
        const int row0 = u.pm * BM + wr * 64 + fr, col0 = u.pn * BM + wc * 32 + 8 * fq;
        f32x4 cs[2][2];
#pragma unroll
        for (int bj = 0; bj < 2; ++bj)
#pragma unroll
            for (int n = 0; n < 2; ++n) cs[bj][n] = *(const f32x4*)(colstep + col0 + bj * HALF + 4 * n);
#pragma unroll
        for (int ai = 0; ai < 2; ++ai)
#pragma unroll
            for (int m = 0; m < 4; ++m) { const int row = row0 + ai * HALF + m * 16; bf16_t* rowp = O + (size_t)row * ldc + col0; const float rs = rowstep[row];
#pragma unroll
                for (int bj = 0; bj < 2; ++bj) { float v[8];
#pragma unroll
                    for (int n = 0; n < 2; ++n)
#pragma unroll
                        for (int j = 0; j < 4; ++j) { const float x = acc[ai][bj][m][n][j]; v[4 * n + j] = (float)__float_as_int(x) * (rs * cs[bj][n][j]); }
                    u32x4 w; w.x = cvt_pk_bf16(v[0], v[1]); w.y = cvt_pk_bf16(v[2], v[3]); w.z = cvt_pk_bf16(v[4], v[5]); w.w = cvt_pk_bf16(v[6], v[7]);
                    *(u32x4*)(rowp + bj * HALF) = w; } }
    }
};
struct EpiSwiGLU8i {
    static constexpr bool PERM = true;
    unsigned char* O; int ldc; const float* rowstep; const float* step1; const float* step3; float oscale;
    __device__ __forceinline__ void operator()(const f32x4 (&acc)[2][2][4][2], const Unit& u, int wr, int wc, int fr, int fq) const {
        const int row0 = u.pm * BM + wr * 64 + fr, col0 = u.pn * HALF + wc * 32 + 8 * fq;
        typedef unsigned u32x2 __attribute__((ext_vector_type(2))); typedef float f2 __attribute__((ext_vector_type(2)));
        f32x4 c1[2], c3[2];
#pragma unroll
        for (int n = 0; n < 2; ++n) { c1[n] = *(const f32x4*)(step1 + col0 + 4 * n) * -1.4426950408889634f; c3[n] = *(const f32x4*)(step3 + col0 + 4 * n) * (oscale * -0.6931471805599453f); }
#pragma unroll
        for (int ai = 0; ai < 2; ++ai)
#pragma unroll
            for (int m = 0; m < 4; ++m) { const int row = row0 + ai * HALF + m * 16; unsigned char* rowp = O + (size_t)row * ldc + col0; const float rs = rowstep[row];
                float h[8];
#pragma unroll
                for (int n = 0; n < 2; ++n)
#pragma unroll
                    for (int j = 0; j < 4; j += 2) { const float x0 = acc[ai][0][m][n][j], x1 = acc[ai][0][m][n][j + 1], y0 = acc[ai][1][m][n][j], y1 = acc[ai][1][m][n][j + 1];
                        const f2 t = (f2){(float)__float_as_int(x0), (float)__float_as_int(x1)} * ((f2){c1[n][j], c1[n][j + 1]} * rs);
                        const f2 b = (f2){(float)__float_as_int(y0), (float)__float_as_int(y1)} * ((f2){c3[n][j], c3[n][j + 1]} * rs);
                        f2 d; d.x = __builtin_amdgcn_exp2f(t.x); d.y = __builtin_amdgcn_exp2f(t.y); d = d + 1.0f;
                        f2 rr; rr.x = __builtin_amdgcn_rcpf(d.x); rr.y = __builtin_amdgcn_rcpf(d.y); const f2 hv = (t * b) * rr;
                        h[4 * n + j] = __builtin_amdgcn_fmed3f(hv.x, -448.0f, 448.0f); h[4 * n + j + 1] = __builtin_amdgcn_fmed3f(hv.y, -448.0f, 448.0f); }
                *(u32x2*)rowp = (u32x2){pk4_fp8_raw(h[0], h[1], h[2], h[3]), pk4_fp8_raw(h[4], h[5], h[6], h[7])}; }
    }
};
struct EpiRes {
    static constexpr bool PERM = true;
    const float* srcL; const float* srcC; bf16_t* xres; const float* gate; float oscale;
    __device__ __forceinline__ void operator()(const f32x4 (&acc)[2][2][4][2], const Unit& u, int wr, int wc, int fr, int fq) const {
        const int pm = u.pm; const bool isc = pm >= 128; const int bidx = isc ? 8 : (pm >> 4);
        const float* s = srcL ? (isc ? srcC + (size_t)(pm - 128) * BM * D : srcL + (size_t)pm * BM * D) : nullptr;
        bf16_t* d = xres + (size_t)pm * BM * D;
        const int col0 = u.pn * BM + wc * 32 + 8 * fq; const float* gv = gate + bidx * MOD6 + col0;
        f32x4 g[2][2];
#pragma unroll
        for (int bj = 0; bj < 2; ++bj)
#pragma unroll
            for (int n = 0; n < 2; ++n) g[bj][n] = *(const f32x4*)(gv + bj * HALF + 4 * n) * oscale;
        if (s) {
#pragma unroll
            for (int am = 0; am < 4; ++am) { const int ai = am >> 1, m0 = (am & 1) * 2; f32x4 x[2][2][2];
#pragma unroll
                for (int mm = 0; mm < 2; ++mm)
#pragma unroll
                    for (int bj = 0; bj < 2; ++bj)
#pragma unroll
                        for (int n = 0; n < 2; ++n) x[mm][bj][n] = *(const f32x4*)(s + (size_t)(wr * 64 + fr + ai * HALF + (m0 + mm) * 16) * D + col0 + bj * HALF + 4 * n);
#pragma unroll
                for (int mm = 0; mm < 2; ++mm)
#pragma unroll
                    for (int bj = 0; bj < 2; ++bj) { const int m = m0 + mm; const u32x2_t p0 = f32_to_bf4(x[mm][bj][0] + g[bj][0] * acc[ai][bj][m][0]), p1 = f32_to_bf4(x[mm][bj][1] + g[bj][1] * acc[ai][bj][m][1]);
                        *(u32x4*)(d + (size_t)(wr * 64 + fr + ai * HALF + m * 16) * D + col0 + bj * HALF) = (u32x4){p0.x, p0.y, p1.x, p1.y}; }
                asm volatile("" ::: "memory"); }
        } else {
#pragma unroll
            for (int ai = 0; ai < 2; ++ai) { u32x4 x[4][2];
#pragma unroll
                for (int m = 0; m < 4; ++m)
#pragma unroll
                    for (int bj = 0; bj < 2; ++bj) x[m][bj] = *(const u32x4*)(d + (size_t)(wr * 64 + fr + ai * HALF + m * 16) * D + col0 + bj * HALF);
#pragma unroll
                for (int m = 0; m < 4; ++m)
#pragma unroll
                    for (int bj = 0; bj < 2; ++bj) { const u32x4 xv = x[m][bj];
                        const u32x2_t p0 = f32_to_bf4(bf4_to_f32((u32x2_t){xv.x, xv.y}) + g[bj][0] * acc[ai][bj][m][0]), p1 = f32_to_bf4(bf4_to_f32((u32x2_t){xv.z, xv.w}) + g[bj][1] * acc[ai][bj][m][1]);
                        *(u32x4*)(d + (size_t)(wr * 64 + fr + ai * HALF + m * 16) * D + col0 + bj * HALF) = (u32x4){p0.x, p0.y, p1.x, p1.y}; }
                asm volatile("" ::: "memory"); }
        }
    }
};
struct EpiScatter {
    static constexpr bool PERM = false;
    const int* ridx; const float* rgate; bf16_t* xres; const float* gate; float oscale;
    __device__ __forceinline__ void operator()(const f32x4 (&acc)[2][2][4][2], const Unit& u, int wr, int wc, int fr, int fq) const {
        const int col0 = u.pn * BM + wc * 32 + 4 * fq;
#pragma unroll
        for (int ai = 0; ai < 2; ++ai)
#pragma unroll
            for (int m = 0; m < 4; ++m) { const int rs = u.pm * BM + wr * 64 + fr + ai * HALF + m * 16; const int tok = ridx[rs];
                if (tok >= 0) { const float gt = rgate[rs] * oscale; const float* gv = gate + (tok >> 12) * MOD6 + col0; bf16_t* d = xres + (size_t)tok * D + col0;
#pragma unroll
                    for (int bj = 0; bj < 2; ++bj)
#pragma unroll
                        for (int n = 0; n < 2; ++n) { const f32x4 g = *(const f32x4*)(gv + bj * HALF + n * 16); const f32x4 x = bf4_to_f32(*(const u32x2_t*)(d + bj * HALF + n * 16));
                            *(u32x2_t*)(d + bj * HALF + n * 16) = f32_to_bf4(x + (g * gt) * acc[ai][bj][m][n]); } }
                asm volatile("" ::: "memory"); }
    }
};

struct MoeOrderRM {
    int nwg, G, c; const char* A; const char* Bt; size_t tstepA, tstepB, estride; const int* texp; int nt0, gap;
    __device__ __forceinline__ bool next(int i, Unit& u) const {
        const int wgid = (G & 7) ? i * G + c : i * G + (c & 7) * (G >> 3) + (c >> 3); if (wgid >= nwg) return false;
        int pm = wgid >> 2; const int pn = wgid & 3; pm = pm < nt0 ? pm : pm + gap;
        const int e = __builtin_amdgcn_readfirstlane(__hip_atomic_load(texp + pm, __ATOMIC_RELAXED, __HIP_MEMORY_SCOPE_AGENT));
        u.pm = __builtin_amdgcn_readfirstlane(pm); u.pn = __builtin_amdgcn_readfirstlane(pn); u.a = uptr(A + (size_t)u.pm * tstepA); u.b = uptr(Bt + (size_t)e * estride + (size_t)u.pn * tstepB); u.ridx = nullptr; return true; }
};
typedef unsigned u32x4_t __attribute__((ext_vector_type(4)));
struct EpiY {
    static constexpr bool PERM = true;
    const float* rgate; bf16_t* y0; bf16_t* y1a; bf16_t* y1b; float oscale; int t1, psplit;
    __device__ __forceinline__ void operator()(const f32x4 (&acc)[2][2][4][2], const Unit& u, int wr, int wc, int fr, int fq) const {
        const int col0 = u.pn * BM + wc * 32 + 8 * fq; const bool s1 = u.pm >= t1; const int p = s1 ? u.pm - t1 : u.pm;
        bf16_t* base = (s1 ? (p < psplit ? y1a + (size_t)p * BM * D : y1b + (size_t)(p - psplit) * BM * D) : y0 + (size_t)p * BM * D) + col0;
        float gt[2][4];
#pragma unroll
        for (int ai = 0; ai < 2; ++ai)
#pragma unroll
            for (int m = 0; m < 4; ++m) gt[ai][m] = rgate[u.pm * BM + wr * 64 + fr + ai * HALF + m * 16] * oscale;
#pragma unroll
        for (int ai = 0; ai < 2; ++ai)
#pragma unroll
            for (int m = 0; m < 4; ++m) { bf16_t* d = base + (size_t)(wr * 64 + fr + ai * HALF + m * 16) * D;
#pragma unroll
                for (int bj = 0; bj < 2; ++bj) { const u32x2_t p0 = f32_to_bf4(acc[ai][bj][m][0] * gt[ai][m]), p1 = f32_to_bf4(acc[ai][bj][m][1] * gt[ai][m]);
                    *(u32x4_t*)(d + bj * HALF) = (u32x4_t){p0.x, p0.y, p1.x, p1.y}; } }
    }
};

template <class Epi, class Sched, bool ALIGN_EPI, bool GATHER, int MODE = 0  >
__device__ __forceinline__ void gemm_phase(PG8_LAS unsigned char* lds, const int K, const Sched& S, const Epi& E) {
    constexpr bool FP8 = (MODE == 1);
    const int wid = __builtin_amdgcn_readfirstlane((int)threadIdx.x >> 6), lane = (int)__builtin_amdgcn_mbcnt_hi(~0u, __builtin_amdgcn_mbcnt_lo(~0u, 0u)), tid = wid * 64 + lane, wr = wid >> 2, wc = wid & 3, fr = lane & 15, fq = lane >> 4;
    const int nt = K / BK;
    unsigned voffA[2], voffB[2];
#pragma unroll
    for (int i = 0; i < 2; ++i) { int R, C; stage_rc(tid * 16 + i * 8192, R, C); const int Rb = Epi::PERM ? ((R & ~31) + perm32(R & 31)) : R;
        voffA[i] = (unsigned)(R * K + C) * 2u; voffB[i] = (unsigned)(Rb * K + C) * 2u; }
    const size_t kstep = (size_t)(BK * 2);
    const size_t hstep = (size_t)HALF * K * 2;
    const unsigned ldsw = (unsigned)wid * 1024u;
    const unsigned ldsb = __builtin_amdgcn_readfirstlane((unsigned)(size_t)lds + ldsw);
    const int aoff = lds_byte(wr * 64 + fr, fq * 8), boff = lds_byte(wc * 32 + fr, fq * 8);
    unsigned vAc[2][2], vAn[2][2];
#define PG8_SA(b, h) (((b) * 2 + (h)) * HTB)
#define PG8_SB(b, h) ((4 + (b) * 2 + (h)) * HTB)
#define PG8_STAGE(bufoff, gbase, voff) do { const char* _g = uptr((const char*)(gbase)); _Pragma("unroll") for (int _i = 0; _i < 2; ++_i) \
        glds_s(_g, (voff)[_i], ldsb + (unsigned)((bufoff) + _i * 8192)); } while (0)
#define PG8_STAGE_A(bufoff, NXT, kb, h) do { if constexpr (GATHER) { const char* _ga = uptr(gA + (kb)); _Pragma("unroll") for (int _i = 0; _i < 2; ++_i) { const unsigned _v = (NXT) ? vAn[h][_i] : vAc[h][_i]; \
        glds_s(_ga, _v, ldsb + (unsigned)((bufoff) + _i * 8192)); } } \
        else { const char* _b = ((NXT) ? nA : cA) + (kb) + (h) * hstep; PG8_STAGE(bufoff, _b, voffA); } } while (0)
#define PG8_LDA(dst, b, h) do { if constexpr (FP8) { _Pragma("unroll") for (int m = 0; m < 4; ++m) dst##8[m] = cat8(*(const PG8_LAS bf16x8*)(lds + PG8_SA(b, h) + aoff + m * 2048), *(const PG8_LAS bf16x8*)(lds + PG8_SA(b, h) + aoff + m * 2048 + 1024)); } \
        else { _Pragma("unroll") for (int m = 0; m < 4; ++m) _Pragma("unroll") for (int k = 0; k < 2; ++k) dst[m][k] = *(const PG8_LAS bf16x8*)(lds + PG8_SA(b, h) + aoff + m * 2048 + k * 1024); } } while (0)
#define PG8_LDB(dst, b, h) do { if constexpr (FP8) { _Pragma("unroll") for (int n = 0; n < 2; ++n) dst##8[n] = cat8(*(const PG8_LAS bf16x8*)(lds + PG8_SB(b, h) + boff + n * 2048), *(const PG8_LAS bf16x8*)(lds + PG8_SB(b, h) + boff + n * 2048 + 1024)); } \
        else { _Pragma("unroll") for (int n = 0; n < 2; ++n) _Pragma("unroll") for (int k = 0; k < 2; ++k) dst[n][k] = *(const PG8_LAS bf16x8*)(lds + PG8_SB(b, h) + boff + n * 2048 + k * 1024); } } while (0)
#define PG8_MMA(ai, bj, At, Bt) do { __builtin_amdgcn_s_setprio(1); if constexpr (FP8) { _Pragma("unroll") for (int m = 0; m < 4; ++m) _Pragma("unroll") for (int n = 0; n < 2; ++n) \
        mfma8(acc[ai][bj][m][n], Bt##8[n], At##8[m], sc127); } \
        else if constexpr (MODE == 2) { _Pragma("unroll") for (int m = 0; m < 4; ++m) _Pragma("unroll") for (int n = 0; n < 2; ++n) _Pragma("unroll") for (int k = 0; k < 2; ++k) \
        acc[ai][bj][m][n] = __builtin_bit_cast(f32x4, __builtin_amdgcn_mfma_i32_16x16x64_i8(__builtin_bit_cast(v4i_t, Bt[n][k]), __builtin_bit_cast(v4i_t, At[m][k]), __builtin_bit_cast(v4i_t, acc[ai][bj][m][n]), 0, 0, 0)); } \
        else { _Pragma("unroll") for (int m = 0; m < 4; ++m) _Pragma("unroll") for (int n = 0; n < 2; ++n) _Pragma("unroll") for (int k = 0; k < 2; ++k) \
        acc[ai][bj][m][n] = __builtin_amdgcn_mfma_f32_16x16x32_bf16(Bt[n][k], At[m][k], acc[ai][bj][m][n], 0, 0, 0); } __builtin_amdgcn_s_setprio(0); } while (0)
#define PG8_WAIT_V(n) asm volatile("s_waitcnt vmcnt(" #n ")" ::: "memory")
#define PG8_WAIT_L(n) asm volatile("s_waitcnt lgkmcnt(" #n ")" ::: "memory")
#define PG8_BAR __builtin_amdgcn_s_barrier()
#define PG8_SCHED __builtin_amdgcn_sched_barrier(0)
#define PG8_GOFF(dst, un) do { _Pragma("unroll") for (int _i = 0; _i < 2; ++_i) { int _R, _C; stage_rc(tid * 16 + _i * 8192, _R, _C); _Pragma("unroll") for (int _h = 0; _h < 2; ++_h) { int _r = (un).ridx[_h * HALF + _R]; _r = _r < 0 ? 0 : _r; \
        dst[_h][_i] = (unsigned)(_r * K + _C) * 2u; } } } while (0)
    Unit cur, nxt; int ui = 0;
    if (!S.next(0, cur)) return;
    f32x4 acc[2][2][4][2];
#pragma unroll
    for (int a = 0; a < 2; ++a)
#pragma unroll
        for (int b = 0; b < 2; ++b)
#pragma unroll
            for (int m = 0; m < 4; ++m)
#pragma unroll
                for (int n = 0; n < 2; ++n) acc[a][b][m][n] = (f32x4){0.f, 0.f, 0.f, 0.f};
    int sc127 = 127; if constexpr (FP8) asm volatile("" : "+v"(sc127));
    bf16x8 At[4][2], B0[2][2], B1[2][2]; v8i_t At8[4], B08[2], B18[2];
    const char* gA = cur.a;
    const char* cA = cur.a; const char* cB = cur.b;
    if constexpr (GATHER) { PG8_GOFF(vAc, cur); }
    {   const char* nA = cA;
        PG8_STAGE(PG8_SB(0, 0), cB, voffB); PG8_STAGE(PG8_SB(0, 1), cB + hstep, voffB); PG8_STAGE_A(PG8_SA(0, 0), false, 0, 0); PG8_STAGE_A(PG8_SA(0, 1), false, 0, 1);
        if (wr == 1) PG8_BAR;
        PG8_WAIT_V(2); PG8_BAR;
        PG8_STAGE(PG8_SB(1, 0), cB + kstep, voffB); PG8_STAGE_A(PG8_SA(1, 0), false, kstep, 0); PG8_STAGE(PG8_SB(1, 1), cB + hstep + kstep, voffB);
        PG8_WAIT_V(6); PG8_BAR; }
    for (;;) {
        const bool has_next = S.next(ui + 1, nxt);
        const char* nA = has_next ? nxt.a : cA; const char* nB = has_next ? nxt.b : cB;
        if constexpr (GATHER) { if (has_next) { PG8_GOFF(vAn, nxt); } else {
#pragma unroll
            for (int h = 0; h < 2; ++h)
#pragma unroll
                for (int i = 0; i < 2; ++i) vAn[h][i] = vAc[h][i]; } }
#pragma unroll 1
        for (int t = 0; t < nt; t += 2) {
            const bool last = (t == nt - 2);
            const size_t kb1 = (size_t)(t + 1) * kstep;
            const size_t kb2 = last ? 0 : (size_t)(t + 2) * kstep, kb3 = kb2 + kstep;
            const char* b2 = last ? nB : cB + (size_t)(t + 2) * kstep; const char* b3 = b2 + kstep;
            PG8_LDB(B0, 0, 0); PG8_LDB(B1, 0, 1); PG8_SCHED; PG8_LDA(At, 0, 0); PG8_STAGE_A(PG8_SA(1, 1), false, kb1, 1);
            PG8_WAIT_V(8); PG8_WAIT_L(0); PG8_BAR; PG8_MMA(0, 0, At, B0); PG8_MMA(0, 1, At, B1); PG8_BAR; PG8_SCHED;
            PG8_LDA(At, 0, 1); PG8_STAGE(PG8_SB(0, 0), b2, voffB); PG8_STAGE(PG8_SB(0, 1), b2 + hstep, voffB); PG8_STAGE_A(PG8_SA(0, 0), last, kb2, 0);
            PG8_WAIT_V(8); PG8_WAIT_L(0); PG8_BAR; PG8_MMA(1, 0, At, B0); PG8_MMA(1, 1, At, B1); PG8_BAR; PG8_SCHED;
            PG8_LDB(B0, 1, 0); PG8_LDB(B1, 1, 1); PG8_SCHED; PG8_LDA(At, 1, 0); PG8_STAGE_A(PG8_SA(0, 1), last, kb2, 1);
            PG8_WAIT_V(8); PG8_WAIT_L(0); PG8_BAR; PG8_MMA(0, 0, At, B0); PG8_MMA(0, 1, At, B1); PG8_BAR; PG8_SCHED;
            PG8_LDA(At, 1, 1); PG8_STAGE(PG8_SB(1, 0), b3, voffB); PG8_STAGE(PG8_SB(1, 1), b3 + hstep, voffB); PG8_STAGE_A(PG8_SA(1, 0), last, kb3, 0);
            PG8_WAIT_V(8); PG8_WAIT_L(0); PG8_BAR; PG8_MMA(1, 0, At, B0); PG8_MMA(1, 1, At, B1); PG8_BAR; PG8_SCHED;
        }
        if constexpr (ALIGN_EPI) { if (wr == 0) PG8_BAR; }
        if constexpr (FP8) asm volatile("s_nop 15\n\ts_nop 15" ::: "memory");
        { int efr = fr, efq = fq; asm volatile("" : "+v"(efr), "+v"(efq));
          E(acc, cur, wr, wc, efr, efq); }
        if (!has_next) break;
#pragma unroll
        for (int a = 0; a < 2; ++a)
#pragma unroll
            for (int b = 0; b < 2; ++b)
#pragma unroll
                for (int m = 0; m < 4; ++m)
#pragma unroll
                    for (int n = 0; n < 2; ++n) acc[a][b][m][n] = (f32x4){0.f, 0.f, 0.f, 0.f};
        cur = nxt; cA = nA; cB = nB; ++ui;
        if constexpr (GATHER) {
#pragma unroll
            for (int h = 0; h < 2; ++h)
#pragma unroll
                for (int i = 0; i < 2; ++i) vAc[h][i] = vAn[h][i]; }
        if constexpr (ALIGN_EPI) { if (wr == 1) PG8_BAR; }
    }
    PG8_WAIT_V(0);
    if constexpr (!ALIGN_EPI) { if (wr == 0) PG8_BAR; }
    PG8_BAR;
#undef PG8_SA
#undef PG8_SB
#undef PG8_STAGE
#undef PG8_STAGE_A
#undef PG8_LDA
#undef PG8_LDB
#undef PG8_MMA
#undef PG8_WAIT_V
#undef PG8_WAIT_L
#undef PG8_BAR
#undef PG8_SCHED
#undef PG8_GOFF
}
}

constexpr int NWAVES = 8, NTHR = NWAVES * 64;
constexpr size_t MiB = 1u << 20;
constexpr int RT_TILES_C = 136;
constexpr size_t WS_CTL = 0, CTL_ZERO_BYTES = 1 * MiB;
constexpr size_t WS_MODP = 1 * MiB;
constexpr size_t WS_MODV = 5 * MiB;
constexpr size_t WS_ROUTE = 6 * MiB;
constexpr size_t WS_WIN = 8 * MiB;
constexpr size_t WS_WOUT = 17 * MiB;
constexpr size_t WS_W13 = 21 * MiB;
constexpr size_t WS_W2 = 32 * MiB;
constexpr size_t WS_MW13 = 38 * MiB;
constexpr size_t WS_MW2 = 94 * MiB;
constexpr size_t WS_CTXRES = 122 * MiB;
constexpr size_t WS_HBUF = 130 * MiB;
constexpr size_t WS_PBUF = 198 * MiB;
constexpr size_t WS_MIX = 351 * MiB;
constexpr size_t WS_XRES = 419 * MiB;
constexpr size_t WS_SLOC = 487 * MiB;
constexpr size_t WS_DTOT = 521 * MiB;
constexpr size_t WS_HID = 198 * MiB;
constexpr size_t WS_HID2 = 164 * MiB;
constexpr size_t WS_ZBUF = WS_HBUF;
constexpr size_t WS_XBC = WS_HBUF + 64 * MiB;
constexpr size_t WS_END = 522 * MiB;
static_assert(WS_HID + (size_t)MT * EFF <= WS_XRES && WS_HID + (size_t)MT * DFF * 2 <= WS_XRES && WS_MIX + (size_t)MT * D * 2 <= WS_XRES && WS_PBUF + (size_t)MT * INP * 2 <= WS_MIX && WS_HBUF + (size_t)MT * D * 2 <= WS_PBUF, "ws map");
static_assert(WS_HID2 + (size_t)2 * RT_TILES_C * 256 * EFF <= WS_XRES && WS_HBUF + (size_t)NL * D <= WS_HID2, "MoE hidden");
static_assert(WS_XRES + (size_t)MT * D * 2 <= WS_SLOC && (size_t)MT * 512 * 4 <= (size_t)NL * D * 4 && WS_SLOC + (size_t)64 * 17 * 8192 * 4 <= WS_DTOT && WS_DTOT + (size_t)64 * 17 * 64 * 4 <= WS_END, "GLA scratch");
static_assert(WS_MW2 + (size_t)NE * D * EFF <= WS_CTXRES && WS_MW13 + (size_t)NE * 2 * EFF * D <= WS_MW2 && WS_W13 + (size_t)2 * DFF * D * 2 <= WS_W2 && WS_W2 + (size_t)D * DFF * 2 <= WS_MW13 && WS_CTXRES + (size_t)NC * D * 4 <= WS_HBUF, "ws map 2");
constexpr int RT_TILES = 136;
constexpr size_t RT_TOKE = 0;
constexpr size_t RT_TOKG = 262144;
constexpr size_t RT_RIDX = 524288;
constexpr size_t RT_RGATE = RT_RIDX + 2 * RT_TILES * 256 * 4;
constexpr size_t RT_TEXP = RT_RGATE + 2 * RT_TILES * 256 * 4;
constexpr size_t RT_NT = RT_TEXP + 2 * RT_TILES * 4;
constexpr size_t WS_WCS = WS_ROUTE + 1536 * 1024;
constexpr int WCS_IN = 0, WCS_W1 = 2 * 2304, WCS_W3 = 2 * 2304 + 2816;
constexpr size_t RT_POS = 1664 * 1024;
constexpr size_t WS_RS = WS_ROUTE + 1280 * 1024;
static_assert(RT_NT + 1024 <= 2 * MiB, "route tables");
constexpr int CW_BAR = 4096, CW_Q = 8192, CW_CONVQ = 12288, CW_WABS = 12800, CW_DONE0 = 16384, CW_FINQ = 16448, CW_DONE1 = 16512;
constexpr size_t WS_Y0 = 8 * MiB;
constexpr int Y1_SPLIT = 68;
static_assert((size_t)Y1_SPLIT * 256 * 1024 * 2 <= 34 * MiB && WS_Y0 + (size_t)136 * 256 * 1024 * 2 <= 94 * MiB, "MoE down product buffers");
#define MDN_MERGE 1
constexpr int RING_BYTES = 131072, LDS_BYTES = 163840, LDSCTL_OFF = LDS_BYTES - 1024, MISC_OFF = LDSCTL_OFF + 320;

#define GAS __attribute__((address_space(1)))
#define LAS __attribute__((address_space(3)))
typedef unsigned short bf16;
typedef unsigned v4u __attribute__((ext_vector_type(4)));
typedef unsigned v2u __attribute__((ext_vector_type(2)));
typedef float f32x4 __attribute__((ext_vector_type(4)));
typedef float f32x2 __attribute__((ext_vector_type(2)));
#define LDS_WAIT() asm volatile("s_waitcnt lgkmcnt(0)" ::: "memory")
__device__ __forceinline__ unsigned f2bf(float f) { unsigned u = __builtin_bit_cast(unsigned, f); return (u + 0x7fffu + ((u >> 16) & 1u)) >> 16; }
__device__ __forceinline__ unsigned pk2(float lo, float hi) { return f2bf(lo) | (f2bf(hi) << 16); }
__device__ __forceinline__ float bf2f(unsigned b) { return __builtin_bit_cast(float, b << 16); }
__device__ __forceinline__ float bflo(unsigned w) { return __builtin_bit_cast(float, w << 16); }
__device__ __forceinline__ float bfhi(unsigned w) { return __builtin_bit_cast(float, w & 0xffff0000u); }
typedef short bf16x8 __attribute__((ext_vector_type(8)));
typedef float f32x16 __attribute__((ext_vector_type(16)));
typedef __bf16 bf16x2_t __attribute__((ext_vector_type(2)));
__device__ __forceinline__ unsigned cvtpk(float lo, float hi) { const f32x2 v = {lo, hi}; return __builtin_bit_cast(unsigned, __builtin_convertvector(v, bf16x2_t)); }
__device__ __forceinline__ bf16 bf1(float x) { return (bf16)(cvtpk(x, x) & 0xffffu); }
__device__ __forceinline__ float silu_fast(float a) { return a * __builtin_amdgcn_rcpf(1.0f + __builtin_amdgcn_exp2f(a * -1.4426950408889634f)); }
__device__ __forceinline__ float cosrev(float f) { return __builtin_amdgcn_cosf(f); }
__device__ __forceinline__ float sinrev(float f) { return __builtin_amdgcn_sinf(f); }
__device__ __forceinline__ int crow32(int reg, int h) { return (reg & 3) + 8 * (reg >> 2) + 4 * h; }
#define MFMA32(a, b, c) __builtin_amdgcn_mfma_f32_32x32x16_bf16((a), (b), (c), 0, 0, 0)

#define XB_TMO      128
#define XB_XCNT(j)  (256  + 64 * (j))
#define XB_XSUB(j)  (1280 + 64 * (j))
#define XB_XGEN(j)  (2304 + 64 * (j))
#define XB_TOP      3328
#define XB_TOPGEN   3392
#define XCD_BAR_WORDS 3456
#define XB_SPIN_CAP (1u << 20)
__device__ __forceinline__ unsigned xb_ld(unsigned* p)              { return __hip_atomic_load(p, __ATOMIC_RELAXED, __HIP_MEMORY_SCOPE_AGENT); }
__device__ __forceinline__ unsigned xb_add(unsigned* p, unsigned v) { return __hip_atomic_fetch_add(p, v, __ATOMIC_RELAXED, __HIP_MEMORY_SCOPE_AGENT); }
__device__ __forceinline__ unsigned xb_xcc_id() { return (unsigned)__builtin_amdgcn_s_getreg((3 << 11) | 20) & 0xFu; }
#define XB_SPIN(cond, bar) do { unsigned _sp = 0; while (cond) { __builtin_amdgcn_s_sleep(1); \
    if ((++_sp & 255u) == 0u) { if (xb_ld(&(bar)[XB_TMO])) break; if (_sp > XB_SPIN_CAP) { atomicAdd(&(bar)[XB_TMO], 1u); break; } } } } while (0)
struct XcdBarrier { unsigned* bar; unsigned x; volatile LAS unsigned* st; };
__device__ __forceinline__ XcdBarrier xcd_barrier_post(unsigned* bar, volatile LAS unsigned* st) {
    XcdBarrier b; b.bar = bar; b.x = xb_xcc_id(); b.st = st;
    if (threadIdx.x == 0) (void)xb_add(&bar[XB_XCNT(b.x)], 1u);
    return b;
}
__device__ __forceinline__ void xcd_barrier_complete(unsigned* bar, unsigned x, unsigned& nloc, unsigned& nx) {
    const unsigned G = gridDim.x * gridDim.y * gridDim.z;
    unsigned sum, cnt, mine, sp = 0u;
    for (;;) {
        sum = 0u; cnt = 0u; mine = 0u;
#pragma unroll
        for (unsigned j = 0; j < 16; ++j) { const unsigned c = xb_ld(&bar[XB_XCNT(j)]); sum += c; cnt += (c > 0u) ? 1u : 0u; mine = (j == x) ? c : mine; }
        if (sum == G) break;
        __builtin_amdgcn_s_sleep(1);
        if ((++sp & 255u) == 0u) { if (xb_ld(&bar[XB_TMO])) break; if (sp > XB_SPIN_CAP) { atomicAdd(&bar[XB_TMO], 1u); break; } }
    }
    nloc = mine > 0u ? mine : 1u; nx = cnt > 0u ? cnt : 1u;
}
__device__ __forceinline__ void xcd_barrier(const XcdBarrier& b) {
    asm volatile("s_waitcnt vmcnt(0)" ::: "memory");
    __syncthreads();
    if (threadIdx.x == 0) {
        unsigned* bar = b.bar;
        __builtin_amdgcn_s_waitcnt(0);
        unsigned nloc = b.st[0], nx = b.st[1];
        if (nloc == 0u) { xcd_barrier_complete(bar, b.x, nloc, nx); b.st[0] = nloc; b.st[1] = nx; }
        const unsigned old = xb_add(&bar[XB_XSUB(b.x)], 1u);
        const unsigned gen = old / nloc;
        if (old + 1u == (gen + 1u) * nloc) {
            __builtin_amdgcn_fence(__ATOMIC_RELEASE, "agent");
            asm volatile("s_waitcnt vmcnt(0)" ::: "memory");
            const unsigned og = xb_add(&bar[XB_TOP], 1u);
            const unsigned tg = og / nx;
            if (og + 1u == (tg + 1u) * nx) xb_add(&bar[XB_TOPGEN], 1u);
            else XB_SPIN(xb_ld(&bar[XB_TOPGEN]) == tg, bar);
            __builtin_amdgcn_fence(__ATOMIC_ACQUIRE, "agent");
            xb_add(&bar[XB_XGEN(b.x)], 1u);
            asm volatile("s_waitcnt vmcnt(0)" ::: "memory");
        } else {
            XB_SPIN(xb_ld(&bar[XB_XGEN(b.x)]) == gen, bar);
            __builtin_amdgcn_fence(__ATOMIC_ACQUIRE, "agent");
            asm volatile("s_waitcnt vmcnt(0)" ::: "memory");
        }
    }
    __syncthreads();
}

struct Args { const float* in[23]; float* out; unsigned char* ws; int ph_lo, ph_hi, li, pad; };

__device__ __forceinline__ float wave_sum(float v) {
#pragma unroll
    for (int o = 1; o < 64; o <<= 1) v += __shfl_xor(v, o);
    return v;
}

__device__ __forceinline__ void transpose_item(const float* W, int K, int N, bf16* WT, int row_off, int mode, LAS float* scr, int item, int lane) {
    const int nblk = N / 32, kb = item / nblk, nb = item % nblk, k0 = 64 * kb, n0 = 32 * nb;
    { float tv[32];
#pragma unroll
      for (int i = 0; i < 32; ++i) tv[i] = W[(size_t)(k0 + 2 * i + (lane >> 5)) * N + n0 + (lane & 31)];
#pragma unroll
      for (int i = 0; i < 32; ++i) scr[(2 * i + (lane >> 5)) * 33 + (lane & 31)] = tv[i]; }
    LDS_WAIT(); asm volatile("" ::: "memory");
    const int r0 = mode == 0 ? row_off + n0 : row_off + (n0 >> 7) * 256 + (n0 & 127) + (mode == 2 ? 128 : 0);
    const int c = lane & 7;
#pragma unroll
    for (int j = 0; j < 4; ++j) { const int n = (lane >> 3) + 8 * j; const LAS float* s = scr + (8 * c) * 33 + n;
        v4u o; o.x = cvtpk(s[0 * 33], s[1 * 33]); o.y = cvtpk(s[2 * 33], s[3 * 33]); o.z = cvtpk(s[4 * 33], s[5 * 33]); o.w = cvtpk(s[6 * 33], s[7 * 33]);
        *(GAS v4u*)(WT + (size_t)(r0 + n) * K + k0 + 8 * c) = o; }
    LDS_WAIT(); asm volatile("" ::: "memory");
}

__device__ __forceinline__ void transpose_item8(const float* W, int K, int N, unsigned char* WT, int row_off, int mode, float sc, LAS float* scr, int item, int lane) {
    const int nblk = N / 32, kb = item / nblk, nb = item % nblk, k0 = 64 * kb, n0 = 32 * nb;
    { float tv[32];
#pragma unroll
      for (int i = 0; i < 32; ++i) tv[i] = W[(size_t)(k0 + 2 * i + (lane >> 5)) * N + n0 + (lane & 31)];
#pragma unroll
      for (int i = 0; i < 32; ++i) scr[(2 * i + (lane >> 5)) * 33 + (lane & 31)] = tv[i]; }
    LDS_WAIT(); asm volatile("" ::: "memory");
    const int r0 = mode == 0 ? row_off + n0 : row_off + (n0 >> 7) * 256 + (n0 & 127) + (mode == 2 ? 128 : 0);
    const int c = lane & 7;
#pragma unroll
    for (int j = 0; j < 4; ++j) { const int n = (lane >> 3) + 8 * j; const LAS float* s = scr + (8 * c) * 33 + n;
        v2u o; o.x = pg8::pk4_fp8(s[0 * 33] * sc, s[1 * 33] * sc, s[2 * 33] * sc, s[3 * 33] * sc); o.y = pg8::pk4_fp8(s[4 * 33] * sc, s[5 * 33] * sc, s[6 * 33] * sc, s[7 * 33] * sc);
        *(GAS v2u*)(WT + (size_t)(r0 + n) * K + k0 + 8 * c) = o; }
    LDS_WAIT(); asm volatile("" ::: "memory");
}

__device__ __forceinline__ unsigned pk4_i8(float a, float b, float c, float d) {
    const int ia = (int)__builtin_rintf(__builtin_amdgcn_fmed3f(a, -127.f, 127.f)), ib = (int)__builtin_rintf(__builtin_amdgcn_fmed3f(b, -127.f, 127.f)), ic = (int)__builtin_rintf(__builtin_amdgcn_fmed3f(c, -127.f, 127.f)), id = (int)__builtin_rintf(__builtin_amdgcn_fmed3f(d, -127.f, 127.f));
    return (unsigned)(ia & 0xff) | ((unsigned)(ib & 0xff) << 8) | ((unsigned)(ic & 0xff) << 16) | ((unsigned)id << 24); }
__device__ __forceinline__ void transpose_item_i8(const float* W, int K, int N, unsigned char* WT, int row_off, int mode, const float* steps, LAS float* scr, int item, int lane) {
    const int nblk = N / 32, kb = item / nblk, nb = item % nblk, k0 = 64 * kb, n0 = 32 * nb;
    { float tv[32];
#pragma unroll
      for (int i = 0; i < 32; ++i) tv[i] = W[(size_t)(k0 + 2 * i + (lane >> 5)) * N + n0 + (lane & 31)];
#pragma unroll
      for (int i = 0; i < 32; ++i) scr[(2 * i + (lane >> 5)) * 33 + (lane & 31)] = tv[i]; }
    LDS_WAIT(); asm volatile("" ::: "memory");
    const int r0 = mode == 0 ? row_off + n0 : row_off + (n0 >> 7) * 256 + (n0 & 127) + (mode == 2 ? 128 : 0);
    const int c = lane & 7;
#pragma unroll
    for (int j = 0; j < 4; ++j) { const int n = (lane >> 3) + 8 * j; const LAS float* s = scr + (8 * c) * 33 + n; const float st = steps[n0 + n], sc = st > 0.f ? 1.0f / st : 0.f;
        v2u o; o.x = pk4_i8(s[0 * 33] * sc, s[1 * 33] * sc, s[2 * 33] * sc, s[3 * 33] * sc); o.y = pk4_i8(s[4 * 33] * sc, s[5 * 33] * sc, s[6 * 33] * sc, s[7 * 33] * sc);
        *(GAS v2u*)(WT + (size_t)(r0 + n) * K + k0 + 8 * c) = o; }
    LDS_WAIT(); asm volatile("" ::: "memory");
}
__device__ __forceinline__ void colmax_item(const float* W, int K, int N, float* steps, int blk, LAS float* red, int wave, int lane) {
    const int n = blk * 64 + lane; float m = 0.f;
    if (n < N) { const float* p = W + (size_t)(wave * (K / 8)) * N + n;
#pragma unroll 1
        for (int k0 = 0; k0 < K / 8; k0 += 32) { float tv[32];
#pragma unroll
            for (int k = 0; k < 32; ++k) tv[k] = p[(size_t)(k0 + k) * N];
#pragma unroll
            for (int k = 0; k < 32; ++k) m = fmaxf(m, fabsf(tv[k])); } }
    red[wave * 64 + lane] = m;
    __syncthreads();
    if (wave == 0) { float mm = m;
#pragma unroll
        for (int q = 1; q < 8; ++q) mm = fmaxf(mm, red[q * 64 + lane]);
        if (n < N) steps[n] = mm * (1.0f / 127.0f); }
    __syncthreads();
}
__device__ __forceinline__ void absmax_pass(const float* W, size_t n4, unsigned* dst, int gtid, int gthreads, int lane) {
    float m = 0.f;
    for (size_t i = gtid; i < n4; i += gthreads) { const f32x4 v = ((const f32x4*)W)[i]; m = fmaxf(fmaxf(fmaxf(fabsf(v.x), fabsf(v.y)), fmaxf(fabsf(v.z), fabsf(v.w))), m); }
#pragma unroll
    for (int o = 1; o < 64; o <<= 1) m = fmaxf(m, __shfl_xor(m, o));
    if (lane == 0) atomicMax(dst, __float_as_uint(m));
}

struct Wg { LAS unsigned char* lds; int tid, lane, wave, G, bx, gw, NGW; };
#define WS_PTR(T, off) ((T*)(a.ws + (off)))
__device__ __forceinline__ void conv_in_tail(const Args& a, const Wg& w, const int nunits, const int quota);

__device__ __forceinline__ void ph_prologue(const Args& a, const Wg& w) {
    const int tid = w.tid, lane = w.lane, wave = w.wave;
    const float* c_in = a.in[1]; const float* cctx_in = a.in[3]; const float* w_mod = a.in[4];
    const float* w_in = a.in[8]; const float* w_out = a.in[14]; const float* ffn_w1 = a.in[15]; const float* ffn_w3 = a.in[16]; const float* ffn_w2 = a.in[17];
    float* MODP = WS_PTR(float, WS_MODP); bf16* WIN = WS_PTR(bf16, WS_WIN); bf16* WOUT = WS_PTR(bf16, WS_WOUT); bf16* W13 = WS_PTR(bf16, WS_W13); bf16* W2 = WS_PTR(bf16, WS_W2);
    LAS float* scr = (LAS float*)(w.lds + wave * 8448);
    LAS float* sil = (LAS float*)(w.lds + 69632);
    for (int i = tid; i < 9 * D; i += NTHR) { const float v = i < 8 * D ? c_in[i] : cctx_in[i - 8 * D]; sil[i] = v / (1.0f + __expf(-v)); }
    __syncthreads();
    constexpr int I_IN = 16 * 65, I_OUT = 16 * 32, I_F13 = 16 * 88, I_F2 = 44 * 32, I_MOD = 2 * 8 * 96;
    constexpr int NITEMS = I_MOD + 2 * I_IN + 2 * I_OUT + 2 * I_F13 + I_F2;
    for (int it = w.gw; it < NITEMS; it += w.NGW) {
        int r = it;
        if (r < I_MOD) {
            const int l = r / 768, kc = (r % 768) / 96, nb = r % 96, n = nb * 64 + lane;
            float acc[9];
#pragma unroll
            for (int b = 0; b < 9; ++b) acc[b] = 0.f;
            const float* wp = w_mod + ((size_t)l * D + kc * 128) * MOD6 + n;
#pragma unroll 1
            for (int k0 = 0; k0 < 128; k0 += 32) { float wv[32];
#pragma unroll
                for (int k = 0; k < 32; ++k) wv[k] = wp[(size_t)(k0 + k) * MOD6];
#pragma unroll
                for (int k = 0; k < 32; ++k)
#pragma unroll
                    for (int b = 0; b < 9; ++b) acc[b] += sil[b * D + kc * 128 + k0 + k] * wv[k]; }
#pragma unroll
            for (int b = 0; b < 9; ++b) MODP[(((size_t)l * 8 + kc) * 9 + b) * MOD6 + n] = acc[b];
            continue; }
        r -= I_MOD;
        if (r < 2 * I_IN) { const int l = r / I_IN; if (!I8_GIN) transpose_item(w_in + (size_t)l * D * INW, D, INW, WIN + (size_t)l * INP * D, 0, 0, scr, r % I_IN, lane); continue; } r -= 2 * I_IN;
        if (r < 2 * I_OUT) { const int l = r / I_OUT; transpose_item(w_out + (size_t)l * D * D, D, D, WOUT + (size_t)l * D * D, 0, 0, scr, r % I_OUT, lane); continue; } r -= 2 * I_OUT;
        if (r < I_F13) { if (I8_FUP) {} else if (FP8_FUP) transpose_item8(ffn_w1, D, DFF, (unsigned char*)W13, 0, 1, FP8_SW, scr, r, lane); else transpose_item(ffn_w1, D, DFF, W13, 0, 1, scr, r, lane); continue; } r -= I_F13;
        if (r < I_F13) { if (I8_FUP) {} else if (FP8_FUP) transpose_item8(ffn_w3, D, DFF, (unsigned char*)W13, 0, 2, FP8_SW, scr, r, lane); else transpose_item(ffn_w3, D, DFF, W13, 0, 2, scr, r, lane); continue; } r -= I_F13;
        if (FP8_FDN) transpose_item8(ffn_w2, DFF, D, (unsigned char*)W2, 0, 0, FP8_SW, scr, r, lane); else transpose_item(ffn_w2, DFF, D, W2, 0, 0, scr, r, lane);
    }
    {
        float* WCS = WS_PTR(float, WS_WCS); LAS float* red = (LAS float*)(w.lds + 110 * 1024);
        constexpr int B_IN = (INW + 63) / 64, B_F = DFF / 64, NB = (I8_GIN ? 2 * B_IN : 0) + (I8_FUP ? 2 * B_F : 0);
        __syncthreads();
        for (int it = w.bx; it < NB; it += w.G) { int r = it;
            if (I8_GIN) { if (r < 2 * B_IN) { const int l = r / B_IN; colmax_item(w_in + (size_t)l * D * INW, D, INW, WCS + WCS_IN + l * 2304, r % B_IN, red, wave, lane); continue; } r -= 2 * B_IN; }
            if (r < B_F) colmax_item(ffn_w1, D, DFF, WCS + WCS_W1, r, red, wave, lane); else colmax_item(ffn_w3, D, DFF, WCS + WCS_W3, r - B_F, red, wave, lane); }
        if (I8_GIN) for (int i = w.bx * NTHR + tid; i < 2 * (INP - INW); i += w.G * NTHR) WCS[WCS_IN + (i / (INP - INW)) * 2304 + INW + i % (INP - INW)] = 0.f;
    }
    for (int i = w.bx * NTHR + tid; i < 2 * (INP - INW) * D / 8; i += w.G * NTHR) { const int l = i / ((INP - INW) * D / 8), o = i % ((INP - INW) * D / 8);
        if (I8_GIN) { if (o < (INP - INW) * D / 16) *(GAS v4u*)((unsigned char*)WIN + (size_t)l * INP * D + (size_t)INW * D + (size_t)o * 16) = (v4u){0u, 0u, 0u, 0u}; }
        else *(GAS v4u*)(WIN + (size_t)l * INP * D + (size_t)INW * D + (size_t)o * 8) = (v4u){0u, 0u, 0u, 0u}; }
    __syncthreads();
}
__device__ __forceinline__ void ph_modfin(const Args& a, const Wg& w) {
    const float* b_mod = a.in[5]; const float* MODP = WS_PTR(float, WS_MODP); float* MODV = WS_PTR(float, WS_MODV);
    for (int i = w.bx * NTHR + w.tid; i < 2 * 9 * MOD6; i += w.G * NTHR) { const int l = i / (9 * MOD6), r = i % (9 * MOD6), n = r % MOD6;
        float s = b_mod[l * MOD6 + n];
#pragma unroll
        for (int kc = 0; kc < 8; ++kc) s += MODP[((size_t)l * 8 + kc) * 9 * MOD6 + r];
        MODV[i] = s; }
}
__device__ __forceinline__ void ph_quant(const Args& a, const Wg& w) {
    __syncthreads();
    if (I8_GIN) {
        LAS float* scr = (LAS float*)(w.lds + w.wave * 8448); constexpr int I_IN = 16 * 65;
        for (int it = w.gw; it < 2 * I_IN; it += w.NGW) { const int l = it / I_IN;
            transpose_item_i8(a.in[8] + (size_t)l * D * INW, D, INW, WS_PTR(unsigned char, WS_WIN) + (size_t)l * INP * D, 0, 0, WS_PTR(float, WS_WCS) + WCS_IN + l * 2304, scr, it % I_IN, w.lane); }
        __syncthreads(); }
    if (I8_FUP) {
        LAS float* scr = (LAS float*)(w.lds + w.wave * 8448); constexpr int I_F13 = 16 * 88;
        for (int it = w.gw; it < 2 * I_F13; it += w.NGW) { if (it < I_F13) transpose_item_i8(a.in[15], D, DFF, WS_PTR(unsigned char, WS_W13), 0, 1, WS_PTR(float, WS_WCS) + WCS_W1, scr, it, w.lane); else transpose_item_i8(a.in[16], D, DFF, WS_PTR(unsigned char, WS_W13), 0, 2, WS_PTR(float, WS_WCS) + WCS_W3, scr, it - I_F13, w.lane); }
        __syncthreads(); }
}
__device__ __forceinline__ void ph_norm(const Args& a, const Wg& w, const int l, const int which) {
    const int lane = w.lane;
    const float* modl = WS_PTR(float, WS_MODV) + (size_t)l * 9 * MOD6;
    const bool fin = (l == 0 && which == 0);
    const float* resL = a.in[0]; const float* resC = a.in[2]; const bf16* XRES = WS_PTR(bf16, WS_XRES);
    const float* nw = (which == 0 ? a.in[6] : a.in[7]) + l * D;
    bf16* HBUF = WS_PTR(bf16, WS_HBUF);
    const bool route = (l == 1 && which == 1);
    LAS float* rw = (LAS float*)w.lds;
    if (route) { const float* router_w = a.in[18]; for (int i = w.tid; i < D * NE / 4; i += NTHR) ((LAS f32x4*)rw)[i] = ((const f32x4*)router_w)[i]; }
    __syncthreads();
    int* TOKE = WS_PTR(int, WS_ROUTE + RT_TOKE); float* TOKG = WS_PTR(float, WS_ROUTE + RT_TOKG);
    const int Mrows = (l == 1 && which == 1) ? NL : MT;
    for (int m = w.gw; m < Mrows; m += w.NGW) {
        const bool isc = m >= NL; const int bidx = isc ? 8 : (m >> 12);
        const float* xr = isc ? resC + (size_t)(m - NL) * D : resL + (size_t)m * D;
        const float* sh = modl + bidx * MOD6 + which * 3 * D, *sc = sh + D;
        f32x4 v[4]; float ss = 0.f;
#pragma unroll
        for (int j = 0; j < 4; ++j) { v[j] = fin ? *(const f32x4*)(xr + 4 * lane + 256 * j) : pg8::bf4_to_f32(*(const pg8::u32x2_t*)(XRES + (size_t)m * D + 4 * lane + 256 * j)); ss += (v[j].x * v[j].x + v[j].y * v[j].y) + (v[j].z * v[j].z + v[j].w * v[j].w); }
        const float rstd = 1.0f / sqrtf(wave_sum(ss) * (1.0f / D) + EPS);
        float lg[8];
#pragma unroll
        for (int e = 0; e < 8; ++e) lg[e] = 0.f;
        f32x4 hq[4]; float amax = 0.f;
#pragma unroll
        for (int j = 0; j < 4; ++j) { const int c = 4 * lane + 256 * j; const f32x4 wv = *(const f32x4*)(nw + c), s1 = *(const f32x4*)(sc + c), s0 = *(const f32x4*)(sh + c);
            const f32x4 h = (v[j] * rstd) * wv * (s1 + 1.0f) + s0; hq[j] = h;
            amax = fmaxf(amax, fmaxf(fmaxf(fabsf(h.x), fabsf(h.y)), fmaxf(fabsf(h.z), fabsf(h.w))));
            if (route) {
#pragma unroll
                for (int q = 0; q < 4; ++q) { const f32x4 r0 = *(const LAS f32x4*)(rw + (c + q) * 8), r1 = *(const LAS f32x4*)(rw + (c + q) * 8 + 4); const float hv = h[q];
                    lg[0] += hv * r0.x; lg[1] += hv * r0.y; lg[2] += hv * r0.z; lg[3] += hv * r0.w; lg[4] += hv * r1.x; lg[5] += hv * r1.y; lg[6] += hv * r1.z; lg[7] += hv * r1.w; } } }
        if ((which == 1 && l == 0 && I8_FUP) || (which == 0 && I8_GIN)) {
#pragma unroll
            for (int o = 1; o < 64; o <<= 1) amax = fmaxf(amax, __shfl_xor(amax, o));
            const float qs = amax > 1e-30f ? 127.0f / amax : 0.f;
            if (lane == 0) WS_PTR(float, WS_RS)[m] = amax * (1.0f / 127.0f);
#pragma unroll
            for (int j = 0; j < 4; ++j) *(unsigned*)((unsigned char*)HBUF + (size_t)m * D + 4 * lane + 256 * j) = pk4_i8(hq[j].x * qs, hq[j].y * qs, hq[j].z * qs, hq[j].w * qs);
        } else {
#pragma unroll
            for (int j = 0; j < 4; ++j) { const int c = 4 * lane + 256 * j; const f32x4 h = hq[j];
                if (which == 0 || (l == 0 && !FP8_FUP)) *(v2u*)(HBUF + (size_t)m * D + c) = (v2u){cvtpk(h.x, h.y), cvtpk(h.z, h.w)};
                else *(unsigned*)((unsigned char*)HBUF + (size_t)m * D + c) = pg8::pk4_fp8(h.x * FP8_SH, h.y * FP8_SH, h.z * FP8_SH, h.w * FP8_SH); } }
        if (route) {
#pragma unroll
            for (int e = 0; e < 8; ++e) lg[e] = wave_sum(lg[e]);
            int e0 = 0; float v0 = lg[0];
#pragma unroll
            for (int e = 1; e < 8; ++e) if (lg[e] > v0) { v0 = lg[e]; e0 = e; }
            int e1 = -1; float v1 = -3.0e38f;
#pragma unroll
            for (int e = 0; e < 8; ++e) if (e != e0 && lg[e] > v1) { v1 = lg[e]; e1 = e; }
            const float g0 = 1.0f / (1.0f + __expf(v1 - v0)), g1 = 1.0f - g0;
            if (lane == 0) { TOKE[m] = e0; TOKE[NL + m] = e1; TOKG[m] = g0; TOKG[NL + m] = g1; }
        }
    }
    __syncthreads();
}
__device__ __forceinline__ void ph_gin(const Args& a, const Wg& w, const int l) {
    if constexpr (I8_GIN) { pg8::DenseOrder S; S.init(WS_PTR(bf16, WS_HBUF), (const bf16*)(WS_PTR(unsigned char, WS_WIN) + (size_t)l * INP * D), MT, INP, D / 2, w.G, w.bx);
        pg8::EpiBf16i E{WS_PTR(bf16, WS_PBUF), INP, WS_PTR(float, WS_RS), WS_PTR(float, WS_WCS) + WCS_IN + l * 2304};
        pg8::gemm_phase<pg8::EpiBf16i, pg8::DenseOrder, true, false, 2>(w.lds, D / 2, S, E); }
    else { pg8::DenseOrder S; S.init(WS_PTR(bf16, WS_HBUF), WS_PTR(bf16, WS_WIN) + (size_t)l * INP * D, MT, INP, D, w.G, w.bx); pg8::EpiBf16 E{WS_PTR(bf16, WS_PBUF), INP};
        pg8::gemm_phase<pg8::EpiBf16, pg8::DenseOrder, true, false>(w.lds, D, S, E); }
    conv_in_tail(a, w, (MT / 256) * (INP / 256), CONV_Q_GIN);
}
__device__ __forceinline__ int wq_next(unsigned* ctr, volatile LAS int* slot, int tid) {
    __syncthreads();
    if (tid == 0) *slot = (int)__hip_atomic_fetch_add(ctr, 1u, __ATOMIC_RELAXED, __HIP_MEMORY_SCOPE_AGENT);
    __syncthreads();
    return __builtin_amdgcn_readfirstlane(*slot);
}
__device__ __forceinline__ int wq_claim(unsigned* ctr, int tid) { return tid == 0 ? (int)__hip_atomic_fetch_add(ctr, 1u, __ATOMIC_RELAXED, __HIP_MEMORY_SCOPE_AGENT) : 0; }
__device__ __forceinline__ int wq_take(volatile LAS int* slot, int& par, int claimed, int tid) {
    if (tid == 0) slot[par] = claimed;
    __syncthreads();
    const int v = __builtin_amdgcn_readfirstlane(slot[par]); par ^= 1; return v;
}
#define MFMA16(a, b, c) __builtin_amdgcn_mfma_f32_16x16x32_bf16((a), (b), (c), 0, 0, 0)
constexpr int GL_QE = 0, GL_KE = 18432, GL_KDT = 36864, GL_P = 55296, GL_VT = 73728, GL_OS = 110592, GL_DEC = 144384, GL_SLOT = 160000;
static_assert(GL_DEC + 512 <= GL_SLOT && GL_SLOT + 64 <= LDSCTL_OFF, "GLA LDS map");
#define BB16 1
#if BB16
typedef _Float16 bb_t;
#else
typedef float bb_t;
#endif
constexpr size_t GSCR_OFF = (size_t)72 * MiB;
constexpr int NG1 = 64 * 17;
__device__ __forceinline__ int gla_run_row0(int b, int run) { return run == 0 ? NL + b * CTXL : b * SEQ + (run - 1) * 256; }
__device__ __forceinline__ float log_sigmoid_f(float z) { return fminf(z, 0.f) - log1pf(__expf(-fabsf(z))); }
__device__ __forceinline__ void gla_vt_image(const bf16* PBUF, LAS unsigned char* lds, int row0, int h, int tid) {
    const int dv = tid & 127, t4 = tid >> 7; unsigned pk[8];
    const bf16* p = PBUF + (size_t)(row0 + 16 * t4) * INP + PC_V + h * 128 + dv;
#pragma unroll
    for (int e = 0; e < 8; ++e) pk[e] = (unsigned)p[(size_t)(2 * e) * INP] | ((unsigned)p[(size_t)(2 * e + 1) * INP] << 16);
    *(LAS v4u*)(lds + GL_VT + dv * 144 + 32 * t4) = (v4u){pk[0], pk[1], pk[2], pk[3]};
    *(LAS v4u*)(lds + GL_VT + dv * 144 + 32 * t4 + 16) = (v4u){pk[4], pk[5], pk[6], pk[7]};
}
__device__ __forceinline__ void gla_state_update(f32x4 (&S)[4], LAS unsigned char* lds, int wave, int r, int q, int o_kdt, int o_vt, int o_dec) {
    const LAS float* dec = (const LAS float*)(lds + o_dec);
#pragma unroll
    for (int kt = 0; kt < 4; ++kt) { const f32x4 d = *(const LAS f32x4*)(dec + 16 * kt + 4 * q); S[kt] = S[kt] * d; }
#pragma unroll
    for (int ks = 0; ks < 2; ++ks) { const bf16x8 B = *(const LAS bf16x8*)(lds + o_vt + (16 * wave + r) * 144 + (32 * ks + 8 * q) * 2);
#pragma unroll
        for (int kt = 0; kt < 4; ++kt) { const bf16x8 A = *(const LAS bf16x8*)(lds + o_kdt + (16 * kt + r) * 144 + (32 * ks + 8 * q) * 2); S[kt] = MFMA16(A, B, S[kt]); } }
}
struct G1Raw { v4u lfa[2]; unsigned kq[4]; unsigned vp[8]; };
__device__ __forceinline__ void g1_load(G1Raw& r, const bf16* PBUF, int row0, int h, int dir, int tid) {
    const int k = tid & 63, tg = tid >> 6, dv = tid & 127, t4 = tid >> 7;
    { const int wv = tid >> 6, ln = tid & 63;
#pragma unroll
      for (int t = 0; t < 2; ++t) r.lfa[t] = *(const v4u*)(PBUF + (size_t)(row0 + 16 * (2 * (wv >> 2) + t) + (ln & 15)) * INP + PC_LF + dir * 16 + 8 * ((ln >> 4) & 1)); }
    const bf16* pk = PBUF + (size_t)(row0 + 8 * tg) * INP + PC_K + h * 64 + k;
#pragma unroll
    for (int e = 0; e < 4; ++e) r.kq[e] = (unsigned)pk[(size_t)(2 * e) * INP] | ((unsigned)pk[(size_t)(2 * e + 1) * INP] << 16);
    const bf16* pv = PBUF + (size_t)(row0 + 16 * t4) * INP + PC_V + h * 128 + dv;
#pragma unroll
    for (int e = 0; e < 8; ++e) r.vp[e] = (unsigned)pv[(size_t)(2 * e) * INP] | ((unsigned)pv[(size_t)(2 * e + 1) * INP] << 16);
}
__device__ __forceinline__ float log_sigmoid_fast(float z) { return fminf(z, 0.f) - 0.6931471805599453f * __builtin_amdgcn_logf(1.0f + __builtin_amdgcn_exp2f(fabsf(z) * -1.4426950408889634f)); }
constexpr int G1_VT = 0, G1_KDT = 36864, G1_LF = 55296, G1_T = 63488, G1_DEC = 67584, G1_Z = 69632;
__device__ __forceinline__ void gla_g1_job(const Args& a, const Wg& w, const int l, const int job, const int var = 0) {
    const int tid = w.tid, lane = w.lane, wave = w.wave, r = lane & 15, q = lane >> 4, k = tid & 63, tg = tid >> 6;
    const int seq = job / 17, step = job - seq * 17, b = seq >> 3, h = (seq >> 1) & 3, dir = seq & 1;
    const int run = step == 0 ? 0 : (dir ? 17 - step : step), rrow0 = gla_run_row0(b, run);
    const bf16* PBUF = WS_PTR(bf16, WS_PBUF); bb_t* BBUF = (bb_t*)a.out; float* SLOC = WS_PTR(float, WS_SLOC); float* DTOT = WS_PTR(float, WS_DTOT);
    LAS unsigned char* lds = w.lds;
    bf16x8 WB;
    { const int kgrp = lane >> 4, r0 = 8 * (kgrp & 1); const float* wgp = (dir ? a.in[11] : a.in[9]) + (size_t)l * 16 * 256 + h * 64 + 16 * (wave & 3) + (lane & 15);
      unsigned pkw[4];
#pragma unroll
      for (int jj = 0; jj < 8; jj += 2) { unsigned hv[2];
#pragma unroll
          for (int u = 0; u < 2; ++u) { const float wv = wgp[(r0 + jj + u) * 256]; const unsigned hb = cvtpk(wv, wv) & 0xffffu; const float lo = wv - __uint_as_float(hb << 16); hv[u] = (kgrp >> 1) ? (cvtpk(lo, lo) & 0xffffu) : hb; }
          pkw[jj >> 1] = hv[0] | (hv[1] << 16); }
      WB = __builtin_bit_cast(bf16x8, (v4u){pkw[0], pkw[1], pkw[2], pkw[3]}); }
    const float bias = (dir ? a.in[12] : a.in[10])[l * 256 + h * 64 + k];
    f32x4 S[4];
#pragma unroll
    for (int kt = 0; kt < 4; ++kt) S[kt] = (f32x4){0.f, 0.f, 0.f, 0.f};
    float logtot = 0.f;
    G1Raw cur; g1_load(cur, PBUF, rrow0 + (dir ? 3 : 0) * 64, h, dir, tid);
    for (int pc = 0; pc < ((var & 8) ? 0 : 4); ++pc) {
        const int par = pc & 1, row0 = rrow0 + (dir ? 3 - pc : pc) * 64;
        LAS unsigned char* VT = lds + G1_VT + par * 18432; LAS unsigned char* KDT = lds + G1_KDT + par * 9216; LAS float* Z = (LAS float*)(lds + G1_Z);
        LAS float* T = (LAS float*)(lds + G1_T + par * 2048); LAS float* DEC = (LAS float*)(lds + G1_DEC + par * 256);
        { f32x4 z0 = (f32x4){0.f, 0.f, 0.f, 0.f}, z1 = z0;
          z0 = MFMA16(__builtin_bit_cast(bf16x8, cur.lfa[0]), WB, z0); z1 = MFMA16(__builtin_bit_cast(bf16x8, cur.lfa[1]), WB, z1);
          LAS float* zp = Z + (32 * (wave >> 2) + 4 * q) * 68 + 16 * (wave & 3) + r;
#pragma unroll
          for (int i = 0; i < 4; ++i) { zp[i * 68] = z0[i]; zp[(16 + i) * 68] = z1[i]; } }
        { const int dv = tid & 127, t4 = tid >> 7;
          *(LAS v4u*)(VT + dv * 144 + 32 * t4) = (v4u){cur.vp[0], cur.vp[1], cur.vp[2], cur.vp[3]}; *(LAS v4u*)(VT + dv * 144 + 32 * t4 + 16) = (v4u){cur.vp[4], cur.vp[5], cur.vp[6], cur.vp[7]}; }
        const unsigned kq0 = cur.kq[0], kq1 = cur.kq[1], kq2 = cur.kq[2], kq3 = cur.kq[3];
        __syncthreads();
        if (pc < 3) g1_load(cur, PBUF, rrow0 + (dir ? 2 - pc : pc + 1) * 64, h, dir, tid);
        float gv[8];
#pragma unroll
        for (int e = 0; e < 8; ++e) { gv[e] = log_sigmoid_fast(Z[(8 * tg + e) * 68 + k] + bias) * (1.0f / 16.0f); if (var & 1) break; }
        if (var & 1) {
#pragma unroll
            for (int e = 1; e < 8; ++e) gv[e] = gv[0]; }
        float runs = 0.f;
        if (!dir) {
#pragma unroll
            for (int e = 0; e < 8; ++e) { runs += gv[e]; gv[e] = runs; } }
        else {
#pragma unroll
            for (int e = 7; e >= 0; --e) { runs += gv[e]; gv[e] = runs; } }
        T[tg * 64 + k] = runs;
        __syncthreads();
        float off = 0.f, tot = 0.f;
#pragma unroll
        for (int t2 = 0; t2 < 8; ++t2) { const float v = T[t2 * 64 + k]; tot += v; const bool before = dir ? (t2 > tg) : (t2 < tg); off += before ? v : 0.f; }
        const unsigned kqa[4] = {kq0, kq1, kq2, kq3}; unsigned pk[4];
#pragma unroll
        for (int e2 = 0; e2 < 4; ++e2) { const float B0 = gv[2 * e2] + off, B1 = gv[2 * e2 + 1] + off; const size_t row = (size_t)(row0 + 8 * tg + 2 * e2);
            if (!(var & 4)) { BBUF[row * 512 + dir * 256 + h * 64 + k] = (bb_t)B0; BBUF[(row + 1) * 512 + dir * 256 + h * 64 + k] = (bb_t)B1; }
            pk[e2] = cvtpk(bflo(kqa[e2]) * __expf(tot - B0), bfhi(kqa[e2]) * __expf(tot - B1)); }
        *(LAS v4u*)(KDT + k * 144 + 16 * tg) = (v4u){pk[0], pk[1], pk[2], pk[3]};
        if (tg == 0) DEC[k] = __expf(tot);
        logtot += tot;
        __syncthreads();
        if (!(var & 2)) {
#pragma unroll
            for (int kt = 0; kt < 4; ++kt) { const f32x4 d = *(const LAS f32x4*)(DEC + 16 * kt + 4 * q); S[kt] = S[kt] * d; }
#pragma unroll
            for (int ks = 0; ks < 2; ++ks) { const bf16x8 Bf = *(const LAS bf16x8*)(VT + (16 * wave + r) * 144 + (32 * ks + 8 * q) * 2);
#pragma unroll
                for (int kt = 0; kt < 4; ++kt) { const bf16x8 Af = *(const LAS bf16x8*)(KDT + (16 * kt + r) * 144 + (32 * ks + 8 * q) * 2); S[kt] = MFMA16(Af, Bf, S[kt]); } }
        }
    }
    const size_t idx = (size_t)seq * 17 + step;
#pragma unroll
    for (int kt = 0; kt < 4; ++kt)
#pragma unroll
        for (int i = 0; i < 4; ++i) SLOC[idx * 8192 + (size_t)(16 * kt + 4 * q + i) * 128 + 16 * wave + r] = S[kt][i];
    if (tg == 0) DTOT[idx * 64 + k] = __expf(logtot);
}
__device__ __forceinline__ void ph_gla_scan(const Args& a, const Wg& w) {
    float* SLOC = WS_PTR(float, WS_SLOC); const float* DTOT = WS_PTR(float, WS_DTOT);
    for (int ge = w.bx * NTHR + w.tid; ge < 64 * 8192; ge += w.G * NTHR) { const int seq = ge >> 13, e = ge & 8191;
        float* p = SLOC + (size_t)seq * 17 * 8192 + e; const float* d = DTOT + (size_t)seq * 17 * 64 + (e >> 7);
        float tv[17], dv[17];
#pragma unroll
        for (int st = 0; st < 17; ++st) { tv[st] = p[(size_t)st * 8192]; dv[st] = d[st * 64]; }
        float s = 0.f;
#pragma unroll
        for (int st = 0; st < 17; ++st) { p[(size_t)st * 8192] = s; s = dv[st] * s + tv[st]; } }
}
struct G3Raw { v4u q, k, B, Bl; unsigned vp[8]; };
static_assert(BB16, "g3_load reads the log-decay buffer as f16 rows");
__device__ __forceinline__ void g3_load(G3Raw& r, const bf16* PBUF, const bb_t* BBUF, int row0, int h, int dir, int tid) {
    const int tok = tid >> 3, k0 = (tid & 7) * 8, dv = tid & 127, t4 = tid >> 7;
    r.q = *(const v4u*)(PBUF + (size_t)(row0 + tok) * INP + PC_Q + h * 64 + k0);
    r.k = *(const v4u*)(PBUF + (size_t)(row0 + tok) * INP + PC_K + h * 64 + k0);
    r.B = *(const v4u*)(BBUF + (size_t)(row0 + tok) * 512 + dir * 256 + h * 64 + k0);
    r.Bl = *(const v4u*)(BBUF + (size_t)(row0 + (dir ? 0 : 63)) * 512 + dir * 256 + h * 64 + k0);
    const bf16* pv = PBUF + (size_t)(row0 + 16 * t4) * INP + PC_V + h * 128 + dv;
#pragma unroll
    for (int e = 0; e < 8; ++e) r.vp[e] = (unsigned)pv[(size_t)(2 * e) * INP] | ((unsigned)pv[(size_t)(2 * e + 1) * INP] << 16);
}
__device__ __forceinline__ void gla_g3_job(const Args& a, const Wg& w, const int l, const int job, const int var = 0) {
    const int tid = w.tid, lane = w.lane, wave = w.wave, r = lane & 15, q = lane >> 4, k = tid & 63, tg = tid >> 6;
    const int b = job / 68, h = (job / 17) & 3, run = job % 17, rrow0 = gla_run_row0(b, run);
    const bf16* PBUF = WS_PTR(bf16, WS_PBUF); const bb_t* BBUF = (const bb_t*)a.out; const float* SLOC = WS_PTR(float, WS_SLOC); bf16* MIX = WS_PTR(bf16, WS_MIX);
    v4u* OFS = (v4u*)((unsigned char*)a.out + GSCR_OFF) + ((size_t)job * 4 * NTHR + tid) * 2;
    const float* gnw = a.in[13] + l * 128 + (tid & 7) * 16;
    f32x4 gw4[4];
#pragma unroll
    for (int j = 0; j < 4; ++j) gw4[j] = *(const f32x4*)(gnw + 4 * j);
    LAS unsigned char* lds = w.lds; LAS float* OS = (LAS float*)(lds + GL_OS);
    f32x4 S[4];
    { const size_t idx = (size_t)((b * 4 + h) * 2 + 0) * 17 + run;
#pragma unroll
      for (int kt = 0; kt < 4; ++kt)
#pragma unroll
          for (int i = 0; i < 4; ++i) S[kt][i] = SLOC[idx * 8192 + (size_t)(16 * kt + 4 * q + i) * 128 + 16 * wave + r]; }
    G3Raw cur; g3_load(cur, PBUF, BBUF, rrow0, h, 0, tid);
    for (int s = 0; s < ((var & 8) ? 0 : 8); ++s) {
        const int dir = s >> 2, pc = s & 3, cidx = dir ? 3 - pc : pc, row0 = rrow0 + cidx * 64, par = s & 1;
        const int oQE = GL_QE + par * 9216, oKE = GL_KE + par * 9216, oKDT = GL_KDT + par * 9216, oP = GL_P + par * 9216, oVT = GL_VT + par * 18432, oDEC = GL_DEC + par * 256;
        if (s == 4) { const size_t idx = (size_t)((b * 4 + h) * 2 + 1) * 17 + (run == 0 ? 0 : 17 - run);
#pragma unroll
            for (int kt = 0; kt < 4; ++kt)
#pragma unroll
                for (int i = 0; i < 4; ++i) S[kt][i] = SLOC[idx * 8192 + (size_t)(16 * kt + 4 * q + i) * 128 + 16 * wave + r]; }
        {
            const int tok = tid >> 3, k0 = (tid & 7) * 8;
            const unsigned qw[4] = {cur.q.x, cur.q.y, cur.q.z, cur.q.w}, kw[4] = {cur.k.x, cur.k.y, cur.k.z, cur.k.w}, bw[4] = {cur.B.x, cur.B.y, cur.B.z, cur.B.w}, lw[4] = {cur.Bl.x, cur.Bl.y, cur.Bl.z, cur.Bl.w};
            unsigned qe[4], ke[4]; float dl[8];
#pragma unroll
            for (int j2 = 0; j2 < 4; ++j2) { typedef _Float16 h2 __attribute__((ext_vector_type(2)));
                const h2 bh = __builtin_bit_cast(h2, bw[j2]), lh = __builtin_bit_cast(h2, lw[j2]);
                const float B0 = (float)bh.x, B1 = (float)bh.y, L0 = (float)lh.x, L1 = (float)lh.y;
                const float q0 = bflo(qw[j2]), q1 = bfhi(qw[j2]), kv0 = bflo(kw[j2]), kv1 = bfhi(kw[j2]);
                qe[j2] = cvtpk(q0 * 0.125f * __expf(B0), q1 * 0.125f * __expf(B1)); ke[j2] = cvtpk(kv0 * __expf(-B0), kv1 * __expf(-B1));
                const unsigned kd2 = cvtpk(kv0 * __expf(L0 - B0), kv1 * __expf(L1 - B1));
                *(LAS bf16*)(lds + oKDT + (k0 + 2 * j2) * 144 + 2 * tok) = (bf16)(kd2 & 0xffffu); *(LAS bf16*)(lds + oKDT + (k0 + 2 * j2 + 1) * 144 + 2 * tok) = (bf16)(kd2 >> 16);
                dl[2 * j2] = L0; dl[2 * j2 + 1] = L1; }
            *(LAS v4u*)(lds + oQE + tok * 144 + 2 * k0) = (v4u){qe[0], qe[1], qe[2], qe[3]};
            *(LAS v4u*)(lds + oKE + tok * 144 + 2 * k0) = (v4u){ke[0], ke[1], ke[2], ke[3]};
            if (tok == 0) { *(LAS f32x4*)(lds + oDEC + 4 * k0) = (f32x4){__expf(dl[0]), __expf(dl[1]), __expf(dl[2]), __expf(dl[3])}; *(LAS f32x4*)(lds + oDEC + 4 * k0 + 16) = (f32x4){__expf(dl[4]), __expf(dl[5]), __expf(dl[6]), __expf(dl[7])}; }
            const int dv = tid & 127, t4 = tid >> 7;
            *(LAS v4u*)(lds + oVT + dv * 144 + 32 * t4) = (v4u){cur.vp[0], cur.vp[1], cur.vp[2], cur.vp[3]}; *(LAS v4u*)(lds + oVT + dv * 144 + 32 * t4 + 16) = (v4u){cur.vp[4], cur.vp[5], cur.vp[6], cur.vp[7]};
        }
        __syncthreads();
        if (s < 7) { const int s1 = s + 1, d1 = s1 >> 2, p1 = s1 & 3; g3_load(cur, PBUF, BBUF, rrow0 + (d1 ? 3 - p1 : p1) * 64, h, d1, tid); }
        v4u of0 = (v4u){0u, 0u, 0u, 0u}, of1 = of0, gA = of0, gB = of0;
        if (dir) { const v4u* op = OFS + (size_t)cidx * NTHR * 2; of0 = op[0]; of1 = op[1];
            const bf16* pg = PBUF + (size_t)(row0 + (tid >> 3)) * INP + PC_G + h * 128 + (tid & 7) * 16; gA = *(const v4u*)pg; gB = *(const v4u*)(pg + 8); }
#pragma unroll
        for (int t = 0; t < 2; ++t) { const int id = 2 * wave + t, st = id >> 2, tt = id & 3;
            f32x4 pa = (f32x4){0.f, 0.f, 0.f, 0.f};
            if (dir ? (st >= tt) : (st <= tt)) {
#pragma unroll
                for (int ks = 0; ks < 2; ++ks) { const bf16x8 A = *(const LAS bf16x8*)(lds + oKE + (16 * st + r) * 144 + (32 * ks + 8 * q) * 2), B = *(const LAS bf16x8*)(lds + oQE + (16 * tt + r) * 144 + (32 * ks + 8 * q) * 2);
                    pa = MFMA16(A, B, pa); }
                const int tau = 16 * tt + r;
#pragma unroll
                for (int i = 0; i < 4; ++i) { const int sg = 16 * st + 4 * q + i; const bool keep = dir ? (sg >= tau) : (sg <= tau); pa[i] = keep ? pa[i] : 0.f; } }
            *(LAS v2u*)(lds + oP + (16 * tt + r) * 144 + (16 * st + 4 * q) * 2) = (v2u){cvtpk(pa[0], pa[1]), cvtpk(pa[2], pa[3])}; }
        __syncthreads();
        f32x4 o[4];
#pragma unroll
        for (int tt = 0; tt < 4; ++tt) o[tt] = (f32x4){0.f, 0.f, 0.f, 0.f};
#pragma unroll
        for (int ks = 0; ks < 2; ++ks) {
            const bf16x8 Bs = __builtin_bit_cast(bf16x8, (v4u){cvtpk(S[2 * ks][0], S[2 * ks][1]), cvtpk(S[2 * ks][2], S[2 * ks][3]), cvtpk(S[2 * ks + 1][0], S[2 * ks + 1][1]), cvtpk(S[2 * ks + 1][2], S[2 * ks + 1][3])});
#pragma unroll
            for (int tt = 0; tt < 4; ++tt) { const v2u alo = *(const LAS v2u*)(lds + oQE + (16 * tt + r) * 144 + (32 * ks + 4 * q) * 2), ahi = *(const LAS v2u*)(lds + oQE + (16 * tt + r) * 144 + (32 * ks + 16 + 4 * q) * 2);
                o[tt] = MFMA16(__builtin_bit_cast(bf16x8, (v4u){alo.x, alo.y, ahi.x, ahi.y}), Bs, o[tt]); } }
#pragma unroll
        for (int ks = 0; ks < 2; ++ks) { const bf16x8 Bv = *(const LAS bf16x8*)(lds + oVT + (16 * wave + r) * 144 + (32 * ks + 8 * q) * 2);
#pragma unroll
            for (int tt = 0; tt < 4; ++tt) { const bf16x8 A = *(const LAS bf16x8*)(lds + oP + (16 * tt + r) * 144 + (32 * ks + 8 * q) * 2); o[tt] = MFMA16(A, Bv, o[tt]); } }
        gla_state_update(S, lds, wave, r, q, oKDT, oVT, oDEC);
        if (dir == 0) {
            v4u* op = OFS + (size_t)cidx * NTHR * 2;
            op[0] = (v4u){cvtpk(o[0][0], o[0][1]), cvtpk(o[0][2], o[0][3]), cvtpk(o[1][0], o[1][1]), cvtpk(o[1][2], o[1][3])};
            op[1] = (v4u){cvtpk(o[2][0], o[2][1]), cvtpk(o[2][2], o[2][3]), cvtpk(o[3][0], o[3][1]), cvtpk(o[3][2], o[3][3])};
        } else {
            const unsigned ofw[8] = {of0.x, of0.y, of0.z, of0.w, of1.x, of1.y, of1.z, of1.w};
#pragma unroll
            for (int tt = 0; tt < 4; ++tt)
#pragma unroll
                for (int i = 0; i < 4; ++i) { const int tk = 16 * tt + 4 * q + i; const unsigned wv = ofw[2 * tt + (i >> 1)]; OS[tk * 132 + 16 * wave + r] = o[tt][i] + ((i & 1) ? bfhi(wv) : bflo(wv)); }
            __syncthreads();
            const int tk = tid >> 3, dv0 = (tid & 7) * 16; const size_t row = (size_t)(row0 + tk);
            f32x4 ov[4]; float ss = 0.f;
#pragma unroll
            for (int j = 0; j < 4; ++j) { ov[j] = *(const LAS f32x4*)(OS + tk * 132 + dv0 + 4 * j); ss += (ov[j].x * ov[j].x + ov[j].y * ov[j].y) + (ov[j].z * ov[j].z + ov[j].w * ov[j].w); }
            ss += __shfl_xor(ss, 1); ss += __shfl_xor(ss, 2); ss += __shfl_xor(ss, 4);
            const float rstd = __builtin_amdgcn_rsqf(ss * (1.0f / 128.0f) + EPS);
            const unsigned gq[8] = {gA.x, gA.y, gA.z, gA.w, gB.x, gB.y, gB.z, gB.w}; unsigned yo[8];
#pragma unroll
            for (int j = 0; j < 4; ++j) { const f32x4 wv = gw4[j];
                const float ga = bflo(gq[2 * j]), gb = bfhi(gq[2 * j]), gc = bflo(gq[2 * j + 1]), gd = bfhi(gq[2 * j + 1]);
                yo[2 * j] = cvtpk(ov[j].x * rstd * wv.x * silu_fast(ga), ov[j].y * rstd * wv.y * silu_fast(gb));
                yo[2 * j + 1] = cvtpk(ov[j].z * rstd * wv.z * silu_fast(gc), ov[j].w * rstd * wv.w * silu_fast(gd)); }
            bf16* mo = MIX + row * D + 512 + h * 128 + dv0;
            *(v4u*)mo = (v4u){yo[0], yo[1], yo[2], yo[3]}; *(v4u*)(mo + 8) = (v4u){yo[4], yo[5], yo[6], yo[7]};
        }
    }
}
__device__ __forceinline__ void four_t1_setup(const Wg& w, bf16x8 (&T1)[8]) {
    const int lane = w.lane, wave = w.wave, r = lane & 31, h = lane >> 5;
    const int k2c = 32 * wave + r, k2 = k2c & 127;
#pragma unroll
    for (int s = 0; s < 8; ++s) { unsigned pk[4];
#pragma unroll
        for (int j = 0; j < 4; ++j) { const int n0 = 16 * s + 8 * h + 2 * j; const float f0 = (float)((n0 * k2) & 127) * (1.0f / 128.0f), f1 = (float)(((n0 + 1) * k2) & 127) * (1.0f / 128.0f);
            pk[j] = k2c < 128 ? cvtpk(cosrev(f0), cosrev(f1)) : cvtpk(-sinrev(f0), -sinrev(f1)); }
        T1[s] = __builtin_bit_cast(bf16x8, (v4u){pk[0], pk[1], pk[2], pk[3]}); }
}
__device__ __forceinline__ void ctx_dft1_item(const Args& a, const Wg& w, const bf16x8 (&T1)[8], const int item) {
    const int tid = w.tid, lane = w.lane, wave = w.wave, r = lane & 31, h = lane >> 5;
    const bf16* PBUF = WS_PTR(bf16, WS_PBUF); bf16* XB = WS_PTR(bf16, WS_XBC) - (size_t)NL * 4 * 256;
    LAS unsigned char* U = w.lds;
    const int g = item & 3, m0 = NL + (item >> 2) * 64;
    __syncthreads();
#pragma unroll
    for (int i = 0; i < 2; ++i) { const int id = tid + NTHR * i, aa = id >> 4, ch = id & 15;
        const v4u v = *(const v4u*)(PBUF + (size_t)(m0 + aa) * INP + PC_U + g * 128 + ch * 8);
        *(LAS v4u*)(U + aa * 272 + ch * 16) = v; }
    __syncthreads();
    f32x16 x0, x1;
#pragma unroll
    for (int i = 0; i < 16; ++i) { x0[i] = 0.f; x1[i] = 0.f; }
#pragma unroll
    for (int s = 0; s < 8; ++s) { const bf16x8 A0 = *(const LAS bf16x8*)(U + r * 272 + (16 * s + 8 * h) * 2), A1 = *(const LAS bf16x8*)(U + (32 + r) * 272 + (16 * s + 8 * h) * 2);
        x0 = MFMA32(A0, T1[s], x0); x1 = MFMA32(A1, T1[s], x1); }
    bf16* xo = XB + ((size_t)m0 * 4 + g) * 256 + 32 * wave + r;
#pragma unroll
    for (int i = 0; i < 16; ++i) { xo[(size_t)crow32(i, h) * 1024] = bf1(x0[i]); xo[(size_t)(32 + crow32(i, h)) * 1024] = bf1(x1[i]); }
}
__device__ __forceinline__ void ctx_dft2_item(const Args& a, const Wg& w, const int it) {
    const int tid = w.tid, lane = w.lane, wave = w.wave, r = lane & 31, h = lane >> 5, dt = wave >> 2, ct = wave & 3;
    const bf16* XB = WS_PTR(bf16, WS_XBC) - (size_t)NL * 4 * 256; bf16* MIX = WS_PTR(bf16, WS_MIX);
    const int b = it >> 4, g = (it >> 2) & 3, kq = it & 3, row0 = NL + b * CTXL;
    LAS unsigned char* T = w.lds; constexpr int P = 528;
    __syncthreads();
    v4u v[16];
#pragma unroll
    for (int i = 0; i < 16; ++i) { const int id = tid + NTHR * i, row = id >> 5, ch = id & 31; v[i] = *(const v4u*)(XB + ((size_t)(row0 + row) * 4 + g) * 256 + ch * 8); }
#pragma unroll
    for (int i = 0; i < 16; ++i) { const int id = tid + NTHR * i, row = id >> 5, ch = id & 31; *(LAS v4u*)(T + row * P + ch * 16) = v[i]; }
    __syncthreads();
    f32x16 y;
#pragma unroll
    for (int i = 0; i < 16; ++i) y[i] = 0.f;
    const int k1 = kq * 64 + dt * 32 + r;
#pragma unroll 4
    for (int s = 0; s < 32; ++s) { unsigned pa[4], pb[4];
#pragma unroll
        for (int jj = 0; jj < 4; ++jj) { const int n1 = 8 * s + 4 * h + jj; const float f = (float)((k1 * n1) & 255) * (1.0f / 256.0f); pa[jj] = cvtpk(cosrev(f), sinrev(f));
            const LAS unsigned char* p = T + n1 * P + (32 * ct + r) * 2; pb[jj] = (unsigned)*(const LAS bf16*)p | ((unsigned)*(const LAS bf16*)(p + 256) << 16); }
        y = MFMA32(__builtin_bit_cast(bf16x8, (v4u){pa[0], pa[1], pa[2], pa[3]}), __builtin_bit_cast(bf16x8, (v4u){pb[0], pb[1], pb[2], pb[3]}), y); }
    const float sc = 1.0f / sqrtf((float)CTXL * 128.0f);
    bf16* mo = MIX + (size_t)(row0 + kq * 64 + 32 * dt) * D + g * 128 + 32 * ct + r;
#pragma unroll
    for (int i = 0; i < 16; ++i) mo[(size_t)crow32(i, h) * D] = bf1(y[i] * sc);
}
__device__ __forceinline__ void four_a_setup(const Wg& w, bf16x8 (&T1)[8]) {
    const int tid = w.tid;
    LAS unsigned char* M64 = w.lds;
    __syncthreads();
    for (int i = tid; i < 128 * 128; i += NTHR) { const int row = i >> 7, col = i & 127, c = row & 63, ri = row >> 6, aa = col & 63, ri2 = col >> 6;
        const float f = (float)((c * aa) & 63) * (1.0f / 64.0f), cs = cosrev(f), sn = sinrev(f); const float v = (ri == ri2) ? cs : (ri == 0 ? sn : -sn);
        *(LAS bf16*)(M64 + row * 272 + col * 2) = (bf16)f2bf(v); }
    four_t1_setup(w, T1);
    __syncthreads();
}
__device__ __forceinline__ void four_a_item(const Args& a, const Wg& w, const bf16x8 (&T1)[8], const int item) {
    const int tid = w.tid, lane = w.lane, wave = w.wave, r = lane & 31, h = lane >> 5;
    const bf16* PBUF = WS_PTR(bf16, WS_PBUF); bf16* ZB = WS_PTR(bf16, WS_ZBUF);
    LAS unsigned char* M64 = w.lds; LAS unsigned char* U = w.lds + 34816; LAS unsigned char* XT = w.lds + 52224;
    const int b = item >> 8, g = (item >> 6) & 3, bcol = item & 63;
#pragma unroll
    for (int i = 0; i < 2; ++i) { const int id = tid + NTHR * i, aa = id >> 4, ch = id & 15;
        const v4u v = *(const v4u*)(PBUF + (size_t)(b * SEQ + 64 * aa + bcol) * INP + PC_U + g * 128 + ch * 8);
        *(LAS v4u*)(U + aa * 272 + ch * 16) = v; }
    __syncthreads();
    f32x16 x0, x1;
#pragma unroll
    for (int i = 0; i < 16; ++i) { x0[i] = 0.f; x1[i] = 0.f; }
#pragma unroll
    for (int s = 0; s < 8; ++s) { const bf16x8 A0 = *(const LAS bf16x8*)(U + r * 272 + (16 * s + 8 * h) * 2), A1 = *(const LAS bf16x8*)(U + (32 + r) * 272 + (16 * s + 8 * h) * 2);
        x0 = MFMA32(A0, T1[s], x0); x1 = MFMA32(A1, T1[s], x1); }
    { const int k2 = (32 * wave + r) & 127, ri2 = wave >> 2;
#pragma unroll
      for (int qq = 0; qq < 4; ++qq) {
          *(LAS v2u*)(XT + k2 * 272 + (ri2 * 64 + 8 * qq + 4 * h) * 2) = (v2u){cvtpk(x0[4 * qq], x0[4 * qq + 1]), cvtpk(x0[4 * qq + 2], x0[4 * qq + 3])};
          *(LAS v2u*)(XT + k2 * 272 + (ri2 * 64 + 32 + 8 * qq + 4 * h) * 2) = (v2u){cvtpk(x1[4 * qq], x1[4 * qq + 1]), cvtpk(x1[4 * qq + 2], x1[4 * qq + 3])}; } }
    __syncthreads();
    const int ct = wave & 3, rt = wave >> 2;
    f32x16 zr, zi;
#pragma unroll
    for (int i = 0; i < 16; ++i) { zr[i] = 0.f; zi[i] = 0.f; }
#pragma unroll
    for (int s = 0; s < 8; ++s) { const bf16x8 B = *(const LAS bf16x8*)(XT + (32 * ct + r) * 272 + (16 * s + 8 * h) * 2);
        const bf16x8 Ar = *(const LAS bf16x8*)(M64 + (32 * rt + r) * 272 + (16 * s + 8 * h) * 2), Ai = *(const LAS bf16x8*)(M64 + (64 + 32 * rt + r) * 272 + (16 * s + 8 * h) * 2);
        zr = MFMA32(Ar, B, zr); zi = MFMA32(Ai, B, zi); }
    bf16* zo = ZB + ((size_t)((b * 4 + g) * 64) * 64 + bcol) * 256 + 32 * ct + r;
#pragma unroll
    for (int i = 0; i < 16; ++i) { const int c = 32 * rt + crow32(i, h); const float f = (float)((bcol * c) & 4095) * (1.0f / 4096.0f), cs = cosrev(f), sn = sinrev(f);
        const float vr = zr[i] * cs + zi[i] * sn, vi = zi[i] * cs - zr[i] * sn;
        bf16* p = zo + (size_t)c * 64 * 256; const unsigned z2 = cvtpk(vr, vi); p[0] = (bf16)(z2 & 0xffffu); p[128] = (bf16)(z2 >> 16); }
}
__device__ __forceinline__ void four_b_setup(const Wg& w, bf16x8 (&M2)[8]) {
    const int lane = w.lane, wave = w.wave, r = lane & 31, h = lane >> 5, d = 32 * (wave >> 2) + r;
#pragma unroll
    for (int s = 0; s < 8; ++s) { unsigned pk[4];
#pragma unroll
        for (int j = 0; j < 4; ++j) { const int bc = (16 * s + 8 * h + 2 * j) >> 1; const float f = (float)((bc * d) & 63) * (1.0f / 64.0f); pk[j] = cvtpk(cosrev(f), sinrev(f)); }
        M2[s] = __builtin_bit_cast(bf16x8, (v4u){pk[0], pk[1], pk[2], pk[3]}); }
}
constexpr int FB_N = 4;
__device__ __forceinline__ void four_b_item(const Args& a, const Wg& w, const bf16x8 (&M2)[8], const int item) {
    const int tid = w.tid, lane = w.lane, wave = w.wave, r = lane & 31, h = lane >> 5, dt = wave >> 2, ct = wave & 3;
    const bf16* ZB = WS_PTR(bf16, WS_ZBUF); bf16* MIX = WS_PTR(bf16, WS_MIX);
    const float scale = 1.0f / sqrtf(4096.0f * 128.0f);
    const int b = item >> 6, g = (item >> 4) & 3, c0 = (item & 15) * FB_N;
    const bf16* zt = ZB + (size_t)((b * 4 + g) * 64 + c0) * 64 * 256;
    v4u v[FB_N][4];
#pragma unroll
    for (int t = 0; t < FB_N; ++t)
#pragma unroll
        for (int i = 0; i < 4; ++i) v[t][i] = *(const v4u*)(zt + (size_t)t * 64 * 256 + (size_t)(tid + NTHR * i) * 8);
#pragma unroll
    for (int t = 0; t < FB_N; ++t) { LAS unsigned char* ZT = w.lds + t * 33792;
#pragma unroll
        for (int i = 0; i < 4; ++i) { const int id = tid + NTHR * i, row = id >> 4, ch = id & 15;
            *(LAS v2u*)(ZT + row * 264 + ch * 16) = (v2u){v[t][i].x, v[t][i].y}; *(LAS v2u*)(ZT + row * 264 + ch * 16 + 8) = (v2u){v[t][i].z, v[t][i].w}; } }
    __syncthreads();
#pragma unroll
    for (int t = 0; t < FB_N; ++t) { const LAS unsigned char* ZT = w.lds + t * 33792;
        f32x16 y;
#pragma unroll
        for (int i = 0; i < 16; ++i) y[i] = 0.f;
#pragma unroll
        for (int s = 0; s < 8; ++s) { unsigned pk[4];
#pragma unroll
            for (int j = 0; j < 4; ++j) { const LAS unsigned char* p = ZT + (16 * s + 8 * h + 2 * j) * 264 + (32 * ct + r) * 2;
                pk[j] = (unsigned)*(const LAS bf16*)p | ((unsigned)*(const LAS bf16*)(p + 264) << 16); }
            y = MFMA32(M2[s], __builtin_bit_cast(bf16x8, (v4u){pk[0], pk[1], pk[2], pk[3]}), y); }
        bf16* mo = MIX + (size_t)(b * SEQ + c0 + t) * D + g * 128 + 32 * ct + r;
#pragma unroll
        for (int i = 0; i < 16; ++i) { const int d = 32 * dt + crow32(i, h); mo[(size_t)d * 64 * D] = bf1(y[i] * scale); } }
}
__device__ __forceinline__ void ph_mix_a(const Args& a, const Wg& w, const int l, const int rep = 0, const int mask = 7) {
    unsigned* ctr = (unsigned*)(a.ws + WS_CTL) + CW_Q + 64 * (2 * l) + 256 * rep;
    volatile LAS int* slot = (volatile LAS int*)(w.lds + GL_SLOT);
    const int nc1 = (l == 0) ? NC * 4 / 64 : 0;
    int par = 0; int item = wq_next(ctr, slot + 2, w.tid);
    if (item < nc1) {
        bf16x8 T1[8]; four_t1_setup(w, T1);
        while (item < nc1) { const int c = wq_claim(ctr, w.tid); if (mask & 4) ctx_dft1_item(a, w, T1, item); item = wq_take(slot, par, c, w.tid); }
    }
    while (item < nc1 + NG1) { const int c = wq_claim(ctr, w.tid); if (mask & 1) gla_g1_job(a, w, l, item - nc1, rep ? REP_VAR : 0); item = wq_take(slot, par, c, w.tid); }
    if (item < nc1 + NG1 + 2048) {
        bf16x8 T1[8]; four_a_setup(w, T1);
        while (item < nc1 + NG1 + 2048) { const int c = wq_claim(ctr, w.tid); if (mask & 2) four_a_item(a, w, T1, item - nc1 - NG1); item = wq_take(slot, par, c, w.tid); }
    }
}
__device__ __forceinline__ void ph_mix_c(const Args& a, const Wg& w, const int l, const int rep = 0, const int mask = 7) {
    unsigned* ctr = (unsigned*)(a.ws + WS_CTL) + CW_Q + 64 * (2 * l + 1) + 256 * rep;
    volatile LAS int* slot = (volatile LAS int*)(w.lds + GL_SLOT);
    const int ng3 = (l == 0) ? 544 : 512, nctx = (l == 0) ? 128 : 0;
    int par = 0; int item = wq_next(ctr, slot + 2, w.tid);
    if (item < nctx) {
        while (item < nctx) { const int c = wq_claim(ctr, w.tid); if (mask & 4) ctx_dft2_item(a, w, item); item = wq_take(slot, par, c, w.tid); }
    }
    while (item < nctx + ng3) {
        const int it = item - nctx, job = (l == 0) ? it : ((it >> 4) * 17 + (it & 15) + 1);
        const int c = wq_claim(ctr, w.tid); if (mask & 1) gla_g3_job(a, w, l, job, rep ? REP_VAR : 0); item = wq_take(slot, par, c, w.tid); }
    if (item < nctx + ng3 + 2048 / FB_N) {
        bf16x8 M2[8]; four_b_setup(w, M2);
        while (item < nctx + ng3 + 2048 / FB_N) { const int c = wq_claim(ctr, w.tid); __syncthreads(); if (mask & 2) four_b_item(a, w, M2, item - nctx - ng3); item = wq_take(slot, par, c, w.tid); }
    }
}
constexpr int CONV_WAVE_ITEMS = 16 * (16 * 112) + 8 * (56 * 32), CONV_ITEMS = CONV_WAVE_ITEMS / 8;
static_assert(CONV_WAVE_ITEMS % 8 == 0, "conversion items");
__device__ __forceinline__ void conv_items(const Args& a, const Wg& w, const int max_items) {
    const float* moe_w1 = a.in[19]; const float* moe_w3 = a.in[20]; const float* moe_w2 = a.in[21];
    unsigned char* MW13 = WS_PTR(unsigned char, WS_MW13); unsigned char* MW2 = WS_PTR(unsigned char, WS_MW2);
    unsigned* ctr = (unsigned*)(a.ws + WS_CTL) + CW_CONVQ;
    volatile LAS int* slot = (volatile LAS int*)(w.lds + 72 * 1024);
    LAS float* scr = (LAS float*)(w.lds + 1024 + w.wave * 8448);
    constexpr int I_M13 = 16 * 112, I_M2 = 56 * 32;
    for (int n = 0; n < max_items; ++n) {
        const int item = wq_next(ctr, slot, w.tid);
        if (item >= CONV_ITEMS) break;
        int r = item * 8 + w.wave;
        if (r < 8 * I_M13) { const int e = r / I_M13; transpose_item8(moe_w1 + (size_t)e * D * EFF, D, EFF, MW13 + (size_t)e * 2 * EFF * D, 0, 1, FP8_SW, scr, r % I_M13, w.lane); continue; } r -= 8 * I_M13;
        if (r < 8 * I_M13) { const int e = r / I_M13; transpose_item8(moe_w3 + (size_t)e * D * EFF, D, EFF, MW13 + (size_t)e * 2 * EFF * D, 0, 2, FP8_SW, scr, r % I_M13, w.lane); continue; } r -= 8 * I_M13;
        { const int e = r / I_M2; transpose_item8(moe_w2 + (size_t)e * EFF * D, EFF, D, MW2 + (size_t)e * D * EFF, 0, 0, FP8_SW, scr, r % I_M2, w.lane); }
    }
    __syncthreads();
}
__device__ __forceinline__ void conv_in_tail(const Args& a, const Wg& w, const int nunits, const int quota) {
    const int mine = (nunits - w.bx + w.G - 1) / w.G, most = (nunits + w.G - 1) / w.G;
    if (mine < most) conv_items(a, w, quota);
}
__device__ __forceinline__ void ph_gout(const Args& a, const Wg& w, const int l) {
    const float* modl = WS_PTR(float, WS_MODV) + (size_t)l * 9 * MOD6;
    pg8::DenseOrder S; S.init(WS_PTR(bf16, WS_MIX), WS_PTR(bf16, WS_WOUT) + (size_t)l * D * D, l == 0 ? MT : NL, D, D, w.G, w.bx);
    pg8::EpiRes E{l == 0 ? a.in[0] : nullptr, l == 0 ? a.in[2] : nullptr, WS_PTR(bf16, WS_XRES), modl + 2 * D, 1.0f};
    pg8::gemm_phase<pg8::EpiRes, pg8::DenseOrder, true, false>(w.lds, D, S, E);
    if (l == 0) conv_in_tail(a, w, (MT / 256) * (D / 256), CONV_Q_GOUT);
}
__device__ __forceinline__ void ph_fup(const Args& a, const Wg& w) {
    constexpr int KA = (FP8_FUP || I8_FUP) ? D / 2 : D;
    pg8::DenseOrder S; S.init(WS_PTR(bf16, WS_HBUF), WS_PTR(bf16, WS_W13), MT, 2 * DFF, KA, w.G, w.bx);
    constexpr float inv = FP8_FUP ? 1.0f / (FP8_SH * FP8_SW) : 1.0f;
    if constexpr (I8_FUP) { static_assert(FP8_FDN, "the int8 up GEMM writes an fp8 hidden");
        pg8::EpiSwiGLU8i E{WS_PTR(unsigned char, WS_HID), DFF, WS_PTR(float, WS_RS), WS_PTR(float, WS_WCS) + WCS_W1, WS_PTR(float, WS_WCS) + WCS_W3, FP8_SHID}; pg8::gemm_phase<pg8::EpiSwiGLU8i, pg8::DenseOrder, true, false, 2>(w.lds, KA, S, E); }
    else if constexpr (FP8_FDN) { pg8::EpiSwiGLU8 E{WS_PTR(unsigned char, WS_HID), DFF, inv, FP8_SHID, 0}; pg8::gemm_phase<pg8::EpiSwiGLU8, pg8::DenseOrder, true, false, FP8_FUP ? 1 : 0>(w.lds, KA, S, E); }
    else { pg8::EpiSwiGLU E{WS_PTR(bf16, WS_HID), DFF, inv}; pg8::gemm_phase<pg8::EpiSwiGLU, pg8::DenseOrder, true, false, FP8_FUP ? 1 : 0>(w.lds, KA, S, E); }
    conv_in_tail(a, w, (MT / 256) * (2 * DFF / 256), CONV_Q_FUP);
}
__device__ __forceinline__ void ph_fdn(const Args& a, const Wg& w) {
    const float* modl = WS_PTR(float, WS_MODV);
    constexpr int KA = FP8_FDN ? DFF / 2 : DFF;
    pg8::DenseOrder S; S.init(WS_PTR(bf16, WS_HID), WS_PTR(bf16, WS_W2), MT, D, KA, w.G, w.bx); pg8::EpiRes E{nullptr, nullptr, WS_PTR(bf16, WS_XRES), modl + 5 * D, FP8_FDN ? 1.0f / (FP8_SHID * FP8_SW) : 1.0f};
    pg8::gemm_phase<pg8::EpiRes, pg8::DenseOrder, true, false, FP8_FDN ? 1 : 0>(w.lds, KA, S, E);
    conv_in_tail(a, w, (MT / 256) * (D / 256), CONV_Q_FDN);
}
__device__ __forceinline__ void ph_route(const Args& a, const Wg& w) {
    if (w.bx >= 128) return;
    const int tid = w.tid, lane = w.lane, wave = w.wave;
    const int* TOKE = WS_PTR(int, WS_ROUTE + RT_TOKE); const float* TOKG = WS_PTR(float, WS_ROUTE + RT_TOKG);
    int* RIDX = WS_PTR(int, WS_ROUTE + RT_RIDX); float* RGATE = WS_PTR(float, WS_ROUTE + RT_RGATE); int* TEXP = WS_PTR(int, WS_ROUTE + RT_TEXP); int* NTL = WS_PTR(int, WS_ROUTE + RT_NT);
    const int s = w.bx >> 6, e = (w.bx >> 3) & 7, seg = w.bx & 7;
    LAS int* cnt = (LAS int*)w.lds;
    LAS int* wtot = (LAS int*)(w.lds + 64);
    if (tid < 9) cnt[tid] = 0;
    __syncthreads();
    int lc[9];
#pragma unroll
    for (int q = 0; q < 9; ++q) lc[q] = 0;
    for (int t = 4 * tid; t < NL; t += 4 * NTHR) { const int4 te = *(const int4*)(TOKE + s * NL + t); const int bef = t < seg * 4096;
#pragma unroll
        for (int q = 0; q < 8; ++q) lc[q] += (te.x == q) + (te.y == q) + (te.z == q) + (te.w == q);
        lc[8] += bef ? (te.x == e) + (te.y == e) + (te.z == e) + (te.w == e) : 0; }
#pragma unroll
    for (int q = 0; q < 9; ++q) { int v = lc[q];
#pragma unroll
        for (int o = 1; o < 64; o <<= 1) v += __shfl_xor(v, o);
        if (lane == 0) atomicAdd((int*)&cnt[q], v); }
    __syncthreads();
    int base = 0, total = 0, mycnt = 0;
    for (int q = 0; q < 8; ++q) { const int cq = cnt[q], tq = (cq + 255) >> 8; if (q < e) base += tq * 256; if (q == e) mycnt = cq; total += tq; }
    int running = cnt[8];
    for (int t0 = seg * 4096; t0 < seg * 4096 + 4096; t0 += 4 * NTHR) {
        const int t = t0 + 4 * tid; const int4 te = *(const int4*)(TOKE + s * NL + t);
        const int f0 = te.x == e, f1 = te.y == e, f2 = te.z == e, f3 = te.w == e, mine = f0 + f1 + f2 + f3;
        int incl = mine;
#pragma unroll
        for (int o = 1; o < 64; o <<= 1) { const int v = __shfl_up(incl, o); if (lane >= o) incl += v; }
        const int wt = __shfl(incl, 63);
        __syncthreads();
        if (lane == 0) wtot[wave] = wt;
        __syncthreads();
        int woff = 0, ctot = 0;
#pragma unroll
        for (int q = 0; q < 8; ++q) { const int v = wtot[q]; if (q < wave) woff += v; ctot += v; }
        int pos = s * RT_TILES * 256 + base + running + woff + incl - mine;
        int* POS = WS_PTR(int, WS_ROUTE + RT_POS) + s * NL; const int pb = s * RT_TILES * 256;
        if (f0) { RIDX[pos] = t;     RGATE[pos] = TOKG[s * NL + t];     POS[t] = pos - pb;     ++pos; }
        if (f1) { RIDX[pos] = t + 1; RGATE[pos] = TOKG[s * NL + t + 1]; POS[t + 1] = pos - pb; ++pos; }
        if (f2) { RIDX[pos] = t + 2; RGATE[pos] = TOKG[s * NL + t + 2]; POS[t + 2] = pos - pb; ++pos; }
        if (f3) { RIDX[pos] = t + 3; RGATE[pos] = TOKG[s * NL + t + 3]; POS[t + 3] = pos - pb; ++pos; }
        running += ctot; }
    if (seg == 0) {
        const int padend = base + ((mycnt + 255) >> 8) * 256;
        for (int p = base + mycnt + tid; p < padend; p += NTHR) { RIDX[s * RT_TILES * 256 + p] = -1; RGATE[s * RT_TILES * 256 + p] = 0.f; }
        for (int tl = (base >> 8) + tid; tl < (padend >> 8); tl += NTHR) TEXP[s * RT_TILES + tl] = e;
        if (e == 0 && tid == 0) NTL[s * 64] = total;
    }
    __syncthreads();
}
__device__ __forceinline__ void ph_mup(const Args& a, const Wg& w, const int skip = 0) {
    const int nt0 = __builtin_amdgcn_readfirstlane(__hip_atomic_load(WS_PTR(int, WS_ROUTE + RT_NT), __ATOMIC_RELAXED, __HIP_MEMORY_SCOPE_AGENT));
    const int nt1 = __builtin_amdgcn_readfirstlane(__hip_atomic_load(WS_PTR(int, WS_ROUTE + RT_NT) + 64, __ATOMIC_RELAXED, __HIP_MEMORY_SCOPE_AGENT));
    pg8::MoeOrder S; S.oc.init(nt0 + nt1, 2 * EFF / 256, w.G, w.bx); S.A = (const char*)WS_PTR(bf16, WS_HBUF); S.Bt = (const char*)WS_PTR(bf16, WS_MW13); S.tstepA = 0; S.tstepB = (size_t)256 * D; S.estride = (size_t)2 * EFF * D;
    S.texp = WS_PTR(int, WS_ROUTE + RT_TEXP); S.ridx = WS_PTR(int, WS_ROUTE + RT_RIDX); S.nt0 = nt0; S.gap = RT_TILES - nt0;
    pg8::EpiSwiGLU8 E{WS_PTR(unsigned char, WS_HID2), EFF, 1.0f / (FP8_SH * FP8_SW), FP8_SHID, skip};
    pg8::gemm_phase<pg8::EpiSwiGLU8, pg8::MoeOrder, true, true, 1>(w.lds, D / 2, S, E);
}
__device__ __forceinline__ void ph_mdn(const Args& a, const Wg& w, const int s) {
    const int ntl = __builtin_amdgcn_readfirstlane(__hip_atomic_load(WS_PTR(int, WS_ROUTE + RT_NT) + s * 64, __ATOMIC_RELAXED, __HIP_MEMORY_SCOPE_AGENT));
    const float* modl = WS_PTR(float, WS_MODV) + (size_t)9 * MOD6;
    pg8::MoeOrder S; S.oc.init(ntl, D / 256, w.G, w.bx); S.A = (const char*)WS_PTR(unsigned char, WS_HID2) + (size_t)s * RT_TILES * 256 * EFF; S.Bt = (const char*)WS_PTR(bf16, WS_MW2); S.tstepA = (size_t)256 * EFF; S.tstepB = (size_t)256 * EFF; S.estride = (size_t)D * EFF;
    S.texp = WS_PTR(int, WS_ROUTE + RT_TEXP) + s * RT_TILES; S.ridx = WS_PTR(int, WS_ROUTE + RT_RIDX) + s * RT_TILES * 256; S.nt0 = 1 << 30; S.gap = 0;
    pg8::EpiScatter E{WS_PTR(int, WS_ROUTE + RT_RIDX) + s * RT_TILES * 256, WS_PTR(float, WS_ROUTE + RT_RGATE) + s * RT_TILES * 256, WS_PTR(bf16, WS_XRES), modl + 5 * D, 1.0f / (FP8_SHID * FP8_SW)};
    pg8::gemm_phase<pg8::EpiScatter, pg8::MoeOrder, true, false, 1>(w.lds, EFF / 2, S, E);
}
__device__ __forceinline__ void ph_mdn2(const Args& a, const Wg& w) {
    const int nt0 = __builtin_amdgcn_readfirstlane(__hip_atomic_load(WS_PTR(int, WS_ROUTE + RT_NT), __ATOMIC_RELAXED, __HIP_MEMORY_SCOPE_AGENT));
    const int nt1 = __builtin_amdgcn_readfirstlane(__hip_atomic_load(WS_PTR(int, WS_ROUTE + RT_NT) + 64, __ATOMIC_RELAXED, __HIP_MEMORY_SCOPE_AGENT));
    pg8::MoeOrderRM S; S.nwg = (nt0 + nt1) * (D / 256); S.G = w.G; S.c = w.bx; S.A = (const char*)WS_PTR(unsigned char, WS_HID2); S.Bt = (const char*)WS_PTR(bf16, WS_MW2); S.tstepA = (size_t)256 * EFF; S.tstepB = (size_t)256 * EFF; S.estride = (size_t)D * EFF;
    S.texp = WS_PTR(int, WS_ROUTE + RT_TEXP); S.nt0 = nt0; S.gap = RT_TILES - nt0;
    pg8::EpiY E{WS_PTR(float, WS_ROUTE + RT_RGATE), WS_PTR(bf16, WS_Y0), WS_PTR(bf16, WS_HBUF), WS_PTR(bf16, WS_SLOC), 1.0f / (FP8_SHID * FP8_SW), RT_TILES, Y1_SPLIT};
    pg8::gemm_phase<pg8::EpiY, pg8::MoeOrderRM, true, false, 1>(w.lds, EFF / 2, S, E);
}
__device__ __forceinline__ void ph_final2(const Args& a, const Wg& w) {
    const int lane = w.lane; const float* fw = a.in[22]; const bf16* XRES = WS_PTR(bf16, WS_XRES); const bf16* Y0 = WS_PTR(bf16, WS_Y0);
    const bf16* Y1A = WS_PTR(bf16, WS_HBUF); const bf16* Y1B = WS_PTR(bf16, WS_SLOC) - (size_t)Y1_SPLIT * 256 * D;
    const int* POS = WS_PTR(int, WS_ROUTE + RT_POS); const float* gate = WS_PTR(float, WS_MODV) + (size_t)9 * MOD6 + 5 * D;
    f32x4 wv[4];
#pragma unroll
    for (int j = 0; j < 4; ++j) wv[j] = *(const f32x4*)(fw + 4 * lane + 256 * j);
    constexpr int TB = 2;
    int np0[TB], np1[TB];
    { const int m0 = w.gw * TB;
#pragma unroll
      for (int k = 0; k < TB; ++k) { np0[k] = m0 + k < NL ? POS[m0 + k] : 0; np1[k] = m0 + k < NL ? POS[NL + m0 + k] : 0; } }
    for (int m0 = w.gw * TB; m0 < NL; m0 += w.NGW * TB) {
        pg8::u32x2_t xr[TB][4], y0r[TB][4], y1r[TB][4];
#pragma unroll
        for (int k = 0; k < TB; ++k) { const int p0 = __builtin_amdgcn_readfirstlane(np0[k]), p1 = __builtin_amdgcn_readfirstlane(np1[k]);
            const bf16* y1p = (p1 < Y1_SPLIT * 256 ? Y1A : Y1B) + (size_t)p1 * D;
#pragma unroll
            for (int j = 0; j < 4; ++j) { const int c = 4 * lane + 256 * j; xr[k][j] = *(const pg8::u32x2_t*)(XRES + (size_t)(m0 + k) * D + c); y0r[k][j] = *(const pg8::u32x2_t*)(Y0 + (size_t)p0 * D + c); y1r[k][j] = *(const pg8::u32x2_t*)(y1p + c); } }
        { const int mn = m0 + w.NGW * TB;
#pragma unroll
          for (int k = 0; k < TB; ++k) { np0[k] = mn + k < NL ? POS[mn + k] : 0; np1[k] = mn + k < NL ? POS[NL + mn + k] : 0; } }
        const float* gp = gate + (m0 >> 12) * MOD6;
        f32x4 g[4];
#pragma unroll
        for (int j = 0; j < 4; ++j) g[j] = *(const f32x4*)(gp + 4 * lane + 256 * j);
#pragma unroll
        for (int k = 0; k < TB; ++k) {
            f32x4 v[4]; float ss = 0.f;
#pragma unroll
            for (int j = 0; j < 4; ++j) { v[j] = pg8::bf4_to_f32(xr[k][j]) + g[j] * (pg8::bf4_to_f32(y0r[k][j]) + pg8::bf4_to_f32(y1r[k][j])); ss += (v[j].x * v[j].x + v[j].y * v[j].y) + (v[j].z * v[j].z + v[j].w * v[j].w); }
            const float rstd = 1.0f / sqrtf(wave_sum(ss) * (1.0f / D) + EPS);
            float* xo = a.out + (size_t)(m0 + k) * D;
#pragma unroll
            for (int j = 0; j < 4; ++j) *(f32x4*)(xo + 4 * lane + 256 * j) = (v[j] * rstd) * wv[j]; }
    }
}
__device__ __forceinline__ void ph_final(const Args& a, const Wg& w) {
    const int lane = w.lane; const float* fw = a.in[22]; const bf16* XRES = WS_PTR(bf16, WS_XRES);
    for (int m = w.gw; m < NL; m += w.NGW) {
        float* xr = a.out + (size_t)m * D;
        f32x4 v[4]; float ss = 0.f;
#pragma unroll
        for (int j = 0; j < 4; ++j) { v[j] = pg8::bf4_to_f32(*(const pg8::u32x2_t*)(XRES + (size_t)m * D + 4 * lane + 256 * j)); ss += (v[j].x * v[j].x + v[j].y * v[j].y) + (v[j].z * v[j].z + v[j].w * v[j].w); }
        const float rstd = 1.0f / sqrtf(wave_sum(ss) * (1.0f / D) + EPS);
#pragma unroll
        for (int j = 0; j < 4; ++j) { const int c = 4 * lane + 256 * j; *(f32x4*)(xr + c) = (v[j] * rstd) * *(const f32x4*)(fw + c); }
    }
}

constexpr int NPH = 23;
__global__ void __launch_bounds__(NTHR, 2) fwd_kernel(Args args) {
    extern __shared__ __attribute__((aligned(16))) unsigned char lds_raw[];
    Wg w; w.lds = (LAS unsigned char*)lds_raw;
    volatile LAS unsigned* MISC = (volatile LAS unsigned*)(w.lds + MISC_OFF);
    w.wave = __builtin_amdgcn_readfirstlane((int)threadIdx.x >> 6); w.lane = (int)__builtin_amdgcn_mbcnt_hi(~0u, __builtin_amdgcn_mbcnt_lo(~0u, 0u)); w.tid = w.wave * 64 + w.lane;
    w.G = gridDim.x; w.bx = blockIdx.x; w.gw = w.bx * NWAVES + w.wave; w.NGW = w.G * NWAVES;
    unsigned* ctl = (unsigned*)(args.ws + WS_CTL);
    for (int u = w.tid; u < (LDS_BYTES - LDSCTL_OFF) / 4; u += NTHR) ((LAS unsigned*)(w.lds + LDSCTL_OFF))[u] = 0u;
    __syncthreads();
    XcdBarrier bar; bar.bar = ctl + CW_BAR; bar.x = 0; bar.st = nullptr;
    if (!MK_MULTI) bar = xcd_barrier_post(ctl + CW_BAR, MISC + 8);
    const int lo = args.ph_lo, hi = args.ph_hi;
#define PH(id, call) do { if (lo <= (id) && (id) < hi) { call; if (!MK_MULTI && (id) + 1 < hi) xcd_barrier(bar); } } while (0)
#define PHR(n, id, call) do { if ((n) > 1) { call; xcd_barrier(bar); } PH(id, call); } while (0)
    PHR(REP_PRO, 0, ph_prologue(args, w));
    PH(1, ph_modfin(args, w));
    PHR(REP_NORM, 2, (ph_norm(args, w, 0, 0), ph_quant(args, w)));
    PHR(REP_GIN, 3, ph_gin(args, w, 0));
    if (REP_MIXA > 1) { ph_mix_a(args, w, 0, 1, REP_MASK); xcd_barrier(bar); }
    PH(4, ph_mix_a(args, w, 0));
    PH(5, ph_gla_scan(args, w));
    if (REP_MIXC > 1) { ph_mix_c(args, w, 0, 1, REP_MASK); xcd_barrier(bar); }
    PH(6, ph_mix_c(args, w, 0));
    PHR(REP_GOUT, 7, ph_gout(args, w, 0));
    PHR(REP_NORM, 8, ph_norm(args, w, 0, 1));
    PHR(REP_FUP, 9, ph_fup(args, w));
    PH(10, ph_fdn(args, w));
    PHR(REP_NORM, 11, ph_norm(args, w, 1, 0));
    PHR(REP_GIN, 12, ph_gin(args, w, 1));
    if (REP_MIXA > 1) { ph_mix_a(args, w, 1, 1, REP_MASK); xcd_barrier(bar); }
    PH(13, ph_mix_a(args, w, 1));
    PH(14, ph_gla_scan(args, w));
    if (REP_MIXC > 1) { ph_mix_c(args, w, 1, 1, REP_MASK); xcd_barrier(bar); }
    PH(15, ph_mix_c(args, w, 1));
    PH(16, ph_gout(args, w, 1));
    PHR(REP_NORM, 17, ph_norm(args, w, 1, 1));
    PHR(REP_PRO, 18, (ph_route(args, w), conv_items(args, w, 1 << 30)));
    if (REP_MUP > 1) { ph_mup(args, w, REP_VAR); xcd_barrier(bar); } PH(19, ph_mup(args, w));
#if MDN_MERGE
    PH(20, ph_mdn2(args, w));
    PH(21, ph_final2(args, w));
#else
    PH(20, ph_mdn(args, w, 0));
    PH(21, ph_mdn(args, w, 1));
    PH(22, ph_final(args, w));
#endif
#undef PH
#undef PHR
}

extern "C" void kernel_launch(void* const* d_in, const int* in_sizes, int n_in, void* d_out, int out_size, void* d_ws, size_t ws_size, hipStream_t stream) {
    static int grid = 0;
    if (grid == 0) {
        if (n_in != 23 || out_size != NL * D || ws_size < WS_END) { fprintf(stderr, "kernel_launch: unexpected shapes (n_in %d, out %d, ws %zu < %zu); nothing launched\n", n_in, out_size, ws_size, (size_t)WS_END); grid = -1; return; }
        int dev = 0, cus = 0, per_cu = 0;
        if (hipGetDevice(&dev) != hipSuccess || hipDeviceGetAttribute(&cus, hipDeviceAttributeMultiprocessorCount, dev) != hipSuccess) { grid = -1; return; }
        if (hipFuncSetAttribute((const void*)fwd_kernel, hipFuncAttributeMaxDynamicSharedMemorySize, LDS_BYTES) != hipSuccess) { fprintf(stderr, "kernel_launch: hipFuncSetAttribute failed\n"); grid = -1; return; }
        if (hipOccupancyMaxActiveBlocksPerMultiprocessor(&per_cu, (const void*)fwd_kernel, NTHR, LDS_BYTES) != hipSuccess || per_cu < 1) { fprintf(stderr, "kernel_launch: occupancy query says %d blocks per CU\n", per_cu); }
        (void)hipGetLastError();
        grid = cus;
    }
    if (grid < 0) return;
    if (hipMemsetAsync((char*)d_ws + WS_CTL, 0, CTL_ZERO_BYTES, stream) != hipSuccess) { fprintf(stderr, "kernel_launch: memset failed\n"); return; }
    Args a{};
    for (int i = 0; i < 23; ++i) a.in[i] = (const float*)d_in[i];
    a.out = (float*)d_out; a.ws = (unsigned char*)d_ws; a.pad = 0;
#if MK_MULTI
    for (int p = 0; p < NPH; ++p) { a.ph_lo = p; a.ph_hi = p + 1; a.li = p; hipLaunchKernelGGL(fwd_kernel, dim3(grid), dim3(NTHR), LDS_BYTES, stream, a); }
#else
    a.ph_lo = 0; a.ph_hi = MDN_MERGE ? 22 : NPH; a.li = 0;
    hipLaunchKernelGGL(fwd_kernel, dim3(grid), dim3(NTHR), LDS_BYTES, stream, a);
#endif
    const hipError_t le = hipPeekAtLastError();
    if (le != hipSuccess) fprintf(stderr, "kernel_launch: launch failed: %s\n", hipGetErrorName(le));
}
```

```cpp
#include <hip/hip_runtime.h>
#include <cstdio>
#include <cstdint>

#ifndef CONV_Q_GIN
#define CONV_Q_GIN 4
#define CONV_Q_GOUT 8
#define CONV_Q_FUP 4
#define CONV_Q_FDN 7
#endif
#ifndef REP_GIN
#define REP_GIN 1
#endif
#ifndef REP_GOUT
#define REP_GOUT 1
#endif
#ifndef REP_FUP
#define REP_FUP 1
#endif
#ifndef REP_MUP
#define REP_MUP 1
#endif
#ifndef REP_GEMM
#define REP_GEMM 1
#endif
#ifndef REP_NORM
#define REP_NORM 1
#endif
#ifndef REP_MIXA
#define REP_MIXA 1
#endif
#ifndef REP_VAR
#define REP_VAR 0
#endif
#ifndef REP_MASK
#define REP_MASK 7
#endif
#ifndef REP_MIXC
#define REP_MIXC 1
#endif
#ifndef REP_PRO
#define REP_PRO 1
#endif
#ifndef I8_GIN
#define I8_GIN 1
#endif
#ifndef I8_FUP
#define I8_FUP 1
#endif
#ifndef FP8_FUP
#define FP8_FUP 0
#endif
#ifndef FP8_FDN
#define FP8_FDN 1
#endif
#ifndef MK_MULTI
#define MK_MULTI 0
#endif

constexpr int D = 1024, NB = 8, SEQ = 4096, CTXL = 256;
constexpr int NL = NB * SEQ;
constexpr int NC = NB * CTXL;
constexpr int MT = NL + NC;
constexpr int INW = 2080, INP = 2304;
constexpr int DFF = 2816, EFF = 3584, NE = 8;
constexpr int MOD6 = 6 * D;
constexpr float EPS = 1e-6f;
constexpr float FP8_SH = 16.0f, FP8_SW = 512.0f, FP8_SHID = 8.0f;
constexpr int PC_U = 0, PC_Q = 512, PC_K = 768, PC_V = 1024, PC_G = 1536, PC_LF = 2048, PC_LB = 2064;

namespace pg8 {
#define PG8_LAS __attribute__((address_space(3)))
typedef unsigned short bf16_t;
typedef short bf16x8 __attribute__((ext_vector_type(8)));
typedef float f32x4 __attribute__((ext_vector_type(4)));
typedef unsigned u32x4 __attribute__((ext_vector_type(4)));
constexpr int BM = 256, BK = 64, HALF = 128, HTB = HALF * BK * 2, STAGE_BYTES = 8 * HTB, NXCD = 8, WGM = 8;

__host__ __device__ __forceinline__ int lds_byte(int r, int c) { const int st = (r >> 4) * 2 + (c >> 5), rr = r & 15, cc = c & 31, ob = rr * 64 + cc * 2; return st * 1024 + (ob ^ (((ob >> 9) & 1) << 5)); }
__host__ __device__ __forceinline__ void stage_rc(int b, int& R, int& C) { const int st = b / 1024, sb = b % 1024, swz = sb ^ (((sb >> 9) & 1) << 5); R = (st >> 1) * 16 + swz / 64; C = (st & 1) * 32 + (swz % 64) / 2; }
__host__ __device__ __forceinline__ int perm32(int rho) { const int n = rho >> 4, i = rho & 15; return 8 * (i >> 2) + 4 * n + (i & 3); }

struct Unit { int pm, pn; const char* a; const char* b; const int* ridx; };

__device__ __forceinline__ const char* uptr(const char* p) { const unsigned long long v = (unsigned long long)p; const unsigned lo = __builtin_amdgcn_readfirstlane((unsigned)v), hi = __builtin_amdgcn_readfirstlane((unsigned)(v >> 32)); return (const char*)(((unsigned long long)hi << 32) | lo); }
__device__ __forceinline__ void glds_s(const char* base, unsigned voff, unsigned lds_dst) { unsigned keep;
    asm volatile("s_mov_b32 %0, m0\n\ts_mov_b32 m0, %3\n\ts_nop 0\n\tglobal_load_lds_dwordx4 %1, %2\n\ts_mov_b32 m0, %0" : "=&s"(keep) : "v"(voff), "s"((unsigned long long)base), "s"(lds_dst) : "memory"); }
struct OrderCore {
    int nM, nN, nwg, G, c;
    __device__ __forceinline__ void init(int nM_, int nN_, int G_, int c_) { nM = nM_; nN = nN_; nwg = nM * nN; G = G_; c = c_; }
    __device__ __forceinline__ bool tile(int i, int& pm, int& pn) const {
        const long L = (long)i * G + c; if (L >= nwg) return false;
        int wgid = (int)L; { const int q = nwg / NXCD, r = nwg % NXCD, xcd = wgid % NXCD, off = wgid / NXCD; wgid = (xcd < r ? xcd * (q + 1) : r * (q + 1) + (xcd - r) * q) + off; }
        const int nig = WGM * nN, gid = wgid / nig, fm = gid * WGM, gsz = (nM - fm) < WGM ? (nM - fm) : WGM;
        pm = fm + ((wgid % nig) % gsz); pn = (wgid % nig) / gsz; return true;
    }
};
struct DenseOrder {
    OrderCore oc; const char* A; const char* Bt; size_t tstep;
    __device__ __forceinline__ void init(const bf16_t* A_, const bf16_t* Bt_, int M, int N, int K, int G, int c) { oc.init(M / BM, N / BM, G, c); A = (const char*)A_; Bt = (const char*)Bt_; tstep = (size_t)BM * K * 2; }
    __device__ __forceinline__ bool next(int i, Unit& u) const { if (!oc.tile(i, u.pm, u.pn)) return false; u.pm = __builtin_amdgcn_readfirstlane(u.pm); u.pn = __builtin_amdgcn_readfirstlane(u.pn); u.a = uptr(A + (size_t)u.pm * tstep); u.b = uptr(Bt + (size_t)u.pn * tstep); u.ridx = nullptr; return true; }
};
struct MoeOrder {
    OrderCore oc; const char* A; const char* Bt; size_t tstepA, tstepB, estride; const int* texp; const int* ridx; int nt0, gap;
    __device__ __forceinline__ bool next(int i, Unit& u) const { if (!oc.tile(i, u.pm, u.pn)) return false;
        u.pm = u.pm < nt0 ? u.pm : u.pm + gap;
        const int e = __builtin_amdgcn_readfirstlane(__hip_atomic_load(texp + u.pm, __ATOMIC_RELAXED, __HIP_MEMORY_SCOPE_AGENT));
        u.pm = __builtin_amdgcn_readfirstlane(u.pm); u.pn = __builtin_amdgcn_readfirstlane(u.pn); u.a = uptr(A + (size_t)u.pm * tstepA); u.b = uptr(Bt + (size_t)e * estride + (size_t)u.pn * tstepB); u.ridx = (const int*)uptr((const char*)(ridx + u.pm * BM)); return true; }
};

typedef int v4i_t __attribute__((ext_vector_type(4)));
typedef int v8i_t __attribute__((ext_vector_type(8)));
__device__ __forceinline__ v8i_t cat8(const bf16x8 lo, const bf16x8 hi) { const v4i_t a = __builtin_bit_cast(v4i_t, lo), b = __builtin_bit_cast(v4i_t, hi); return __builtin_shufflevector(a, b, 0, 1, 2, 3, 4, 5, 6, 7); }
__device__ __forceinline__ void mfma8(f32x4& acc, const v8i_t a, const v8i_t b, const int sc) {
    asm volatile("v_mfma_scale_f32_16x16x128_f8f6f4 %0, %1, %2, %0, %3, %3 op_sel_hi:[0,0,0]" : "+v"(acc) : "v"(a), "v"(b), "v"(sc)); }
__device__ __forceinline__ unsigned pk4_fp8_raw(float a, float b, float c, float d) { int r = __builtin_amdgcn_cvt_pk_fp8_f32(a, b, 0, false); r = __builtin_amdgcn_cvt_pk_fp8_f32(c, d, r, true); return (unsigned)r; }
__device__ __forceinline__ unsigned pk4_fp8(float a, float b, float c, float d) { return pk4_fp8_raw(__builtin_amdgcn_fmed3f(a, -448.f, 448.f), __builtin_amdgcn_fmed3f(b, -448.f, 448.f), __builtin_amdgcn_fmed3f(c, -448.f, 448.f), __builtin_amdgcn_fmed3f(d, -448.f, 448.f)); }
__device__ __forceinline__ float clamp448(float v) { return __builtin_fminf(__builtin_fmaxf(v, -448.0f), 448.0f); }
__device__ __forceinline__ unsigned cvt_pk_bf16(float lo, float hi) { unsigned r; asm volatile("v_cvt_pk_bf16_f32 %0, %1, %2" : "=v"(r) : "v"(lo), "v"(hi)); return r; }

struct EpiBf16 {
    static constexpr bool PERM = true;
    bf16_t* O; int ldc;
    __device__ __forceinline__ void operator()(const f32x4 (&acc)[2][2][4][2], const Unit& u, int wr, int wc, int fr, int fq) const {
        const int row0 = u.pm * BM + wr * 64 + fr, col0 = u.pn * BM + wc * 32 + 8 * fq;
#pragma unroll
        for (int ai = 0; ai < 2; ++ai)
#pragma unroll
            for (int m = 0; m < 4; ++m) { bf16_t* rowp = O + (size_t)(row0 + ai * HALF + m * 16) * ldc + col0;
#pragma unroll
                for (int bj = 0; bj < 2; ++bj) { const f32x4 v0 = acc[ai][bj][m][0], v1 = acc[ai][bj][m][1];
                    u32x4 w; w.x = cvt_pk_bf16(v0[0], v0[1]); w.y = cvt_pk_bf16(v0[2], v0[3]); w.z = cvt_pk_bf16(v1[0], v1[1]); w.w = cvt_pk_bf16(v1[2], v1[3]);
                    *(u32x4*)(rowp + bj * HALF) = w; } }
    }
};
__device__ __forceinline__ float silu_f(float a) { return a * __builtin_amdgcn_rcpf(1.0f + __builtin_amdgcn_exp2f(a * -1.4426950408889634f)); }
struct EpiSwiGLU {
    static constexpr bool PERM = true;
    bf16_t* O; int ldc; float inv;
    __device__ __forceinline__ void operator()(const f32x4 (&acc)[2][2][4][2], const Unit& u, int wr, int wc, int fr, int fq) const {
        const int row0 = u.pm * BM + wr * 64 + fr, col0 = u.pn * HALF + wc * 32 + 8 * fq;
#pragma unroll
        for (int ai = 0; ai < 2; ++ai)
#pragma unroll
            for (int m = 0; m < 4; ++m) { bf16_t* rowp = O + (size_t)(row0 + ai * HALF + m * 16) * ldc + col0;
                float h[8]; typedef float f2 __attribute__((ext_vector_type(2)));
                const float kexp = inv * -1.4426950408889634f, c0 = 1.0f / (inv * inv), lc0 = __builtin_log2f(c0);
#pragma unroll
                for (int n = 0; n < 2; ++n)
#pragma unroll
                    for (int j = 0; j < 4; j += 2) { const f2 a1 = {acc[ai][0][m][n][j], acc[ai][0][m][n][j + 1]}, a3 = {acc[ai][1][m][n][j], acc[ai][1][m][n][j + 1]};
                        const f2 t = a1 * kexp + lc0; f2 d; d.x = __builtin_amdgcn_exp2f(t.x); d.y = __builtin_amdgcn_exp2f(t.y); d = d + c0;
                        f2 rr; rr.x = __builtin_amdgcn_rcpf(d.x); rr.y = __builtin_amdgcn_rcpf(d.y); const f2 hv = (a1 * a3) * rr; h[4 * n + j] = hv.x; h[4 * n + j + 1] = hv.y; }
                u32x4 w; w.x = cvt_pk_bf16(h[0], h[1]); w.y = cvt_pk_bf16(h[2], h[3]); w.z = cvt_pk_bf16(h[4], h[5]); w.w = cvt_pk_bf16(h[6], h[7]);
                *(u32x4*)rowp = w; }
    }
};
struct EpiSwiGLU8 {
    static constexpr bool PERM = true;
    unsigned char* O; int ldc; float inv, oscale; int skip;
    __device__ __forceinline__ void operator()(const f32x4 (&acc)[2][2][4][2], const Unit& u, int wr, int wc, int fr, int fq) const {
        if (skip) return;
        const int row0 = u.pm * BM + wr * 64 + fr, col0 = u.pn * HALF + wc * 32 + 8 * fq;
        const float kexp = inv * -1.4426950408889634f, c0 = 1.0f / (inv * inv * oscale), lc0 = __builtin_log2f(c0);
        typedef unsigned u32x2 __attribute__((ext_vector_type(2))); typedef float f2 __attribute__((ext_vector_type(2)));
#pragma unroll
        for (int ai = 0; ai < 2; ++ai)
#pragma unroll
            for (int m = 0; m < 4; ++m) { unsigned char* rowp = O + (size_t)(row0 + ai * HALF + m * 16) * ldc + col0;
                float h[8];
#pragma unroll
                for (int n = 0; n < 2; ++n)
#pragma unroll
                    for (int j = 0; j < 4; j += 2) { const f2 a1 = {acc[ai][0][m][n][j], acc[ai][0][m][n][j + 1]}, a3 = {acc[ai][1][m][n][j], acc[ai][1][m][n][j + 1]};
                        const f2 t = a1 * kexp + lc0; f2 d; d.x = __builtin_amdgcn_exp2f(t.x); d.y = __builtin_amdgcn_exp2f(t.y); d = d + c0;
                        f2 rr; rr.x = __builtin_amdgcn_rcpf(d.x); rr.y = __builtin_amdgcn_rcpf(d.y); const f2 hv = (a1 * a3) * rr;
                        h[4 * n + j] = __builtin_amdgcn_fmed3f(hv.x, -448.0f, 448.0f); h[4 * n + j + 1] = __builtin_amdgcn_fmed3f(hv.y, -448.0f, 448.0f); }
                *(u32x2*)rowp = (u32x2){pk4_fp8_raw(h[0], h[1], h[2], h[3]), pk4_fp8_raw(h[4], h[5], h[6], h[7])}; }
    }
};
typedef unsigned u32x2_t __attribute__((ext_vector_type(2)));
__device__ __forceinline__ f32x4 bf4_to_f32(const u32x2_t v) { f32x4 r; r.x = __uint_as_float(v.x << 16); r.y = __uint_as_float(v.x & 0xffff0000u); r.z = __uint_as_float(v.y << 16); r.w = __uint_as_float(v.y & 0xffff0000u); return r; }
__device__ __forceinline__ u32x2_t f32_to_bf4(const f32x4 v) { return (u32x2_t){cvt_pk_bf16(v.x, v.y), cvt_pk_bf16(v.z, v.w)}; }
struct EpiBf16i {
    static constexpr bool PERM = true;
    bf16_t* O; int ldc; const float* rowstep; const float* colstep;
    __device__ __forceinline__ void operator()(const f32x4 (&acc)[2][2][4][2], const Unit& u, int wr, int wc, int fr, int fq) const {
        const int row0 = u.pm * BM + wr * 64 + fr, col0 = u.pn * BM + wc * 32 + 8 * fq;
        f32x4 cs[2][2];
#pragma unroll
        for (int bj = 0; bj < 2; ++bj)
#pragma unroll
            for (int n = 0; n < 2; ++n) cs[bj][n] = *(const f32x4*)(colstep + col0 + bj * HALF + 4 * n);
#pragma unroll
        for (int ai = 0; ai < 2; ++ai)
#pragma unroll
            for (int m = 0; m < 4; ++m) { const int row = row0 + ai * HALF + m * 16; bf16_t* rowp = O + (size_t)row * ldc + col0; const float rs = rowstep[row];
#pragma unroll
                for (int bj = 0; bj < 2; ++bj) { float v[8];
#pragma unroll
                    for (int n = 0; n < 2; ++n)
#pragma unroll
                        for (int j = 0; j < 4; ++j) { const float x = acc[ai][bj][m][n][j]; v[4 * n + j] = (float)__float_as_int(x) * (rs * cs[bj][n][j]); }
                    u32x4 w; w.x = cvt_pk_bf16(v[0], v[1]); w.y = cvt_pk_bf16(v[2], v[3]); w.z = cvt_pk_bf16(v[4], v[5]); w.w = cvt_pk_bf16(v[6], v[7]);
                    *(u32x4*)(rowp + bj * HALF) = w; } }
    }
};
struct EpiSwiGLU8i {
    static constexpr bool PERM = true;
    unsigned char* O; int ldc; const float* rowstep; const float* step1; const float* step3; float oscale;
    __device__ __forceinline__ void operator()(const f32x4 (&acc)[2][2][4][2], const Unit& u, int wr, int wc, int fr, int fq) const {
        const int row0 = u.pm * BM + wr * 64 + fr, col0 = u.pn * HALF + wc * 32 + 8 * fq;
        typedef unsigned u32x2 __attribute__((ext_vector_type(2))); typedef float f2 __attribute__((ext_vector_type(2)));
        f32x4 c1[2], c3[2];
#pragma unroll
        for (int n = 0; n < 2; ++n) { c1[n] = *(const f32x4*)(step1 + col0 + 4 * n) * -1.4426950408889634f; c3[n] = *(const f32x4*)(step3 + col0 + 4 * n) * (oscale * -0.6931471805599453f); }
#pragma unroll
        for (int ai = 0; ai < 2; ++ai)
#pragma unroll
            for (int m = 0; m < 4; ++m) { const int row = row0 + ai * HALF + m * 16; unsigned char* rowp = O + (size_t)row * ldc + col0; const float rs = rowstep[row];
                float h[8];
#pragma unroll
                for (int n = 0; n < 2; ++n)
#pragma unroll
                    for (int j = 0; j < 4; j += 2) { const float x0 = acc[ai][0][m][n][j], x1 = acc[ai][0][m][n][j + 1], y0 = acc[ai][1][m][n][j], y1 = acc[ai][1][m][n][j + 1];
                        const f2 t = (f2){(float)__float_as_int(x0), (float)__float_as_int(x1)} * ((f2){c1[n][j], c1[n][j + 1]} * rs);
                        const f2 b = (f2){(float)__float_as_int(y0), (float)__float_as_int(y1)} * ((f2){c3[n][j], c3[n][j + 1]} * rs);
                        f2 d; d.x = __builtin_amdgcn_exp2f(t.x); d.y = __builtin_amdgcn_exp2f(t.y); d = d + 1.0f;
                        f2 rr; rr.x = __builtin_amdgcn_rcpf(d.x); rr.y = __builtin_amdgcn_rcpf(d.y); const f2 hv = (t * b) * rr;
                        h[4 * n + j] = __builtin_amdgcn_fmed3f(hv.x, -448.0f, 448.0f); h[4 * n + j + 1] = __builtin_amdgcn_fmed3f(hv.y, -448.0f, 448.0f); }
                *(u32x2*)rowp = (u32x2){pk4_fp8_raw(h[0], h[1], h[2], h[3]), pk4_fp8_raw(h[4], h[5], h[6], h[7])}; }
    }
};
struct EpiRes {
    static constexpr bool PERM = true;
    const float* srcL; const float* srcC; bf16_t* xres; const float* gate; float oscale;
    __device__ __forceinline__ void operator()(const f32x4 (&acc)[2][2][4][2], const Unit& u, int wr, int wc, int fr, int fq) const {
        const int pm = u.pm; const bool isc = pm >= 128; const int bidx = isc ? 8 : (pm >> 4);
        const float* s = srcL ? (isc ? srcC + (size_t)(pm - 128) * BM * D : srcL + (size_t)pm * BM * D) : nullptr;
        bf16_t* d = xres + (size_t)pm * BM * D;
        const int col0 = u.pn * BM + wc * 32 + 8 * fq; const float* gv = gate + bidx * MOD6 + col0;
        f32x4 g[2][2];
#pragma unroll
        for (int bj = 0; bj < 2; ++bj)
#pragma unroll
            for (int n = 0; n < 2; ++n) g[bj][n] = *(const f32x4*)(gv + bj * HALF + 4 * n) * oscale;
        if (s) {
#pragma unroll
            for (int am = 0; am < 4; ++am) { const int ai = am >> 1, m0 = (am & 1) * 2; f32x4 x[2][2][2];
#pragma unroll
                for (int mm = 0; mm < 2; ++mm)
#pragma unroll
                    for (int bj = 0; bj < 2; ++bj)
#pragma unroll
                        for (int n = 0; n < 2; ++n) x[mm][bj][n] = *(const f32x4*)(s + (size_t)(wr * 64 + fr + ai * HALF + (m0 + mm) * 16) * D + col0 + bj * HALF + 4 * n);
#pragma unroll
                for (int mm = 0; mm < 2; ++mm)
#pragma unroll
                    for (int bj = 0; bj < 2; ++bj) { const int m = m0 + mm; const u32x2_t p0 = f32_to_bf4(x[mm][bj][0] + g[bj][0] * acc[ai][bj][m][0]), p1 = f32_to_bf4(x[mm][bj][1] + g[bj][1] * acc[ai][bj][m][1]);
                        *(u32x4*)(d + (size_t)(wr * 64 + fr + ai * HALF + m * 16) * D + col0 + bj * HALF) = (u32x4){p0.x, p0.y, p1.x, p1.y}; }
                asm volatile("" ::: "memory"); }
        } else {
#pragma unroll
            for (int ai = 0; ai < 2; ++ai) { u32x4 x[4][2];
#pragma unroll
                for (int m = 0; m < 4; ++m)
#pragma unroll
                    for (int bj = 0; bj < 2; ++bj) x[m][bj] = *(const u32x4*)(d + (size_t)(wr * 64 + fr + ai * HALF + m * 16) * D + col0 + bj * HALF);
#pragma unroll
                for (int m = 0; m < 4; ++m)
#pragma unroll
                    for (int bj = 0; bj < 2; ++bj) { const u32x4 xv = x[m][bj];
                        const u32x2_t p0 = f32_to_bf4(bf4_to_f32((u32x2_t){xv.x, xv.y}) + g[bj][0] * acc[ai][bj][m][0]), p1 = f32_to_bf4(bf4_to_f32((u32x2_t){xv.z, xv.w}) + g[bj][1] * acc[ai][bj][m][1]);
                        *(u32x4*)(d + (size_t)(wr * 64 + fr + ai * HALF + m * 16) * D + col0 + bj * HALF) = (u32x4){p0.x, p0.y, p1.x, p1.y}; }
                asm volatile("" ::: "memory"); }
        }
    }
};
struct EpiScatter {
    static constexpr bool PERM = false;
    const int* ridx; const float* rgate; bf16_t* xres; const float* gate; float oscale;
    __device__ __forceinline__ void operator()(const f32x4 (&acc)[2][2][4][2], const Unit& u, int wr, int wc, int fr, int fq) const {
        const int col0 = u.pn * BM + wc * 32 + 4 * fq;
#pragma unroll
        for (int ai = 0; ai < 2; ++ai)
#pragma unroll
            for (int m = 0; m < 4; ++m) { const int rs = u.pm * BM + wr * 64 + fr + ai * HALF + m * 16; const int tok = ridx[rs];
                if (tok >= 0) { const float gt = rgate[rs] * oscale; const float* gv = gate + (tok >> 12) * MOD6 + col0; bf16_t* d = xres + (size_t)tok * D + col0;
#pragma unroll
                    for (int bj = 0; bj < 2; ++bj)
#pragma unroll
                        for (int n = 0; n < 2; ++n) { const f32x4 g = *(const f32x4*)(gv + bj * HALF + n * 16); const f32x4 x = bf4_to_f32(*(const u32x2_t*)(d + bj * HALF + n * 16));
                            *(u32x2_t*)(d + bj * HALF + n * 16) = f32_to_bf4(x + (g * gt) * acc[ai][bj][m][n]); } }
                asm volatile("" ::: "memory"); }
    }
};

struct MoeOrderRM {
    int nwg, G, c; const char* A; const char* Bt; size_t tstepA, tstepB, estride; const int* texp; int nt0, gap;
    __device__ __forceinline__ bool next(int i, Unit& u) const {
        const int wgid = (G & 7) ? i * G + c : i * G + (c & 7) * (G >> 3) + (c >> 3); if (wgid >= nwg) return false;
        int pm = wgid >> 2; const int pn = wgid & 3; pm = pm < nt0 ? pm : pm + gap;
        const int e = __builtin_amdgcn_readfirstlane(__hip_atomic_load(texp + pm, __ATOMIC_RELAXED, __HIP_MEMORY_SCOPE_AGENT));
        u.pm = __builtin_amdgcn_readfirstlane(pm); u.pn = __builtin_amdgcn_readfirstlane(pn); u.a = uptr(A + (size_t)u.pm * tstepA); u.b = uptr(Bt + (size_t)e * estride + (size_t)u.pn * tstepB); u.ridx = nullptr; return true; }
};
typedef unsigned u32x4_t __attribute__((ext_vector_type(4)));
struct EpiY {
    static constexpr bool PERM = true;
    const float* rgate; bf16_t* y0; bf16_t* y1a; bf16_t* y1b; float oscale; int t1, psplit;
    __device__ __forceinline__ void operator()(const f32x4 (&acc)[2][2][4][2], const Unit& u, int wr, int wc, int fr, int fq) const {
        const int col0 = u.pn * BM + wc * 32 + 8 * fq; const bool s1 = u.pm >= t1; const int p = s1 ? u.pm - t1 : u.pm;
        bf16_t* base = (s1 ? (p < psplit ? y1a + (size_t)p * BM * D : y1b + (size_t)(p - psplit) * BM * D) : y0 + (size_t)p * BM * D) + col0;
        float gt[2][4];
#pragma unroll
        for (int ai = 0; ai < 2; ++ai)
#pragma unroll
            for (int m = 0; m < 4; ++m) gt[ai][m] = rgate[u.pm * BM + wr * 64 + fr + ai * HALF + m * 16] * oscale;
#pragma unroll
        for (int ai = 0; ai < 2; ++ai)
#pragma unroll
            for (int m = 0; m < 4; ++m) { bf16_t* d = base + (size_t)(wr * 64 + fr + ai * HALF + m * 16) * D;
#pragma unroll
                for (int bj = 0; bj < 2; ++bj) { const u32x2_t p0 = f32_to_bf4(acc[ai][bj][m][0] * gt[ai][m]), p1 = f32_to_bf4(acc[ai][bj][m][1] * gt[ai][m]);
                    *(u32x4_t*)(d + bj * HALF) = (u32x4_t){p0.x, p0.y, p1.x, p1.y}; } }
    }
};

template <class Epi, class Sched, bool ALIGN_EPI, bool GATHER, int MODE = 0  >
__device__ __forceinline__ void gemm_phase(PG8_LAS unsigned char* lds, const int K, const Sched& S, const Epi& E) {
    constexpr bool FP8 = (MODE == 1);
    const int wid = __builtin_amdgcn_readfirstlane((int)threadIdx.x >> 6), lane = (int)__builtin_amdgcn_mbcnt_hi(~0u, __builtin_amdgcn_mbcnt_lo(~0u, 0u)), tid = wid * 64 + lane, wr = wid >> 2, wc = wid & 3, fr = lane & 15, fq = lane >> 4;
    const int nt = K / BK;
    unsigned voffA[2], voffB[2];
#pragma unroll
    for (int i = 0; i < 2; ++i) { int R, C; stage_rc(tid * 16 + i * 8192, R, C); const int Rb = Epi::PERM ? ((R & ~31) + perm32(R & 31)) : R;
        voffA[i] = (unsigned)(R * K + C) * 2u; voffB[i] = (unsigned)(Rb * K + C) * 2u; }
    const size_t kstep = (size_t)(BK * 2);
    const size_t hstep = (size_t)HALF * K * 2;
    const unsigned ldsw = (unsigned)wid * 1024u;
    const unsigned ldsb = __builtin_amdgcn_readfirstlane((unsigned)(size_t)lds + ldsw);
    const int aoff = lds_byte(wr * 64 + fr, fq * 8), boff = lds_byte(wc * 32 + fr, fq * 8);
    unsigned vAc[2][2], vAn[2][2];
#define PG8_SA(b, h) (((b) * 2 + (h)) * HTB)
#define PG8_SB(b, h) ((4 + (b) * 2 + (h)) * HTB)
#define PG8_STAGE(bufoff, gbase, voff) do { const char* _g = uptr((const char*)(gbase)); _Pragma("unroll") for (int _i = 0; _i < 2; ++_i) \
        glds_s(_g, (voff)[_i], ldsb + (unsigned)((bufoff) + _i * 8192)); } while (0)
#define PG8_STAGE_A(bufoff, NXT, kb, h) do { if constexpr (GATHER) { const char* _ga = uptr(gA + (kb)); _Pragma("unroll") for (int _i = 0; _i < 2; ++_i) { const unsigned _v = (NXT) ? vAn[h][_i] : vAc[h][_i]; \
        glds_s(_ga, _v, ldsb + (unsigned)((bufoff) + _i * 8192)); } } \
        else { const char* _b = ((NXT) ? nA : cA) + (kb) + (h) * hstep; PG8_STAGE(bufoff, _b, voffA); } } while (0)
#define PG8_LDA(dst, b, h) do { if constexpr (FP8) { _Pragma("unroll") for (int m = 0; m < 4; ++m) dst##8[m] = cat8(*(const PG8_LAS bf16x8*)(lds + PG8_SA(b, h) + aoff + m * 2048), *(const PG8_LAS bf16x8*)(lds + PG8_SA(b, h) + aoff + m * 2048 + 1024)); } \
        else { _Pragma("unroll") for (int m = 0; m < 4; ++m) _Pragma("unroll") for (int k = 0; k < 2; ++k) dst[m][k] = *(const PG8_LAS bf16x8*)(lds + PG8_SA(b, h) + aoff + m * 2048 + k * 1024); } } while (0)
#define PG8_LDB(dst, b, h) do { if constexpr (FP8) { _Pragma("unroll") for (int n = 0; n < 2; ++n) dst##8[n] = cat8(*(const PG8_LAS bf16x8*)(lds + PG8_SB(b, h) + boff + n * 2048), *(const PG8_LAS bf16x8*)(lds + PG8_SB(b, h) + boff + n * 2048 + 1024)); } \
        else { _Pragma("unroll") for (int n = 0; n < 2; ++n) _Pragma("unroll") for (int k = 0; k < 2; ++k) dst[n][k] = *(const PG8_LAS bf16x8*)(lds + PG8_SB(b, h) + boff + n * 2048 + k * 1024); } } while (0)
#define PG8_MMA(ai, bj, At, Bt) do { __builtin_amdgcn_s_setprio(1); if constexpr (FP8) { _Pragma("unroll") for (int m = 0; m < 4; ++m) _Pragma("unroll") for (int n = 0; n < 2; ++n) \
        mfma8(acc[ai][bj][m][n], Bt##8[n], At##8[m], sc127); } \
        else if constexpr (MODE == 2) { _Pragma("unroll") for (int m = 0; m < 4; ++m) _Pragma("unroll") for (int n = 0; n < 2; ++n) _Pragma("unroll") for (int k = 0; k < 2; ++k) \
        acc[ai][bj][m][n] = __builtin_bit_cast(f32x4, __builtin_amdgcn_mfma_i32_16x16x64_i8(__builtin_bit_cast(v4i_t, Bt[n][k]), __builtin_bit_cast(v4i_t, At[m][k]), __builtin_bit_cast(v4i_t, acc[ai][bj][m][n]), 0, 0, 0)); } \
        else { _Pragma("unroll") for (int m = 0; m < 4; ++m) _Pragma("unroll") for (int n = 0; n < 2; ++n) _Pragma("unroll") for (int k = 0; k < 2; ++k) \
        acc[ai][bj][m][n] = __builtin_amdgcn_mfma_f32_16x16x32_bf16(Bt[n][k], At[m][k], acc[ai][bj][m][n], 0, 0, 0); } __builtin_amdgcn_s_setprio(0); } while (0)
#define PG8_WAIT_V(n) asm volatile("s_waitcnt vmcnt(" #n ")" ::: "memory")
#define PG8_WAIT_L(n) asm volatile("s_waitcnt lgkmcnt(" #n ")" ::: "memory")
#define PG8_BAR __builtin_amdgcn_s_barrier()
#define PG8_SCHED __builtin_amdgcn_sched_barrier(0)
#define PG8_GOFF(dst, un) do { _Pragma("unroll") for (int _i = 0; _i < 2; ++_i) { int _R, _C; stage_rc(tid * 16 + _i * 8192, _R, _C); _Pragma("unroll") for (int _h = 0; _h < 2; ++_h) { int _r = (un).ridx[_h * HALF + _R]; _r = _r < 0 ? 0 : _r; \
        dst[_h][_i] = (unsigned)(_r * K + _C) * 2u; } } } while (0)
    Unit cur, nxt; int ui = 0;
    if (!S.next(0, cur)) return;
    f32x4 acc[2][2][4][2];
#pragma unroll
    for (int a = 0; a < 2; ++a)
#pragma unroll
        for (int b = 0; b < 2; ++b)
#pragma unroll
            for (int m = 0; m < 4; ++m)
#pragma unroll
                for (int n = 0; n < 2; ++n) acc[a][b][m][n] = (f32x4){0.f, 0.f, 0.f, 0.f};
    int sc127 = 127; if constexpr (FP8) asm volatile("" : "+v"(sc127));
    bf16x8 At[4][2], B0[2][2], B1[2][2]; v8i_t At8[4], B08[2], B18[2];
    const char* gA = cur.a;
    const char* cA = cur.a; const char* cB = cur.b;
    if constexpr (GATHER) { PG8_GOFF(vAc, cur); }
    {   const char* nA = cA;
        PG8_STAGE(PG8_SB(0, 0), cB, voffB); PG8_STAGE(PG8_SB(0, 1), cB + hstep, voffB); PG8_STAGE_A(PG8_SA(0, 0), false, 0, 0); PG8_STAGE_A(PG8_SA(0, 1), false, 0, 1);
        if (wr == 1) PG8_BAR;
        PG8_WAIT_V(2); PG8_BAR;
        PG8_STAGE(PG8_SB(1, 0), cB + kstep, voffB); PG8_STAGE_A(PG8_SA(1, 0), false, kstep, 0); PG8_STAGE(PG8_SB(1, 1), cB + hstep + kstep, voffB);
        PG8_WAIT_V(6); PG8_BAR; }
    for (;;) {
        const bool has_next = S.next(ui + 1, nxt);
        const char* nA = has_next ? nxt.a : cA; const char* nB = has_next ? nxt.b : cB;
        if constexpr (GATHER) { if (has_next) { PG8_GOFF(vAn, nxt); } else {
#pragma unroll
            for (int h = 0; h < 2; ++h)
#pragma unroll
                for (int i = 0; i < 2; ++i) vAn[h][i] = vAc[h][i]; } }
#pragma unroll 1
        for (int t = 0; t < nt; t += 2) {
            const bool last = (t == nt - 2);
            const size_t kb1 = (size_t)(t + 1) * kstep;
            const size_t kb2 = last ? 0 : (size_t)(t + 2) * kstep, kb3 = kb2 + kstep;
            const char* b2 = last ? nB : cB + (size_t)(t + 2) * kstep; const char* b3 = b2 + kstep;
            PG8_LDB(B0, 0, 0); PG8_LDB(B1, 0, 1); PG8_SCHED; PG8_LDA(At, 0, 0); PG8_STAGE_A(PG8_SA(1, 1), false, kb1, 1);
            PG8_WAIT_V(8); PG8_WAIT_L(0); PG8_BAR; PG8_MMA(0, 0, At, B0); PG8_MMA(0, 1, At, B1); PG8_BAR; PG8_SCHED;
            PG8_LDA(At, 0, 1); PG8_STAGE(PG8_SB(0, 0), b2, voffB); PG8_STAGE(PG8_SB(0, 1), b2 + hstep, voffB); PG8_STAGE_A(PG8_SA(0, 0), last, kb2, 0);
            PG8_WAIT_V(8); PG8_WAIT_L(0); PG8_BAR; PG8_MMA(1, 0, At, B0); PG8_MMA(1, 1, At, B1); PG8_BAR; PG8_SCHED;
            PG8_LDB(B0, 1, 0); PG8_LDB(B1, 1, 1); PG8_SCHED; PG8_LDA(At, 1, 0); PG8_STAGE_A(PG8_SA(0, 1), last, kb2, 1);
            PG8_WAIT_V(8); PG8_WAIT_L(0); PG8_BAR; PG8_MMA(0, 0, At, B0); PG8_MMA(0, 1, At, B1); PG8_BAR; PG8_SCHED;
            PG8_LDA(At, 1, 1); PG8_STAGE(PG8_SB(1, 0), b3, voffB); PG8_STAGE(PG8_SB(1, 1), b3 + hstep, voffB); PG8_STAGE_A(PG8_SA(1, 0), last, kb3, 0);
            PG8_WAIT_V(8); PG8_WAIT_L(0); PG8_BAR; PG8_MMA(1, 0, At, B0); PG8_MMA(1, 1, At, B1); PG8_BAR; PG8_SCHED;
        }
        if constexpr (ALIGN_EPI) { if (wr == 0) PG8_BAR; }
        if constexpr (FP8) asm volatile("s_nop 15\n\ts_nop 15" ::: "memory");
        { int efr = fr, efq = fq; asm volatile("" : "+v"(efr), "+v"(efq));
          E(acc, cur, wr, wc, efr, efq); }
        if (!has_next) break;
#pragma unroll
        for (int a = 0; a < 2; ++a)
#pragma unroll
            for (int b = 0; b < 2; ++b)
#pragma unroll
                for (int m = 0; m < 4; ++m)
#pragma unroll
                    for (int n = 0; n < 2; ++n) acc[a][b][m][n] = (f32x4){0.f, 0.f, 0.f, 0.f};
        cur = nxt; cA = nA; cB = nB; ++ui;
        if constexpr (GATHER) {
#pragma unroll
            for (int h = 0; h < 2; ++h)
#pragma unroll
                for (int i = 0; i < 2; ++i) vAc[h][i] = vAn[h][i]; }
        if constexpr (ALIGN_EPI) { if (wr == 1) PG8_BAR; }
    }
    PG8_WAIT_V(0);
    if constexpr (!ALIGN_EPI) { if (wr == 0) PG8_BAR; }
    PG8_BAR;
#undef PG8_SA
#undef PG8_SB
#undef PG8_STAGE
#undef PG8_STAGE_A
#undef PG8_LDA
#undef PG8_LDB
#undef PG8_MMA
#undef PG8_WAIT_V
#undef PG8_WAIT_L
#undef PG8_BAR
#undef PG8_SCHED
#undef PG8_GOFF
}
}

constexpr int NWAVES = 8, NTHR = NWAVES * 64;
constexpr size_t MiB = 1u << 20;
constexpr int RT_TILES_C = 136;
constexpr size_t WS_CTL = 0, CTL_ZERO_BYTES = 1 * MiB;
constexpr size_t WS_MODP = 1 * MiB;
constexpr size_t WS_MODV = 5 * MiB;
constexpr size_t WS_ROUTE = 6 * MiB;
constexpr size_t WS_WIN = 8 * MiB;
constexpr size_t WS_WOUT = 17 * MiB;
constexpr size_t WS_W13 = 21 * MiB;
constexpr size_t WS_W2 = 32 * MiB;
constexpr size_t WS_MW13 = 38 * MiB;
constexpr size_t WS_MW2 = 94 * MiB;
constexpr size_t WS_CTXRES = 122 * MiB;
constexpr size_t WS_HBUF = 130 * MiB;
constexpr size_t WS_PBUF = 198 * MiB;
constexpr size_t WS_MIX = 351 * MiB;
constexpr size_t WS_XRES = 419 * MiB;
constexpr size_t WS_SLOC = 487 * MiB;
constexpr size_t WS_DTOT = 521 * MiB;
constexpr size_t WS_HID = 198 * MiB;
constexpr size_t WS_HID2 = 164 * MiB;
constexpr size_t WS_ZBUF = WS_HBUF;
constexpr size_t WS_XBC = WS_HBUF + 64 * MiB;
constexpr size_t WS_END = 522 * MiB;
static_assert(WS_HID + (size_t)MT * EFF <= WS_XRES && WS_HID + (size_t)MT * DFF * 2 <= WS_XRES && WS_MIX + (size_t)MT * D * 2 <= WS_XRES && WS_PBUF + (size_t)MT * INP * 2 <= WS_MIX && WS_HBUF + (size_t)MT * D * 2 <= WS_PBUF, "ws map");
static_assert(WS_HID2 + (size_t)2 * RT_TILES_C * 256 * EFF <= WS_XRES && WS_HBUF + (size_t)NL * D <= WS_HID2, "MoE hidden");
static_assert(WS_XRES + (size_t)MT * D * 2 <= WS_SLOC && (size_t)MT * 512 * 4 <= (size_t)NL * D * 4 && WS_SLOC + (size_t)64 * 17 * 8192 * 4 <= WS_DTOT && WS_DTOT + (size_t)64 * 17 * 64 * 4 <= WS_END, "GLA scratch");
static_assert(WS_MW2 + (size_t)NE * D * EFF <= WS_CTXRES && WS_MW13 + (size_t)NE * 2 * EFF * D <= WS_MW2 && WS_W13 + (size_t)2 * DFF * D * 2 <= WS_W2 && WS_W2 + (size_t)D * DFF * 2 <= WS_MW13 && WS_CTXRES + (size_t)NC * D * 4 <= WS_HBUF, "ws map 2");
constexpr int RT_TILES = 136;
constexpr size_t RT_TOKE = 0;
constexpr size_t RT_TOKG = 262144;
constexpr size_t RT_RIDX = 524288;
constexpr size_t RT_RGATE = RT_RIDX + 2 * RT_TILES * 256 * 4;
constexpr size_t RT_TEXP = RT_RGATE + 2 * RT_TILES * 256 * 4;
constexpr size_t RT_NT = RT_TEXP + 2 * RT_TILES * 4;
constexpr size_t WS_WCS = WS_ROUTE + 1536 * 1024;
constexpr int WCS_IN = 0, WCS_W1 = 2 * 2304, WCS_W3 = 2 * 2304 + 2816;
constexpr size_t RT_POS = 1664 * 1024;
constexpr size_t WS_RS = WS_ROUTE + 1280 * 1024;
static_assert(RT_NT + 1024 <= 2 * MiB, "route tables");
constexpr int CW_BAR = 4096, CW_Q = 8192, CW_CONVQ = 12288, CW_WABS = 12800, CW_DONE0 = 16384, CW_FINQ = 16448, CW_DONE1 = 16512;
constexpr size_t WS_Y0 = 8 * MiB;
constexpr int Y1_SPLIT = 68;
static_assert((size_t)Y1_SPLIT * 256 * 1024 * 2 <= 34 * MiB && WS_Y0 + (size_t)136 * 256 * 1024 * 2 <= 94 * MiB, "MoE down product buffers");
#define MDN_MERGE 1
constexpr int RING_BYTES = 131072, LDS_BYTES = 163840, LDSCTL_OFF = LDS_BYTES - 1024, MISC_OFF = LDSCTL_OFF + 320;

#define GAS __attribute__((address_space(1)))
#define LAS __attribute__((address_space(3)))
typedef unsigned short bf16;
typedef unsigned v4u __attribute__((ext_vector_type(4)));
typedef unsigned v2u __attribute__((ext_vector_type(2)));
typedef float f32x4 __attribute__((ext_vector_type(4)));
typedef float f32x2 __attribute__((ext_vector_type(2)));
#define LDS_WAIT() asm volatile("s_waitcnt lgkmcnt(0)" ::: "memory")
__device__ __forceinline__ unsigned f2bf(float f) { unsigned u = __builtin_bit_cast(unsigned, f); return (u + 0x7fffu + ((u >> 16) & 1u)) >> 16; }
__device__ __forceinline__ unsigned pk2(float lo, float hi) { return f2bf(lo) | (f2bf(hi) << 16); }
__device__ __forceinline__ float bf2f(unsigned b) { return __builtin_bit_cast(float, b << 16); }
__device__ __forceinline__ float bflo(unsigned w) { return __builtin_bit_cast(float, w << 16); }
__device__ __forceinline__ float bfhi(unsigned w) { return __builtin_bit_cast(float, w & 0xffff0000u); }
typedef short bf16x8 __attribute__((ext_vector_type(8)));
typedef float f32x16 __attribute__((ext_vector_type(16)));
typedef __bf16 bf16x2_t __attribute__((ext_vector_type(2)));
__device__ __forceinline__ unsigned cvtpk(float lo, float hi) { const f32x2 v = {lo, hi}; return __builtin_bit_cast(unsigned, __builtin_convertvector(v, bf16x2_t)); }
__device__ __forceinline__ bf16 bf1(float x) { return (bf16)(cvtpk(x, x) & 0xffffu); }
__device__ __forceinline__ float silu_fast(float a) { return a * __builtin_amdgcn_rcpf(1.0f + __builtin_amdgcn_exp2f(a * -1.4426950408889634f)); }
__device__ __forceinline__ float cosrev(float f) { return __builtin_amdgcn_cosf(f); }
__device__ __forceinline__ float sinrev(float f) { return __builtin_amdgcn_sinf(f); }
__device__ __forceinline__ int crow32(int reg, int h) { return (reg & 3) + 8 * (reg >> 2) + 4 * h; }
#define MFMA32(a, b, c) __builtin_amdgcn_mfma_f32_32x32x16_bf16((a), (b), (c), 0, 0, 0)

#define XB_TMO      128
#define XB_XCNT(j)  (256  + 64 * (j))
#define XB_XSUB(j)  (1280 + 64 * (j))
#define XB_XGEN(j)  (2304 + 64 * (j))
#define XB_TOP      3328
#define XB_TOPGEN   3392
#define XCD_BAR_WORDS 3456
#define XB_SPIN_CAP (1u << 20)
__device__ __forceinline__ unsigned xb_ld(unsigned* p)              { return __hip_atomic_load(p, __ATOMIC_RELAXED, __HIP_MEMORY_SCOPE_AGENT); }
__device__ __forceinline__ unsigned xb_add(unsigned* p, unsigned v) { return __hip_atomic_fetch_add(p, v, __ATOMIC_RELAXED, __HIP_MEMORY_SCOPE_AGENT); }
__device__ __forceinline__ unsigned xb_xcc_id() { return (unsigned)__builtin_amdgcn_s_getreg((3 << 11) | 20) & 0xFu; }
#define XB_SPIN(cond, bar) do { unsigned _sp = 0; while (cond) { __builtin_amdgcn_s_sleep(1); \
    if ((++_sp & 255u) == 0u) { if (xb_ld(&(bar)[XB_TMO])) break; if (_sp > XB_SPIN_CAP) { atomicAdd(&(bar)[XB_TMO], 1u); break; } } } } while (0)
struct XcdBarrier { unsigned* bar; unsigned x; volatile LAS unsigned* st; };
__device__ __forceinline__ XcdBarrier xcd_barrier_post(unsigned* bar, volatile LAS unsigned* st) {
    XcdBarrier b; b.bar = bar; b.x = xb_xcc_id(); b.st = st;
    if (threadIdx.x == 0) (void)xb_add(&bar[XB_XCNT(b.x)], 1u);
    return b;
}
__device__ __forceinline__ void xcd_barrier_complete(unsigned* bar, unsigned x, unsigned& nloc, unsigned& nx) {
    const unsigned G = gridDim.x * gridDim.y * gridDim.z;
    unsigned sum, cnt, mine, sp = 0u;
    for (;;) {
        sum = 0u; cnt = 0u; mine = 0u;
#pragma unroll
        for (unsigned j = 0; j < 16; ++j) { const unsigned c = xb_ld(&bar[XB_XCNT(j)]); sum += c; cnt += (c > 0u) ? 1u : 0u; mine = (j == x) ? c : mine; }
        if (sum == G) break;
        __builtin_amdgcn_s_sleep(1);
        if ((++sp & 255u) == 0u) { if (xb_ld(&bar[XB_TMO])) break; if (sp > XB_SPIN_CAP) { atomicAdd(&bar[XB_TMO], 1u); break; } }
    }
    nloc = mine > 0u ? mine : 1u; nx = cnt > 0u ? cnt : 1u;
}
__device__ __forceinline__ void xcd_barrier(const XcdBarrier& b) {
    asm volatile("s_waitcnt vmcnt(0)" ::: "memory");
    __syncthreads();
    if (threadIdx.x == 0) {
        unsigned* bar = b.bar;
        __builtin_amdgcn_s_waitcnt(0);
        unsigned nloc = b.st[0], nx = b.st[1];
        if (nloc == 0u) { xcd_barrier_complete(bar, b.x, nloc, nx); b.st[0] = nloc; b.st[1] = nx; }
        const unsigned old = xb_add(&bar[XB_XSUB(b.x)], 1u);
        const unsigned gen = old / nloc;
        if (old + 1u == (gen + 1u) * nloc) {
            __builtin_amdgcn_fence(__ATOMIC_RELEASE, "agent");
            asm volatile("s_waitcnt vmcnt(0)" ::: "memory");
            const unsigned og = xb_add(&bar[XB_TOP], 1u);
            const unsigned tg = og / nx;
            if (og + 1u == (tg + 1u) * nx) xb_add(&bar[XB_TOPGEN], 1u);
            else XB_SPIN(xb_ld(&bar[XB_TOPGEN]) == tg, bar);
            __builtin_amdgcn_fence(__ATOMIC_ACQUIRE, "agent");
            xb_add(&bar[XB_XGEN(b.x)], 1u);
            asm volatile("s_waitcnt vmcnt(0)" ::: "memory");
        } else {
            XB_SPIN(xb_ld(&bar[XB_XGEN(b.x)]) == gen, bar);
            __builtin_amdgcn_fence(__ATOMIC_ACQUIRE, "agent");
            asm volatile("s_waitcnt vmcnt(0)" ::: "memory");
        }
    }
    __syncthreads();
}

struct Args { const float* in[23]; float* out; unsigned char* ws; int ph_lo, ph_hi, li, pad; };

__device__ __forceinline__ float wave_sum(float v) {
#pragma unroll
    for (int o = 1; o < 64; o <<= 1) v += __shfl_xor(v, o);
    return v;
}

__device__ __forceinline__ void transpose_item(const float* W, int K, int N, bf16* WT, int row_off, int mode, LAS float* scr, int item, int lane) {
    const int nblk = N / 32, kb = item / nblk, nb = item % nblk, k0 = 64 * kb, n0 = 32 * nb;
    { float tv[32];
#pragma unroll
      for (int i = 0; i < 32; ++i) tv[i] = W[(size_t)(k0 + 2 * i + (lane >> 5)) * N + n0 + (lane & 31)];
#pragma unroll
      for (int i = 0; i < 32; ++i) scr[(2 * i + (lane >> 5)) * 33 + (lane & 31)] = tv[i]; }
    LDS_WAIT(); asm volatile("" ::: "memory");
    const int r0 = mode == 0 ? row_off + n0 : row_off + (n0 >> 7) * 256 + (n0 & 127) + (mode == 2 ? 128 : 0);
    const int c = lane & 7;
#pragma unroll
    for (int j = 0; j < 4; ++j) { const int n = (lane >> 3) + 8 * j; const LAS float* s = scr + (8 * c) * 33 + n;
        v4u o; o.x = cvtpk(s[0 * 33], s[1 * 33]); o.y = cvtpk(s[2 * 33], s[3 * 33]); o.z = cvtpk(s[4 * 33], s[5 * 33]); o.w = cvtpk(s[6 * 33], s[7 * 33]);
        *(GAS v4u*)(WT + (size_t)(r0 + n) * K + k0 + 8 * c) = o; }
    LDS_WAIT(); asm volatile("" ::: "memory");
}

__device__ __forceinline__ void transpose_item8(const float* W, int K, int N, unsigned char* WT, int row_off, int mode, float sc, LAS float* scr, int item, int lane) {
    const int nblk = N / 32, kb = item / nblk, nb = item % nblk, k0 = 64 * kb, n0 = 32 * nb;
    { float tv[32];
#pragma unroll
      for (int i = 0; i < 32; ++i) tv[i] = W[(size_t)(k0 + 2 * i + (lane >> 5)) * N + n0 + (lane & 31)];
#pragma unroll
      for (int i = 0; i < 32; ++i) scr[(2 * i + (lane >> 5)) * 33 + (lane & 31)] = tv[i]; }
    LDS_WAIT(); asm volatile("" ::: "memory");
    const int r0 = mode == 0 ? row_off + n0 : row_off + (n0 >> 7) * 256 + (n0 & 127) + (mode == 2 ? 128 : 0);
    const int c = lane & 7;
#pragma unroll
    for (int j = 0; j < 4; ++j) { const int n = (lane >> 3) + 8 * j; const LAS float* s = scr + (8 * c) * 33 + n;
        v2u o; o.x = pg8::pk4_fp8(s[0 * 33] * sc, s[1 * 33] * sc, s[2 * 33] * sc, s[3 * 33] * sc); o.y = pg8::pk4_fp8(s[4 * 33] * sc, s[5 * 33] * sc, s[6 * 33] * sc, s[7 * 33] * sc);
        *(GAS v2u*)(WT + (size_t)(r0 + n) * K + k0 + 8 * c) = o; }
    LDS_WAIT(); asm volatile("" ::: "memory");
}

__device__ __forceinline__ unsigned pk4_i8(float a, float b, float c, float d) {
    const int ia = (int)__builtin_rintf(__builtin_amdgcn_fmed3f(a, -127.f, 127.f)), ib = (int)__builtin_rintf(__builtin_amdgcn_fmed3f(b, -127.f, 127.f)), ic = (int)__builtin_rintf(__builtin_amdgcn_fmed3f(c, -127.f, 127.f)), id = (int)__builtin_rintf(__builtin_amdgcn_fmed3f(d, -127.f, 127.f));
    return (unsigned)(ia & 0xff) | ((unsigned)(ib & 0xff) << 8) | ((unsigned)(ic & 0xff) << 16) | ((unsigned)id << 24); }
__device__ __forceinline__ void transpose_item_i8(const float* W, int K, int N, unsigned char* WT, int row_off, int mode, const float* steps, LAS float* scr, int item, int lane) {
    const int nblk = N / 32, kb = item / nblk, nb = item % nblk, k0 = 64 * kb, n0 = 32 * nb;
    { float tv[32];
#pragma unroll
      for (int i = 0; i < 32; ++i) tv[i] = W[(size_t)(k0 + 2 * i + (lane >> 5)) * N + n0 + (lane & 31)];
#pragma unroll
      for (int i = 0; i < 32; ++i) scr[(2 * i + (lane >> 5)) * 33 + (lane & 31)] = tv[i]; }
    LDS_WAIT(); asm volatile("" ::: "memory");
    const int r0 = mode == 0 ? row_off + n0 : row_off + (n0 >> 7) * 256 + (n0 & 127) + (mode == 2 ? 128 : 0);
    const int c = lane & 7;
#pragma unroll
    for (int j = 0; j < 4; ++j) { const int n = (lane >> 3) + 8 * j; const LAS float* s = scr + (8 * c) * 33 + n; const float st = steps[n0 + n], sc = st > 0.f ? 1.0f / st : 0.f;
        v2u o; o.x = pk4_i8(s[0 * 33] * sc, s[1 * 33] * sc, s[2 * 33] * sc, s[3 * 33] * sc); o.y = pk4_i8(s[4 * 33] * sc, s[5 * 33] * sc, s[6 * 33] * sc, s[7 * 33] * sc);
        *(GAS v2u*)(WT + (size_t)(r0 + n) * K + k0 + 8 * c) = o; }
    LDS_WAIT(); asm volatile("" ::: "memory");
}
__device__ __forceinline__ void colmax_item(const float* W, int K, int N, float* steps, int blk, LAS float* red, int wave, int lane) {
    const int n = blk * 64 + lane; float m = 0.f;
    if (n < N) { const float* p = W + (size_t)(wave * (K / 8)) * N + n;
#pragma unroll 1
        for (int k0 = 0; k0 < K / 8; k0 += 32) { float tv[32];
#pragma unroll
            for (int k = 0; k < 32; ++k) tv[k] = p[(size_t)(k0 + k) * N];
#pragma unroll
            for (int k = 0; k < 32; ++k) m = fmaxf(m, fabsf(tv[k])); } }
    red[wave * 64 + lane] = m;
    __syncthreads();
    if (wave == 0) { float mm = m;
#pragma unroll
        for (int q = 1; q < 8; ++q) mm = fmaxf(mm, red[q * 64 + lane]);
        if (n < N) steps[n] = mm * (1.0f / 127.0f); }
    __syncthreads();
}
__device__ __forceinline__ void absmax_pass(const float* W, size_t n4, unsigned* dst, int gtid, int gthreads, int lane) {
    float m = 0.f;
    for (size_t i = gtid; i < n4; i += gthreads) { const f32x4 v = ((const f32x4*)W)[i]; m = fmaxf(fmaxf(fmaxf(fabsf(v.x), fabsf(v.y)), fmaxf(fabsf(v.z), fabsf(v.w))), m); }
#pragma unroll
    for (int o = 1; o < 64; o <<= 1) m = fmaxf(m, __shfl_xor(m, o));
    if (lane == 0) atomicMax(dst, __float_as_uint(m));
}

struct Wg { LAS unsigned char* lds; int tid, lane, wave, G, bx, gw, NGW; };
#define WS_PTR(T, off) ((T*)(a.ws + (off)))
__device__ __forceinline__ void conv_in_tail(const Args& a, const Wg& w, const int nunits, const int quota);

__device__ __forceinline__ void ph_prologue(const Args& a, const Wg& w) {
    const int tid = w.tid, lane = w.lane, wave = w.wave;
    const float* c_in = a.in[1]; const float* cctx_in = a.in[3]; const float* w_mod = a.in[4];
    const float* w_in = a.in[8]; const float* w_out = a.in[14]; const float* ffn_w1 = a.in[15]; const float* ffn_w3 = a.in[16]; const float* ffn_w2 = a.in[17];
    float* MODP = WS_PTR(float, WS_MODP); bf16* WIN = WS_PTR(bf16, WS_WIN); bf16* WOUT = WS_PTR(bf16, WS_WOUT); bf16* W13 = WS_PTR(bf16, WS_W13); bf16* W2 = WS_PTR(bf16, WS_W2);
    LAS float* scr = (LAS float*)(w.lds + wave * 8448);
    LAS float* sil = (LAS float*)(w.lds + 69632);
    for (int i = tid; i < 9 * D; i += NTHR) { const float v = i < 8 * D ? c_in[i] : cctx_in[i - 8 * D]; sil[i] = v / (1.0f + __expf(-v)); }
    __syncthreads();
    constexpr int I_IN = 16 * 65, I_OUT = 16 * 32, I_F13 = 16 * 88, I_F2 = 44 * 32, I_MOD = 2 * 8 * 96;
    constexpr int NITEMS = I_MOD + 2 * I_IN + 2 * I_OUT + 2 * I_F13 + I_F2;
    for (int it = w.gw; it < NITEMS; it += w.NGW) {
        int r = it;
        if (r < I_MOD) {
            const int l = r / 768, kc = (r % 768) / 96, nb = r % 96, n = nb * 64 + lane;
            float acc[9];
#pragma unroll
            for (int b = 0; b < 9; ++b) acc[b] = 0.f;
            const float* wp = w_mod + ((size_t)l * D + kc * 128) * MOD6 + n;
#pragma unroll 1
            for (int k0 = 0; k0 < 128; k0 += 32) { float wv[32];
#pragma unroll
                for (int k = 0; k < 32; ++k) wv[k] = wp[(size_t)(k0 + k) * MOD6];
#pragma unroll
                for (int k = 0; k < 32; ++k)
#pragma unroll
                    for (int b = 0; b < 9; ++b) acc[b] += sil[b * D + kc * 128 + k0 + k] * wv[k]; }
#pragma unroll
            for (int b = 0; b < 9; ++b) MODP[(((size_t)l * 8 + kc) * 9 + b) * MOD6 + n] = acc[b];
            continue; }
        r -= I_MOD;
        if (r < 2 * I_IN) { const int l = r / I_IN; if (!I8_GIN) transpose_item(w_in + (size_t)l * D * INW, D, INW, WIN + (size_t)l * INP * D, 0, 0, scr, r % I_IN, lane); continue; } r -= 2 * I_IN;
        if (r < 2 * I_OUT) { const int l = r / I_OUT; transpose_item(w_out + (size_t)l * D * D, D, D, WOUT + (size_t)l * D * D, 0, 0, scr, r % I_OUT, lane); continue; } r -= 2 * I_OUT;
        if (r < I_F13) { if (I8_FUP) {} else if (FP8_FUP) transpose_item8(ffn_w1, D, DFF, (unsigned char*)W13, 0, 1, FP8_SW, scr, r, lane); else transpose_item(ffn_w1, D, DFF, W13, 0, 1, scr, r, lane); continue; } r -= I_F13;
        if (r < I_F13) { if (I8_FUP) {} else if (FP8_FUP) transpose_item8(ffn_w3, D, DFF, (unsigned char*)W13, 0, 2, FP8_SW, scr, r, lane); else transpose_item(ffn_w3, D, DFF, W13, 0, 2, scr, r, lane); continue; } r -= I_F13;
        if (FP8_FDN) transpose_item8(ffn_w2, DFF, D, (unsigned char*)W2, 0, 0, FP8_SW, scr, r, lane); else transpose_item(ffn_w2, DFF, D, W2, 0, 0, scr, r, lane);
    }
    {
        float* WCS = WS_PTR(float, WS_WCS); LAS float* red = (LAS float*)(w.lds + 110 * 1024);
        constexpr int B_IN = (INW + 63) / 64, B_F = DFF / 64, NB = (I8_GIN ? 2 * B_IN : 0) + (I8_FUP ? 2 * B_F : 0);
        __syncthreads();
        for (int it = w.bx; it < NB; it += w.G) { int r = it;
            if (I8_GIN) { if (r < 2 * B_IN) { const int l = r / B_IN; colmax_item(w_in + (size_t)l * D * INW, D, INW, WCS + WCS_IN + l * 2304, r % B_IN, red, wave, lane); continue; } r -= 2 * B_IN; }
            if (r < B_F) colmax_item(ffn_w1, D, DFF, WCS + WCS_W1, r, red, wave, lane); else colmax_item(ffn_w3, D, DFF, WCS + WCS_W3, r - B_F, red, wave, lane); }
        if (I8_GIN) for (int i = w.bx * NTHR + tid; i < 2 * (INP - INW); i += w.G * NTHR) WCS[WCS_IN + (i / (INP - INW)) * 2304 + INW + i % (INP - INW)] = 0.f;
    }
    for (int i = w.bx * NTHR + tid; i < 2 * (INP - INW) * D / 8; i += w.G * NTHR) { const int l = i / ((INP - INW) * D / 8), o = i % ((INP - INW) * D / 8);
        if (I8_GIN) { if (o < (INP - INW) * D / 16) *(GAS v4u*)((unsigned char*)WIN + (size_t)l * INP * D + (size_t)INW * D + (size_t)o * 16) = (v4u){0u, 0u, 0u, 0u}; }
        else *(GAS v4u*)(WIN + (size_t)l * INP * D + (size_t)INW * D + (size_t)o * 8) = (v4u){0u, 0u, 0u, 0u}; }
    __syncthreads();
}
__device__ __forceinline__ void ph_modfin(const Args& a, const Wg& w) {
    const float* b_mod = a.in[5]; const float* MODP = WS_PTR(float, WS_MODP); float* MODV = WS_PTR(float, WS_MODV);
    for (int i = w.bx * NTHR + w.tid; i < 2 * 9 * MOD6; i += w.G * NTHR) { const int l = i / (9 * MOD6), r = i % (9 * MOD6), n = r % MOD6;
        float s = b_mod[l * MOD6 + n];
#pragma unroll
        for (int kc = 0; kc < 8; ++kc) s += MODP[((size_t)l * 8 + kc) * 9 * MOD6 + r];
        MODV[i] = s; }
}
__device__ __forceinline__ void ph_quant(const Args& a, const Wg& w) {
    __syncthreads();
    if (I8_GIN) {
        LAS float* scr = (LAS float*)(w.lds + w.wave * 8448); constexpr int I_IN = 16 * 65;
        for (int it = w.gw; it < 2 * I_IN; it += w.NGW) { const int l = it / I_IN;
            transpose_item_i8(a.in[8] + (size_t)l * D * INW, D, INW, WS_PTR(unsigned char, WS_WIN) + (size_t)l * INP * D, 0, 0, WS_PTR(float, WS_WCS) + WCS_IN + l * 2304, scr, it % I_IN, w.lane); }
        __syncthreads(); }
    if (I8_FUP) {
        LAS float* scr = (LAS float*)(w.lds + w.wave * 8448); constexpr int I_F13 = 16 * 88;
        for (int it = w.gw; it < 2 * I_F13; it += w.NGW) { if (it < I_F13) transpose_item_i8(a.in[15], D, DFF, WS_PTR(unsigned char, WS_W13), 0, 1, WS_PTR(float, WS_WCS) + WCS_W1, scr, it, w.lane); else transpose_item_i8(a.in[16], D, DFF, WS_PTR(unsigned char, WS_W13), 0, 2, WS_PTR(float, WS_WCS) + WCS_W3, scr, it - I_F13, w.lane); }
        __syncthreads(); }
}
__device__ __forceinline__ void ph_norm(const Args& a, const Wg& w, const int l, const int which) {
    const int lane = w.lane;
    const float* modl = WS_PTR(float, WS_MODV) + (size_t)l * 9 * MOD6;
    const bool fin = (l == 0 && which == 0);
    const float* resL = a.in[0]; const float* resC = a.in[2]; const bf16* XRES = WS_PTR(bf16, WS_XRES);
    const float* nw = (which == 0 ? a.in[6] : a.in[7]) + l * D;
    bf16* HBUF = WS_PTR(bf16, WS_HBUF);
    const bool route = (l == 1 && which == 1);
    LAS float* rw = (LAS float*)w.lds;
    if (route) { const float* router_w = a.in[18]; for (int i = w.tid; i < D * NE / 4; i += NTHR) ((LAS f32x4*)rw)[i] = ((const f32x4*)router_w)[i]; }
    __syncthreads();
    int* TOKE = WS_PTR(int, WS_ROUTE + RT_TOKE); float* TOKG = WS_PTR(float, WS_ROUTE + RT_TOKG);
    const int Mrows = (l == 1 && which == 1) ? NL : MT;
    for (int m = w.gw; m < Mrows; m += w.NGW) {
        const bool isc = m >= NL; const int bidx = isc ? 8 : (m >> 12);
        const float* xr = isc ? resC + (size_t)(m - NL) * D : resL + (size_t)m * D;
        const float* sh = modl + bidx * MOD6 + which * 3 * D, *sc = sh + D;
        f32x4 v[4]; float ss = 0.f;
#pragma unroll
        for (int j = 0; j < 4; ++j) { v[j] = fin ? *(const f32x4*)(xr + 4 * lane + 256 * j) : pg8::bf4_to_f32(*(const pg8::u32x2_t*)(XRES + (size_t)m * D + 4 * lane + 256 * j)); ss += (v[j].x * v[j].x + v[j].y * v[j].y) + (v[j].z * v[j].z + v[j].w * v[j].w); }
        const float rstd = 1.0f / sqrtf(wave_sum(ss) * (1.0f / D) + EPS);
        float lg[8];
#pragma unroll
        for (int e = 0; e < 8; ++e) lg[e] = 0.f;
        f32x4 hq[4]; float amax = 0.f;
#pragma unroll
        for (int j = 0; j < 4; ++j) { const int c = 4 * lane + 256 * j; const f32x4 wv = *(const f32x4*)(nw + c), s1 = *(const f32x4*)(sc + c), s0 = *(const f32x4*)(sh + c);
            const f32x4 h = (v[j] * rstd) * wv * (s1 + 1.0f) + s0; hq[j] = h;
            amax = fmaxf(amax, fmaxf(fmaxf(fabsf(h.x), fabsf(h.y)), fmaxf(fabsf(h.z), fabsf(h.w))));
            if (route) {
#pragma unroll
                for (int q = 0; q < 4; ++q) { const f32x4 r0 = *(const LAS f32x4*)(rw + (c + q) * 8), r1 = *(const LAS f32x4*)(rw + (c + q) * 8 + 4); const float hv = h[q];
                    lg[0] += hv * r0.x; lg[1] += hv * r0.y; lg[2] += hv * r0.z; lg[3] += hv * r0.w; lg[4] += hv * r1.x; lg[5] += hv * r1.y; lg[6] += hv * r1.z; lg[7] += hv * r1.w; } } }
        if ((which == 1 && l == 0 && I8_FUP) || (which == 0 && I8_GIN)) {
#pragma unroll
            for (int o = 1; o < 64; o <<= 1) amax = fmaxf(amax, __shfl_xor(amax, o));
            const float qs = amax > 1e-30f ? 127.0f / amax : 0.f;
            if (lane == 0) WS_PTR(float, WS_RS)[m] = amax * (1.0f / 127.0f);
#pragma unroll
            for (int j = 0; j < 4; ++j) *(unsigned*)((unsigned char*)HBUF + (size_t)m * D + 4 * lane + 256 * j) = pk4_i8(hq[j].x * qs, hq[j].y * qs, hq[j].z * qs, hq[j].w * qs);
        } else {
#pragma unroll
            for (int j = 0; j < 4; ++j) { const int c = 4 * lane + 256 * j; const f32x4 h = hq[j];
                if (which == 0 || (l == 0 && !FP8_FUP)) *(v2u*)(HBUF + (size_t)m * D + c) = (v2u){cvtpk(h.x, h.y), cvtpk(h.z, h.w)};
                else *(unsigned*)((unsigned char*)HBUF + (size_t)m * D + c) = pg8::pk4_fp8(h.x * FP8_SH, h.y * FP8_SH, h.z * FP8_SH, h.w * FP8_SH); } }
        if (route) {
#pragma unroll
            for (int e = 0; e < 8; ++e) lg[e] = wave_sum(lg[e]);
            int e0 = 0; float v0 = lg[0];
#pragma unroll
            for (int e = 1; e < 8; ++e) if (lg[e] > v0) { v0 = lg[e]; e0 = e; }
            int e1 = -1; float v1 = -3.0e38f;
#pragma unroll
            for (int e = 0; e < 8; ++e) if (e != e0 && lg[e] > v1) { v1 = lg[e]; e1 = e; }
            const float g0 = 1.0f / (1.0f + __expf(v1 - v0)), g1 = 1.0f - g0;
            if (lane == 0) { TOKE[m] = e0; TOKE[NL + m] = e1; TOKG[m] = g0; TOKG[NL + m] = g1; }
        }
    }
    __syncthreads();
}
__device__ __forceinline__ void ph_gin(const Args& a, const Wg& w, const int l) {
    if constexpr (I8_GIN) { pg8::DenseOrder S; S.init(WS_PTR(bf16, WS_HBUF), (const bf16*)(WS_PTR(unsigned char, WS_WIN) + (size_t)l * INP * D), MT, INP, D / 2, w.G, w.bx);
        pg8::EpiBf16i E{WS_PTR(bf16, WS_PBUF), INP, WS_PTR(float, WS_RS), WS_PTR(float, WS_WCS) + WCS_IN + l * 2304};
        pg8::gemm_phase<pg8::EpiBf16i, pg8::DenseOrder, true, false, 2>(w.lds, D / 2, S, E); }
    else { pg8::DenseOrder S; S.init(WS_PTR(bf16, WS_HBUF), WS_PTR(bf16, WS_WIN) + (size_t)l * INP * D, MT, INP, D, w.G, w.bx); pg8::EpiBf16 E{WS_PTR(bf16, WS_PBUF), INP};
        pg8::gemm_phase<pg8::EpiBf16, pg8::DenseOrder, true, false>(w.lds, D, S, E); }
    conv_in_tail(a, w, (MT / 256) * (INP / 256), CONV_Q_GIN);
}
__device__ __forceinline__ int wq_next(unsigned* ctr, volatile LAS int* slot, int tid) {
    __syncthreads();
    if (tid == 0) *slot = (int)__hip_atomic_fetch_add(ctr, 1u, __ATOMIC_RELAXED, __HIP_MEMORY_SCOPE_AGENT);
    __syncthreads();
    return __builtin_amdgcn_readfirstlane(*slot);
}
__device__ __forceinline__ int wq_claim(unsigned* ctr, int tid) { return tid == 0 ? (int)__hip_atomic_fetch_add(ctr, 1u, __ATOMIC_RELAXED, __HIP_MEMORY_SCOPE_AGENT) : 0; }
__device__ __forceinline__ int wq_take(volatile LAS int* slot, int& par, int claimed, int tid) {
    if (tid == 0) slot[par] = claimed;
    __syncthreads();
    const int v = __builtin_amdgcn_readfirstlane(slot[par]); par ^= 1; return v;
}
#define MFMA16(a, b, c) __builtin_amdgcn_mfma_f32_16x16x32_bf16((a), (b), (c), 0, 0, 0)
constexpr int GL_QE = 0, GL_KE = 18432, GL_KDT = 36864, GL_P = 55296, GL_VT = 73728, GL_OS = 110592, GL_DEC = 144384, GL_SLOT = 160000;
static_assert(GL_DEC + 512 <= GL_SLOT && GL_SLOT + 64 <= LDSCTL_OFF, "GLA LDS map");
#define BB16 1
#if BB16
typedef _Float16 bb_t;
#else
typedef float bb_t;
#endif
constexpr size_t GSCR_OFF = (size_t)72 * MiB;
constexpr int NG1 = 64 * 17;
__device__ __forceinline__ int gla_run_row0(int b, int run) { return run == 0 ? NL + b * CTXL : b * SEQ + (run - 1) * 256; }
__device__ __forceinline__ float log_sigmoid_f(float z) { return fminf(z, 0.f) - log1pf(__expf(-fabsf(z))); }
__device__ __forceinline__ void gla_vt_image(const bf16* PBUF, LAS unsigned char* lds, int row0, int h, int tid) {
    const int dv = tid & 127, t4 = tid >> 7; unsigned pk[8];
    const bf16* p = PBUF + (size_t)(row0 + 16 * t4) * INP + PC_V + h * 128 + dv;
#pragma unroll
    for (int e = 0; e < 8; ++e) pk[e] = (unsigned)p[(size_t)(2 * e) * INP] | ((unsigned)p[(size_t)(2 * e + 1) * INP] << 16);
    *(LAS v4u*)(lds + GL_VT + dv * 144 + 32 * t4) = (v4u){pk[0], pk[1], pk[2], pk[3]};
    *(LAS v4u*)(lds + GL_VT + dv * 144 + 32 * t4 + 16) = (v4u){pk[4], pk[5], pk[6], pk[7]};
}
__device__ __forceinline__ bf16x8 tr_frag16(unsigned img, int pitch, int row0, int col0, int lane) {
    const int g = lane >> 4, qq = (lane & 15) >> 2, pp = lane & 3; const unsigned a0 = img + (unsigned)((row0 + 8 * g + qq) * pitch + (col0 + 4 * pp) * 2);
    v2u lo, hi;
    asm volatile("ds_read_b64_tr_b16 %0, %2\n\tds_read_b64_tr_b16 %1, %3\n\ts_waitcnt lgkmcnt(0)" : "=&v"(lo), "=&v"(hi) : "v"(a0), "v"(a0 + 4u * (unsigned)pitch) : "memory");
    return __builtin_bit_cast(bf16x8, (v4u){lo.x, lo.y, hi.x, hi.y});
}
__device__ __forceinline__ void gla_state_update(f32x4 (&S)[4], LAS unsigned char* lds, int wave, int r, int q, int o_kdt, int o_vt, int o_dec) {
    const LAS float* dec = (const LAS float*)(lds + o_dec);
#pragma unroll
    for (int kt = 0; kt < 4; ++kt) { const f32x4 d = *(const LAS f32x4*)(dec + 16 * kt + 4 * q); S[kt] = S[kt] * d; }
#pragma unroll
    for (int ks = 0; ks < 2; ++ks) { const bf16x8 B = *(const LAS bf16x8*)(lds + o_vt + (16 * wave + r) * 144 + (32 * ks + 8 * q) * 2);
#pragma unroll
        for (int kt = 0; kt < 4; ++kt) { const bf16x8 A = *(const LAS bf16x8*)(lds + o_kdt + (16 * kt + r) * 144 + (32 * ks + 8 * q) * 2); S[kt] = MFMA16(A, B, S[kt]); } }
}
struct G1Raw { v4u lfa[2]; v4u kr, v0, v1; };
__device__ __forceinline__ void g1_load(G1Raw& r, const bf16* PBUF, int row0, int h, int dir, int tid) {
    const int tok = tid >> 3, k0 = (tid & 7) * 8;
    { const int wv = tid >> 6, ln = tid & 63;
#pragma unroll
      for (int t = 0; t < 2; ++t) r.lfa[t] = *(const v4u*)(PBUF + (size_t)(row0 + 16 * (2 * (wv >> 2) + t) + (ln & 15)) * INP + PC_LF + dir * 16 + 8 * ((ln >> 4) & 1)); }
    r.kr = *(const v4u*)(PBUF + (size_t)(row0 + tok) * INP + PC_K + h * 64 + k0);
    const bf16* pv = PBUF + (size_t)(row0 + tok) * INP + PC_V + h * 128 + 2 * k0;
    r.v0 = *(const v4u*)pv; r.v1 = *(const v4u*)(pv + 8);
}
__device__ __forceinline__ float log_sigmoid_fast(float z) { return fminf(z, 0.f) - 0.6931471805599453f * __builtin_amdgcn_logf(1.0f + __builtin_amdgcn_exp2f(fabsf(z) * -1.4426950408889634f)); }
constexpr int G1_VT = 0, G1_KDT = 36864, G1_LF = 55296, G1_T = 63488, G1_DEC = 67584, G1_Z = 69632, G1_KR = 87040, G1_BI = 96256;
__device__ __forceinline__ void gla_g1_job(const Args& a, const Wg& w, const int l, const int job, const int var = 0) {
    const int tid = w.tid, lane = w.lane, wave = w.wave, r = lane & 15, q = lane >> 4, k = tid & 63, tg = tid >> 6;
    const int seq = job / 17, step = job - seq * 17, b = seq >> 3, h = (seq >> 1) & 3, dir = seq & 1;
    const int run = step == 0 ? 0 : (dir ? 17 - step : step), rrow0 = gla_run_row0(b, run);
    const bf16* PBUF = WS_PTR(bf16, WS_PBUF); bb_t* BBUF = (bb_t*)a.out; float* SLOC = WS_PTR(float, WS_SLOC); float* DTOT = WS_PTR(float, WS_DTOT);
    LAS unsigned char* lds = w.lds;
    bf16x8 WB;
    { const int kgrp = lane >> 4, r0 = 8 * (kgrp & 1); const float* wgp = (dir ? a.in[11] : a.in[9]) + (size_t)l * 16 * 256 + h * 64 + 16 * (wave & 3) + (lane & 15);
      unsigned pkw[4];
#pragma unroll
      for (int jj = 0; jj < 8; jj += 2) { unsigned hv[2];
#pragma unroll
          for (int u = 0; u < 2; ++u) { const float wv = wgp[(r0 + jj + u) * 256]; const unsigned hb = cvtpk(wv, wv) & 0xffffu; const float lo = wv - __uint_as_float(hb << 16); hv[u] = (kgrp >> 1) ? (cvtpk(lo, lo) & 0xffffu) : hb; }
          pkw[jj >> 1] = hv[0] | (hv[1] << 16); }
      WB = __builtin_bit_cast(bf16x8, (v4u){pkw[0], pkw[1], pkw[2], pkw[3]}); }
    const float bias = (dir ? a.in[12] : a.in[10])[l * 256 + h * 64 + k];
    f32x4 S[4];
#pragma unroll
    for (int kt = 0; kt < 4; ++kt) S[kt] = (f32x4){0.f, 0.f, 0.f, 0.f};
    float logtot = 0.f;
    G1Raw cur; g1_load(cur, PBUF, rrow0 + (dir ? 3 : 0) * 64, h, dir, tid);
    for (int pc = 0; pc < ((var & 8) ? 0 : 4); ++pc) {
        const int par = pc & 1, row0 = rrow0 + (dir ? 3 - pc : pc) * 64;
        LAS unsigned char* VT = lds + G1_VT + par * 18432; LAS unsigned char* KDT = lds + G1_KDT + par * 9216; LAS float* Z = (LAS float*)(lds + G1_Z);
        LAS float* T = (LAS float*)(lds + G1_T + par * 2048); LAS float* DEC = (LAS float*)(lds + G1_DEC + par * 256);
        { f32x4 z0 = (f32x4){0.f, 0.f, 0.f, 0.f}, z1 = z0;
          z0 = MFMA16(__builtin_bit_cast(bf16x8, cur.lfa[0]), WB, z0); z1 = MFMA16(__builtin_bit_cast(bf16x8, cur.lfa[1]), WB, z1);
          LAS float* zp = Z + (32 * (wave >> 2) + 4 * q) * 68 + 16 * (wave & 3) + r;
#pragma unroll
          for (int i = 0; i < 4; ++i) { zp[i * 68] = z0[i]; zp[(16 + i) * 68] = z1[i]; } }
        { const int tok = tid >> 3, k0 = (tid & 7) * 8;
          *(LAS v4u*)(VT + tok * 288 + 4 * k0) = cur.v0; *(LAS v4u*)(VT + tok * 288 + 4 * k0 + 16) = cur.v1;
          *(LAS v4u*)(lds + G1_KR + tok * 144 + 2 * k0) = cur.kr; }
        __syncthreads();
        if (pc < 3) g1_load(cur, PBUF, rrow0 + (dir ? 2 - pc : pc + 1) * 64, h, dir, tid);
        float gv[8];
#pragma unroll
        for (int e = 0; e < 8; ++e) { gv[e] = log_sigmoid_fast(Z[(8 * tg + e) * 68 + k] + bias) * (1.0f / 16.0f); if (var & 1) break; }
        if (var & 1) {
#pragma unroll
            for (int e = 1; e < 8; ++e) gv[e] = gv[0]; }
        float runs = 0.f;
        if (!dir) {
#pragma unroll
            for (int e = 0; e < 8; ++e) { runs += gv[e]; gv[e] = runs; } }
        else {
#pragma unroll
            for (int e = 7; e >= 0; --e) { runs += gv[e]; gv[e] = runs; } }
        T[tg * 64 + k] = runs;
        __syncthreads();
        float off = 0.f, tot = 0.f;
#pragma unroll
        for (int t2 = 0; t2 < 8; ++t2) { const float v = T[t2 * 64 + k]; tot += v; const bool before = dir ? (t2 > tg) : (t2 < tg); off += before ? v : 0.f; }
        unsigned pk[4];
#pragma unroll
        for (int e2 = 0; e2 < 4; ++e2) { const float B0 = gv[2 * e2] + off, B1 = gv[2 * e2 + 1] + off; const int tk = 8 * tg + 2 * e2;
            *(LAS bb_t*)(lds + G1_BI + tk * 144 + 2 * k) = (bb_t)B0; *(LAS bb_t*)(lds + G1_BI + (tk + 1) * 144 + 2 * k) = (bb_t)B1;
            const float kv0 = bf2f(*(const LAS bf16*)(lds + G1_KR + tk * 144 + 2 * k)), kv1 = bf2f(*(const LAS bf16*)(lds + G1_KR + (tk + 1) * 144 + 2 * k));
            pk[e2] = cvtpk(kv0 * __expf(tot - B0), kv1 * __expf(tot - B1)); }
        *(LAS v4u*)(KDT + k * 144 + 16 * tg) = (v4u){pk[0], pk[1], pk[2], pk[3]};
        if (tg == 0) DEC[k] = __expf(tot);
        logtot += tot;
        __syncthreads();
        if (!(var & 4)) { const int tok = tid >> 3, k0 = (tid & 7) * 8; *(v4u*)(BBUF + (size_t)(row0 + tok) * 512 + dir * 256 + h * 64 + k0) = *(const LAS v4u*)(lds + G1_BI + tok * 144 + 2 * k0); }
        if (!(var & 2)) {
#pragma unroll
            for (int kt = 0; kt < 4; ++kt) { const f32x4 d = *(const LAS f32x4*)(DEC + 16 * kt + 4 * q); S[kt] = S[kt] * d; }
#pragma unroll
            for (int ks = 0; ks < 2; ++ks) { const bf16x8 Bf = tr_frag16((unsigned)(size_t)VT, 288, 32 * ks, 16 * wave, lane);
#pragma unroll
                for (int kt = 0; kt < 4; ++kt) { const bf16x8 Af = *(const LAS bf16x8*)(KDT + (16 * kt + r) * 144 + (32 * ks + 8 * q) * 2); S[kt] = MFMA16(Af, Bf, S[kt]); } }
        }
    }
    const size_t idx = (size_t)seq * 17 + step;
#pragma unroll
    for (int kt = 0; kt < 4; ++kt)
#pragma unroll
        for (int i = 0; i < 4; ++i) SLOC[idx * 8192 + (size_t)(16 * kt + 4 * q + i) * 128 + 16 * wave + r] = S[kt][i];
    if (tg == 0) DTOT[idx * 64 + k] = __expf(logtot);
}
__device__ __forceinline__ void ph_gla_scan(const Args& a, const Wg& w) {
    float* SLOC = WS_PTR(float, WS_SLOC); const float* DTOT = WS_PTR(float, WS_DTOT);
    for (int ge = w.bx * NTHR + w.tid; ge < 64 * 8192; ge += w.G * NTHR) { const int seq = ge >> 13, e = ge & 8191;
        float* p = SLOC + (size_t)seq * 17 * 8192 + e; const float* d = DTOT + (size_t)seq * 17 * 64 + (e >> 7);
        float tv[17], dv[17];
#pragma unroll
        for (int st = 0; st < 17; ++st) { tv[st] = p[(size_t)st * 8192]; dv[st] = d[st * 64]; }
        float s = 0.f;
#pragma unroll
        for (int st = 0; st < 17; ++st) { p[(size_t)st * 8192] = s; s = dv[st] * s + tv[st]; } }
}
struct G3Raw { v4u q, k, B, Bl, v0, v1; };
static_assert(BB16, "g3_load reads the log-decay buffer as f16 rows");
__device__ __forceinline__ void g3_load(G3Raw& r, const bf16* PBUF, const bb_t* BBUF, int row0, int h, int dir, int tid) {
    const int tok = tid >> 3, k0 = (tid & 7) * 8;
    r.q = *(const v4u*)(PBUF + (size_t)(row0 + tok) * INP + PC_Q + h * 64 + k0);
    r.k = *(const v4u*)(PBUF + (size_t)(row0 + tok) * INP + PC_K + h * 64 + k0);
    r.B = *(const v4u*)(BBUF + (size_t)(row0 + tok) * 512 + dir * 256 + h * 64 + k0);
    r.Bl = *(const v4u*)(BBUF + (size_t)(row0 + (dir ? 0 : 63)) * 512 + dir * 256 + h * 64 + k0);
    const bf16* pv = PBUF + (size_t)(row0 + tok) * INP + PC_V + h * 128 + 2 * k0;
    r.v0 = *(const v4u*)pv; r.v1 = *(const v4u*)(pv + 8);
}
__device__ __forceinline__ void gla_g3_job(const Args& a, const Wg& w, const int l, const int job, const int var = 0) {
    const int tid = w.tid, lane = w.lane, wave = w.wave, r = lane & 15, q = lane >> 4, k = tid & 63, tg = tid >> 6;
    const int b = job / 68, h = (job / 17) & 3, run = job % 17, rrow0 = gla_run_row0(b, run);
    const bf16* PBUF = WS_PTR(bf16, WS_PBUF); const bb_t* BBUF = (const bb_t*)a.out; const float* SLOC = WS_PTR(float, WS_SLOC); bf16* MIX = WS_PTR(bf16, WS_MIX);
    v4u* OFS = (v4u*)((unsigned char*)a.out + GSCR_OFF) + ((size_t)job * 4 * NTHR + tid) * 2;
    const float* gnw = a.in[13] + l * 128 + (tid & 7) * 16;
    f32x4 gw4[4];
#pragma unroll
    for (int j = 0; j < 4; ++j) gw4[j] = *(const f32x4*)(gnw + 4 * j);
    LAS unsigned char* lds = w.lds; LAS float* OS = (LAS float*)(lds + GL_OS);
    f32x4 S[4];
    { const size_t idx = (size_t)((b * 4 + h) * 2 + 0) * 17 + run;
#pragma unroll
      for (int kt = 0; kt < 4; ++kt)
#pragma unroll
          for (int i = 0; i < 4; ++i) S[kt][i] = SLOC[idx * 8192 + (size_t)(16 * kt + 4 * q + i) * 128 + 16 * wave + r]; }
    G3Raw cur; g3_load(cur, PBUF, BBUF, rrow0, h, 0, tid);
    for (int s = 0; s < ((var & 8) ? 0 : 8); ++s) {
        const int dir = s >> 2, pc = s & 3, cidx = dir ? 3 - pc : pc, row0 = rrow0 + cidx * 64, par = s & 1;
        const int oQE = GL_QE + par * 9216, oKE = GL_KE + par * 9216, oKDT = GL_KDT + par * 9216, oP = GL_P + par * 9216, oVT = GL_VT + par * 18432, oDEC = GL_DEC + par * 256;
        if (s == 4) { const size_t idx = (size_t)((b * 4 + h) * 2 + 1) * 17 + (run == 0 ? 0 : 17 - run);
#pragma unroll
            for (int kt = 0; kt < 4; ++kt)
#pragma unroll
                for (int i = 0; i < 4; ++i) S[kt][i] = SLOC[idx * 8192 + (size_t)(16 * kt + 4 * q + i) * 128 + 16 * wave + r]; }
        {
            const int tok = tid >> 3, k0 = (tid & 7) * 8;
            const unsigned qw[4] = {cur.q.x, cur.q.y, cur.q.z, cur.q.w}, kw[4] = {cur.k.x, cur.k.y, cur.k.z, cur.k.w}, bw[4] = {cur.B.x, cur.B.y, cur.B.z, cur.B.w}, lw[4] = {cur.Bl.x, cur.Bl.y, cur.Bl.z, cur.Bl.w};
            unsigned qe[4], ke[4]; float dl[8];
#pragma unroll
            for (int j2 = 0; j2 < 4; ++j2) { typedef _Float16 h2 __attribute__((ext_vector_type(2)));
                const h2 bh = __builtin_bit_cast(h2, bw[j2]), lh = __builtin_bit_cast(h2, lw[j2]);
                const float B0 = (float)bh.x, B1 = (float)bh.y, L0 = (float)lh.x, L1 = (float)lh.y;
                const float q0 = bflo(qw[j2]), q1 = bfhi(qw[j2]), kv0 = bflo(kw[j2]), kv1 = bfhi(kw[j2]);
                qe[j2] = cvtpk(q0 * 0.125f * __expf(B0), q1 * 0.125f * __expf(B1)); ke[j2] = cvtpk(kv0 * __expf(-B0), kv1 * __expf(-B1));
                const unsigned kd2 = cvtpk(kv0 * __expf(L0 - B0), kv1 * __expf(L1 - B1));
                *(LAS bf16*)(lds + oKDT + (k0 + 2 * j2) * 144 + 2 * tok) = (bf16)(kd2 & 0xffffu); *(LAS bf16*)(lds + oKDT + (k0 + 2 * j2 + 1) * 144 + 2 * tok) = (bf16)(kd2 >> 16);
                dl[2 * j2] = L0; dl[2 * j2 + 1] = L1; }
            *(LAS v4u*)(lds + oQE + tok * 144 + 2 * k0) = (v4u){qe[0], qe[1], qe[2], qe[3]};
            *(LAS v4u*)(lds + oKE + tok * 144 + 2 * k0) = (v4u){ke[0], ke[1], ke[2], ke[3]};
            if (tok == 0) { *(LAS f32x4*)(lds + oDEC + 4 * k0) = (f32x4){__expf(dl[0]), __expf(dl[1]), __expf(dl[2]), __expf(dl[3])}; *(LAS f32x4*)(lds + oDEC + 4 * k0 + 16) = (f32x4){__expf(dl[4]), __expf(dl[5]), __expf(dl[6]), __expf(dl[7])}; }
            *(LAS v4u*)(lds + oVT + tok * 288 + 4 * k0) = cur.v0; *(LAS v4u*)(lds + oVT + tok * 288 + 4 * k0 + 16) = cur.v1;
        }
        __syncthreads();
        if (s < 7) { const int s1 = s + 1, d1 = s1 >> 2, p1 = s1 & 3; g3_load(cur, PBUF, BBUF, rrow0 + (d1 ? 3 - p1 : p1) * 64, h, d1, tid); }
        v4u of0 = (v4u){0u, 0u, 0u, 0u}, of1 = of0, gA = of0, gB = of0;
        if (dir) { const v4u* op = OFS + (size_t)cidx * NTHR * 2; of0 = op[0]; of1 = op[1];
            const bf16* pg = PBUF + (size_t)(row0 + (tid >> 3)) * INP + PC_G + h * 128 + (tid & 7) * 16; gA = *(const v4u*)pg; gB = *(const v4u*)(pg + 8); }
#pragma unroll
        for (int t = 0; t < 2; ++t) { const int id = 2 * wave + t, st = id >> 2, tt = id & 3;
            f32x4 pa = (f32x4){0.f, 0.f, 0.f, 0.f};
            if (dir ? (st >= tt) : (st <= tt)) {
#pragma unroll
                for (int ks = 0; ks < 2; ++ks) { const bf16x8 A = *(const LAS bf16x8*)(lds + oKE + (16 * st + r) * 144 + (32 * ks + 8 * q) * 2), B = *(const LAS bf16x8*)(lds + oQE + (16 * tt + r) * 144 + (32 * ks + 8 * q) * 2);
                    pa = MFMA16(A, B, pa); }
                const int tau = 16 * tt + r;
#pragma unroll
                for (int i = 0; i < 4; ++i) { const int sg = 16 * st + 4 * q + i; const bool keep = dir ? (sg >= tau) : (sg <= tau); pa[i] = keep ? pa[i] : 0.f; } }
            *(LAS v2u*)(lds + oP + (16 * tt + r) * 144 + (16 * st + 4 * q) * 2) = (v2u){cvtpk(pa[0], pa[1]), cvtpk(pa[2], pa[3])}; }
        __syncthreads();
        f32x4 o[4];
#pragma unroll
        for (int tt = 0; tt < 4; ++tt) o[tt] = (f32x4){0.f, 0.f, 0.f, 0.f};
#pragma unroll
        for (int ks = 0; ks < 2; ++ks) {
            const bf16x8 Bs = __builtin_bit_cast(bf16x8, (v4u){cvtpk(S[2 * ks][0], S[2 * ks][1]), cvtpk(S[2 * ks][2], S[2 * ks][3]), cvtpk(S[2 * ks + 1][0], S[2 * ks + 1][1]), cvtpk(S[2 * ks + 1][2], S[2 * ks + 1][3])});
#pragma unroll
            for (int tt = 0; tt < 4; ++tt) { const v2u alo = *(const LAS v2u*)(lds + oQE + (16 * tt + r) * 144 + (32 * ks + 4 * q) * 2), ahi = *(const LAS v2u*)(lds + oQE + (16 * tt + r) * 144 + (32 * ks + 16 + 4 * q) * 2);
                o[tt] = MFMA16(__builtin_bit_cast(bf16x8, (v4u){alo.x, alo.y, ahi.x, ahi.y}), Bs, o[tt]); } }
        bf16x8 Bv[2];
#pragma unroll
        for (int ks = 0; ks < 2; ++ks) Bv[ks] = tr_frag16((unsigned)(size_t)(lds + oVT), 288, 32 * ks, 16 * wave, lane);
#pragma unroll
        for (int ks = 0; ks < 2; ++ks) {
#pragma unroll
            for (int tt = 0; tt < 4; ++tt) { const bf16x8 A = *(const LAS bf16x8*)(lds + oP + (16 * tt + r) * 144 + (32 * ks + 8 * q) * 2); o[tt] = MFMA16(A, Bv[ks], o[tt]); } }
        { const LAS float* dec = (const LAS float*)(lds + oDEC);
#pragma unroll
          for (int kt = 0; kt < 4; ++kt) { const f32x4 dd = *(const LAS f32x4*)(dec + 16 * kt + 4 * q); S[kt] = S[kt] * dd; }
#pragma unroll
          for (int ks = 0; ks < 2; ++ks)
#pragma unroll
              for (int kt = 0; kt < 4; ++kt) { const bf16x8 A = *(const LAS bf16x8*)(lds + oKDT + (16 * kt + r) * 144 + (32 * ks + 8 * q) * 2); S[kt] = MFMA16(A, Bv[ks], S[kt]); } }
        if (dir == 0) {
            v4u* op = OFS + (size_t)cidx * NTHR * 2;
            op[0] = (v4u){cvtpk(o[0][0], o[0][1]), cvtpk(o[0][2], o[0][3]), cvtpk(o[1][0], o[1][1]), cvtpk(o[1][2], o[1][3])};
            op[1] = (v4u){cvtpk(o[2][0], o[2][1]), cvtpk(o[2][2], o[2][3]), cvtpk(o[3][0], o[3][1]), cvtpk(o[3][2], o[3][3])};
        } else {
            const unsigned ofw[8] = {of0.x, of0.y, of0.z, of0.w, of1.x, of1.y, of1.z, of1.w};
#pragma unroll
            for (int tt = 0; tt < 4; ++tt)
#pragma unroll
                for (int i = 0; i < 4; ++i) { const int tk = 16 * tt + 4 * q + i; const unsigned wv = ofw[2 * tt + (i >> 1)]; OS[tk * 132 + 16 * wave + r] = o[tt][i] + ((i & 1) ? bfhi(wv) : bflo(wv)); }
            __syncthreads();
            const int tk = tid >> 3, dv0 = (tid & 7) * 16; const size_t row = (size_t)(row0 + tk);
            f32x4 ov[4]; float ss = 0.f;
#pragma unroll
            for (int j = 0; j < 4; ++j) { ov[j] = *(const LAS f32x4*)(OS + tk * 132 + dv0 + 4 * j); ss += (ov[j].x * ov[j].x + ov[j].y * ov[j].y) + (ov[j].z * ov[j].z + ov[j].w * ov[j].w); }
            ss += __shfl_xor(ss, 1); ss += __shfl_xor(ss, 2); ss += __shfl_xor(ss, 4);
            const float rstd = __builtin_amdgcn_rsqf(ss * (1.0f / 128.0f) + EPS);
            const unsigned gq[8] = {gA.x, gA.y, gA.z, gA.w, gB.x, gB.y, gB.z, gB.w}; unsigned yo[8];
#pragma unroll
            for (int j = 0; j < 4; ++j) { const f32x4 wv = gw4[j];
                const float ga = bflo(gq[2 * j]), gb = bfhi(gq[2 * j]), gc = bflo(gq[2 * j + 1]), gd = bfhi(gq[2 * j + 1]);
                yo[2 * j] = cvtpk(ov[j].x * rstd * wv.x * silu_fast(ga), ov[j].y * rstd * wv.y * silu_fast(gb));
                yo[2 * j + 1] = cvtpk(ov[j].z * rstd * wv.z * silu_fast(gc), ov[j].w * rstd * wv.w * silu_fast(gd)); }
            bf16* mo = MIX + row * D + 512 + h * 128 + dv0;
            *(v4u*)mo = (v4u){yo[0], yo[1], yo[2], yo[3]}; *(v4u*)(mo + 8) = (v4u){yo[4], yo[5], yo[6], yo[7]};
        }
    }
}
__device__ __forceinline__ void four_t1_setup(const Wg& w, bf16x8 (&T1)[8]) {
    const int lane = w.lane, wave = w.wave, r = lane & 31, h = lane >> 5;
    const int k2c = 32 * wave + r, k2 = k2c & 127;
#pragma unroll
    for (int s = 0; s < 8; ++s) { unsigned pk[4];
#pragma unroll
        for (int j = 0; j < 4; ++j) { const int n0 = 16 * s + 8 * h + 2 * j; const float f0 = (float)((n0 * k2) & 127) * (1.0f / 128.0f), f1 = (float)(((n0 + 1) * k2) & 127) * (1.0f / 128.0f);
            pk[j] = k2c < 128 ? cvtpk(cosrev(f0), cosrev(f1)) : cvtpk(-sinrev(f0), -sinrev(f1)); }
        T1[s] = __builtin_bit_cast(bf16x8, (v4u){pk[0], pk[1], pk[2], pk[3]}); }
}
__device__ __forceinline__ void ctx_dft1_item(const Args& a, const Wg& w, const bf16x8 (&T1)[8], const int item) {
    const int tid = w.tid, lane = w.lane, wave = w.wave, r = lane & 31, h = lane >> 5;
    const bf16* PBUF = WS_PTR(bf16, WS_PBUF); bf16* XB = WS_PTR(bf16, WS_XBC) - (size_t)NL * 4 * 256;
    LAS unsigned char* U = w.lds;
    const int g = item & 3, m0 = NL + (item >> 2) * 64;
    __syncthreads();
#pragma unroll
    for (int i = 0; i < 2; ++i) { const int id = tid + NTHR * i, aa = id >> 4, ch = id & 15;
        const v4u v = *(const v4u*)(PBUF + (size_t)(m0 + aa) * INP + PC_U + g * 128 + ch * 8);
        *(LAS v4u*)(U + aa * 272 + ch * 16) = v; }
    __syncthreads();
    f32x16 x0, x1;
#pragma unroll
    for (int i = 0; i < 16; ++i) { x0[i] = 0.f; x1[i] = 0.f; }
#pragma unroll
    for (int s = 0; s < 8; ++s) { const bf16x8 A0 = *(const LAS bf16x8*)(U + r * 272 + (16 * s + 8 * h) * 2), A1 = *(const LAS bf16x8*)(U + (32 + r) * 272 + (16 * s + 8 * h) * 2);
        x0 = MFMA32(A0, T1[s], x0); x1 = MFMA32(A1, T1[s], x1); }
    bf16* xo = XB + ((size_t)m0 * 4 + g) * 256 + 32 * wave + r;
#pragma unroll
    for (int i = 0; i < 16; ++i) { xo[(size_t)crow32(i, h) * 1024] = bf1(x0[i]); xo[(size_t)(32 + crow32(i, h)) * 1024] = bf1(x1[i]); }
}
__device__ __forceinline__ void ctx_dft2_item(const Args& a, const Wg& w, const int it) {
    const int tid = w.tid, lane = w.lane, wave = w.wave, r = lane & 31, h = lane >> 5, dt = wave >> 2, ct = wave & 3;
    const bf16* XB = WS_PTR(bf16, WS_XBC) - (size_t)NL * 4 * 256; bf16* MIX = WS_PTR(bf16, WS_MIX);
    const int b = it >> 4, g = (it >> 2) & 3, kq = it & 3, row0 = NL + b * CTXL;
    LAS unsigned char* T = w.lds; constexpr int P = 528;
    __syncthreads();
    v4u v[16];
#pragma unroll
    for (int i = 0; i < 16; ++i) { const int id = tid + NTHR * i, row = id >> 5, ch = id & 31; v[i] = *(const v4u*)(XB + ((size_t)(row0 + row) * 4 + g) * 256 + ch * 8); }
#pragma unroll
    for (int i = 0; i < 16; ++i) { const int id = tid + NTHR * i, row = id >> 5, ch = id & 31; *(LAS v4u*)(T + row * P + ch * 16) = v[i]; }
    __syncthreads();
    f32x16 y;
#pragma unroll
    for (int i = 0; i < 16; ++i) y[i] = 0.f;
    const int k1 = kq * 64 + dt * 32 + r;
#pragma unroll 4
    for (int s = 0; s < 32; ++s) { unsigned pa[4], pb[4];
#pragma unroll
        for (int jj = 0; jj < 4; ++jj) { const int n1 = 8 * s + 4 * h + jj; const float f = (float)((k1 * n1) & 255) * (1.0f / 256.0f); pa[jj] = cvtpk(cosrev(f), sinrev(f));
            const LAS unsigned char* p = T + n1 * P + (32 * ct + r) * 2; pb[jj] = (unsigned)*(const LAS bf16*)p | ((unsigned)*(const LAS bf16*)(p + 256) << 16); }
        y = MFMA32(__builtin_bit_cast(bf16x8, (v4u){pa[0], pa[1], pa[2], pa[3]}), __builtin_bit_cast(bf16x8, (v4u){pb[0], pb[1], pb[2], pb[3]}), y); }
    const float sc = 1.0f / sqrtf((float)CTXL * 128.0f);
    bf16* mo = MIX + (size_t)(row0 + kq * 64 + 32 * dt) * D + g * 128 + 32 * ct + r;
#pragma unroll
    for (int i = 0; i < 16; ++i) mo[(size_t)crow32(i, h) * D] = bf1(y[i] * sc);
}
__device__ __forceinline__ void four_a_setup(const Wg& w, bf16x8 (&T1)[8]) {
    const int tid = w.tid;
    LAS unsigned char* M64 = w.lds;
    __syncthreads();
    for (int i = tid; i < 128 * 128; i += NTHR) { const int row = i >> 7, col = i & 127, c = row & 63, ri = row >> 6, aa = col & 63, ri2 = col >> 6;
        const float f = (float)((c * aa) & 63) * (1.0f / 64.0f), cs = cosrev(f), sn = sinrev(f); const float v = (ri == ri2) ? cs : (ri == 0 ? sn : -sn);
        *(LAS bf16*)(M64 + row * 272 + col * 2) = (bf16)f2bf(v); }
    four_t1_setup(w, T1);
    __syncthreads();
}
__device__ __forceinline__ void four_a_item(const Args& a, const Wg& w, const bf16x8 (&T1)[8], const int item) {
    const int tid = w.tid, lane = w.lane, wave = w.wave, r = lane & 31, h = lane >> 5;
    const bf16* PBUF = WS_PTR(bf16, WS_PBUF); bf16* ZB = WS_PTR(bf16, WS_ZBUF);
    LAS unsigned char* M64 = w.lds; LAS unsigned char* U = w.lds + 34816; LAS unsigned char* XT = w.lds + 52224;
    const int b = item >> 8, g = (item >> 6) & 3, bcol = item & 63;
#pragma unroll
    for (int i = 0; i < 2; ++i) { const int id = tid + NTHR * i, aa = id >> 4, ch = id & 15;
        const v4u v = *(const v4u*)(PBUF + (size_t)(b * SEQ + 64 * aa + bcol) * INP + PC_U + g * 128 + ch * 8);
        *(LAS v4u*)(U + aa * 272 + ch * 16) = v; }
    __syncthreads();
    f32x16 x0, x1;
#pragma unroll
    for (int i = 0; i < 16; ++i) { x0[i] = 0.f; x1[i] = 0.f; }
#pragma unroll
    for (int s = 0; s < 8; ++s) { const bf16x8 A0 = *(const LAS bf16x8*)(U + r * 272 + (16 * s + 8 * h) * 2), A1 = *(const LAS bf16x8*)(U + (32 + r) * 272 + (16 * s + 8 * h) * 2);
        x0 = MFMA32(A0, T1[s], x0); x1 = MFMA32(A1, T1[s], x1); }
    { const int k2 = (32 * wave + r) & 127, ri2 = wave >> 2;
#pragma unroll
      for (int qq = 0; qq < 4; ++qq) {
          *(LAS v2u*)(XT + k2 * 272 + (ri2 * 64 + 8 * qq + 4 * h) * 2) = (v2u){cvtpk(x0[4 * qq], x0[4 * qq + 1]), cvtpk(x0[4 * qq + 2], x0[4 * qq + 3])};
          *(LAS v2u*)(XT + k2 * 272 + (ri2 * 64 + 32 + 8 * qq + 4 * h) * 2) = (v2u){cvtpk(x1[4 * qq], x1[4 * qq + 1]), cvtpk(x1[4 * qq + 2], x1[4 * qq + 3])}; } }
    __syncthreads();
    const int ct = wave & 3, rt = wave >> 2;
    f32x16 zr, zi;
#pragma unroll
    for (int i = 0; i < 16; ++i) { zr[i] = 0.f; zi[i] = 0.f; }
#pragma unroll
    for (int s = 0; s < 8; ++s) { const bf16x8 B = *(const LAS bf16x8*)(XT + (32 * ct + r) * 272 + (16 * s + 8 * h) * 2);
        const bf16x8 Ar = *(const LAS bf16x8*)(M64 + (32 * rt + r) * 272 + (16 * s + 8 * h) * 2), Ai = *(const LAS bf16x8*)(M64 + (64 + 32 * rt + r) * 272 + (16 * s + 8 * h) * 2);
        zr = MFMA32(Ar, B, zr); zi = MFMA32(Ai, B, zi); }
    bf16* zo = ZB + ((size_t)((b * 4 + g) * 64) * 64 + bcol) * 256 + 32 * ct + r;
#pragma unroll
    for (int i = 0; i < 16; ++i) { const int c = 32 * rt + crow32(i, h); const float f = (float)((bcol * c) & 4095) * (1.0f / 4096.0f), cs = cosrev(f), sn = sinrev(f);
        const float vr = zr[i] * cs + zi[i] * sn, vi = zi[i] * cs - zr[i] * sn;
        bf16* p = zo + (size_t)c * 64 * 256; const unsigned z2 = cvtpk(vr, vi); p[0] = (bf16)(z2 & 0xffffu); p[128] = (bf16)(z2 >> 16); }
}
__device__ __forceinline__ void four_b_setup(const Wg& w, bf16x8 (&M2)[8]) {
    const int lane = w.lane, wave = w.wave, r = lane & 31, h = lane >> 5, d = 32 * (wave >> 2) + r;
#pragma unroll
    for (int s = 0; s < 8; ++s) { unsigned pk[4];
#pragma unroll
        for (int j = 0; j < 4; ++j) { const int bc = (16 * s + 8 * h + 2 * j) >> 1; const float f = (float)((bc * d) & 63) * (1.0f / 64.0f); pk[j] = cvtpk(cosrev(f), sinrev(f)); }
        M2[s] = __builtin_bit_cast(bf16x8, (v4u){pk[0], pk[1], pk[2], pk[3]}); }
}
constexpr int FB_N = 4;
__device__ __forceinline__ void four_b_item(const Args& a, const Wg& w, const bf16x8 (&M2)[8], const int item) {
    const int tid = w.tid, lane = w.lane, wave = w.wave, r = lane & 31, h = lane >> 5, dt = wave >> 2, ct = wave & 3;
    const bf16* ZB = WS_PTR(bf16, WS_ZBUF); bf16* MIX = WS_PTR(bf16, WS_MIX);
    const float scale = 1.0f / sqrtf(4096.0f * 128.0f);
    const int b = item >> 6, g = (item >> 4) & 3, c0 = (item & 15) * FB_N;
    const bf16* zt = ZB + (size_t)((b * 4 + g) * 64 + c0) * 64 * 256;
    v4u v[FB_N][4];
#pragma unroll
    for (int t = 0; t < FB_N; ++t)
#pragma unroll
        for (int i = 0; i < 4; ++i) v[t][i] = *(const v4u*)(zt + (size_t)t * 64 * 256 + (size_t)(tid + NTHR * i) * 8);
#pragma unroll
    for (int t = 0; t < FB_N; ++t) { LAS unsigned char* ZT = w.lds + t * 33792;
#pragma unroll
        for (int i = 0; i < 4; ++i) { const int id = tid + NTHR * i, row = id >> 4, ch = id & 15;
            *(LAS v2u*)(ZT + row * 264 + ch * 16) = (v2u){v[t][i].x, v[t][i].y}; *(LAS v2u*)(ZT + row * 264 + ch * 16 + 8) = (v2u){v[t][i].z, v[t][i].w}; } }
    __syncthreads();
#pragma unroll
    for (int t = 0; t < FB_N; ++t) { const LAS unsigned char* ZT = w.lds + t * 33792;
        f32x16 y;
#pragma unroll
        for (int i = 0; i < 16; ++i) y[i] = 0.f;
#pragma unroll
        for (int s = 0; s < 8; ++s) { unsigned pk[4];
#pragma unroll
            for (int j = 0; j < 4; ++j) { const LAS unsigned char* p = ZT + (16 * s + 8 * h + 2 * j) * 264 + (32 * ct + r) * 2;
                pk[j] = (unsigned)*(const LAS bf16*)p | ((unsigned)*(const LAS bf16*)(p + 264) << 16); }
            y = MFMA32(M2[s], __builtin_bit_cast(bf16x8, (v4u){pk[0], pk[1], pk[2], pk[3]}), y); }
        bf16* mo = MIX + (size_t)(b * SEQ + c0 + t) * D + g * 128 + 32 * ct + r;
#pragma unroll
        for (int i = 0; i < 16; ++i) { const int d = 32 * dt + crow32(i, h); mo[(size_t)d * 64 * D] = bf1(y[i] * scale); } }
}
__device__ __forceinline__ void ph_mix_a(const Args& a, const Wg& w, const int l, const int rep = 0, const int mask = 7) {
    unsigned* ctr = (unsigned*)(a.ws + WS_CTL) + CW_Q + 64 * (2 * l) + 256 * rep;
    volatile LAS int* slot = (volatile LAS int*)(w.lds + GL_SLOT);
    const int nc1 = (l == 0) ? NC * 4 / 64 : 0;
    int par = 0; int item = wq_next(ctr, slot + 2, w.tid);
    if (item < nc1) {
        bf16x8 T1[8]; four_t1_setup(w, T1);
        while (item < nc1) { const int c = wq_claim(ctr, w.tid); if (mask & 4) ctx_dft1_item(a, w, T1, item); item = wq_take(slot, par, c, w.tid); }
    }
    while (item < nc1 + NG1) { const int c = wq_claim(ctr, w.tid); if (mask & 1) gla_g1_job(a, w, l, item - nc1, rep ? REP_VAR : 0); item = wq_take(slot, par, c, w.tid); }
    if (item < nc1 + NG1 + 2048) {
        bf16x8 T1[8]; four_a_setup(w, T1);
        while (item < nc1 + NG1 + 2048) { const int c = wq_claim(ctr, w.tid); if (mask & 2) four_a_item(a, w, T1, item - nc1 - NG1); item = wq_take(slot, par, c, w.tid); }
    }
}
__device__ __forceinline__ void ph_mix_c(const Args& a, const Wg& w, const int l, const int rep = 0, const int mask = 7) {
    unsigned* ctr = (unsigned*)(a.ws + WS_CTL) + CW_Q + 64 * (2 * l + 1) + 256 * rep;
    volatile LAS int* slot = (volatile LAS int*)(w.lds + GL_SLOT);
    const int ng3 = (l == 0) ? 544 : 512, nctx = (l == 0) ? 128 : 0;
    int par = 0; int item = wq_next(ctr, slot + 2, w.tid);
    if (item < nctx) {
        while (item < nctx) { const int c = wq_claim(ctr, w.tid); if (mask & 4) ctx_dft2_item(a, w, item); item = wq_take(slot, par, c, w.tid); }
    }
    while (item < nctx + ng3) {
        const int it = item - nctx, job = (l == 0) ? it : ((it >> 4) * 17 + (it & 15) + 1);
        const int c = wq_claim(ctr, w.tid); if (mask & 1) gla_g3_job(a, w, l, job, rep ? REP_VAR : 0); item = wq_take(slot, par, c, w.tid); }
    if (item < nctx + ng3 + 2048 / FB_N) {
        bf16x8 M2[8]; four_b_setup(w, M2);
        while (item < nctx + ng3 + 2048 / FB_N) { const int c = wq_claim(ctr, w.tid); __syncthreads(); if (mask & 2) four_b_item(a, w, M2, item - nctx - ng3); item = wq_take(slot, par, c, w.tid); }
    }
}
constexpr int CONV_WAVE_ITEMS = 16 * (16 * 112) + 8 * (56 * 32), CONV_ITEMS = CONV_WAVE_ITEMS / 8;
static_assert(CONV_WAVE_ITEMS % 8 == 0, "conversion items");
__device__ __forceinline__ void conv_items(const Args& a, const Wg& w, const int max_items) {
    const float* moe_w1 = a.in[19]; const float* moe_w3 = a.in[20]; const float* moe_w2 = a.in[21];
    unsigned char* MW13 = WS_PTR(unsigned char, WS_MW13); unsigned char* MW2 = WS_PTR(unsigned char, WS_MW2);
    unsigned* ctr = (unsigned*)(a.ws + WS_CTL) + CW_CONVQ;
    volatile LAS int* slot = (volatile LAS int*)(w.lds + 72 * 1024);
    LAS float* scr = (LAS float*)(w.lds + 1024 + w.wave * 8448);
    constexpr int I_M13 = 16 * 112, I_M2 = 56 * 32;
    for (int n = 0; n < max_items; ++n) {
        const int item = wq_next(ctr, slot, w.tid);
        if (item >= CONV_ITEMS) break;
        int r = item * 8 + w.wave;
        if (r < 8 * I_M13) { const int e = r / I_M13; transpose_item8(moe_w1 + (size_t)e * D * EFF, D, EFF, MW13 + (size_t)e * 2 * EFF * D, 0, 1, FP8_SW, scr, r % I_M13, w.lane); continue; } r -= 8 * I_M13;
        if (r < 8 * I_M13) { const int e = r / I_M13; transpose_item8(moe_w3 + (size_t)e * D * EFF, D, EFF, MW13 + (size_t)e * 2 * EFF * D, 0, 2, FP8_SW, scr, r % I_M13, w.lane); continue; } r -= 8 * I_M13;
        { const int e = r / I_M2; transpose_item8(moe_w2 + (size_t)e * EFF * D, EFF, D, MW2 + (size_t)e * D * EFF, 0, 0, FP8_SW, scr, r % I_M2, w.lane); }
    }
    __syncthreads();
}
__device__ __forceinline__ void conv_in_tail(const Args& a, const Wg& w, const int nunits, const int quota) {
    const int mine = (nunits - w.bx + w.G - 1) / w.G, most = (nunits + w.G - 1) / w.G;
    if (mine < most) conv_items(a, w, quota);
}
__device__ __forceinline__ void ph_gout(const Args& a, const Wg& w, const int l) {
    const float* modl = WS_PTR(float, WS_MODV) + (size_t)l * 9 * MOD6;
    pg8::DenseOrder S; S.init(WS_PTR(bf16, WS_MIX), WS_PTR(bf16, WS_WOUT) + (size_t)l * D * D, l == 0 ? MT : NL, D, D, w.G, w.bx);
    pg8::EpiRes E{l == 0 ? a.in[0] : nullptr, l == 0 ? a.in[2] : nullptr, WS_PTR(bf16, WS_XRES), modl + 2 * D, 1.0f};
    pg8::gemm_phase<pg8::EpiRes, pg8::DenseOrder, true, false>(w.lds, D, S, E);
    if (l == 0) conv_in_tail(a, w, (MT / 256) * (D / 256), CONV_Q_GOUT);
}
__device__ __forceinline__ void ph_fup(const Args& a, const Wg& w) {
    constexpr int KA = (FP8_FUP || I8_FUP) ? D / 2 : D;
    pg8::DenseOrder S; S.init(WS_PTR(bf16, WS_HBUF), WS_PTR(bf16, WS_W13), MT, 2 * DFF, KA, w.G, w.bx);
    constexpr float inv = FP8_FUP ? 1.0f / (FP8_SH * FP8_SW) : 1.0f;
    if constexpr (I8_FUP) { static_assert(FP8_FDN, "the int8 up GEMM writes an fp8 hidden");
        pg8::EpiSwiGLU8i E{WS_PTR(unsigned char, WS_HID), DFF, WS_PTR(float, WS_RS), WS_PTR(float, WS_WCS) + WCS_W1, WS_PTR(float, WS_WCS) + WCS_W3, FP8_SHID}; pg8::gemm_phase<pg8::EpiSwiGLU8i, pg8::DenseOrder, true, false, 2>(w.lds, KA, S, E); }
    else if constexpr (FP8_FDN) { pg8::EpiSwiGLU8 E{WS_PTR(unsigned char, WS_HID), DFF, inv, FP8_SHID, 0}; pg8::gemm_phase<pg8::EpiSwiGLU8, pg8::DenseOrder, true, false, FP8_FUP ? 1 : 0>(w.lds, KA, S, E); }
    else { pg8::EpiSwiGLU E{WS_PTR(bf16, WS_HID), DFF, inv}; pg8::gemm_phase<pg8::EpiSwiGLU, pg8::DenseOrder, true, false, FP8_FUP ? 1 : 0>(w.lds, KA, S, E); }
    conv_in_tail(a, w, (MT / 256) * (2 * DFF / 256), CONV_Q_FUP);
}
__device__ __forceinline__ void ph_fdn(const Args& a, const Wg& w) {
    const float* modl = WS_PTR(float, WS_MODV);
    constexpr int KA = FP8_FDN ? DFF / 2 : DFF;
    pg8::DenseOrder S; S.init(WS_PTR(bf16, WS_HID), WS_PTR(bf16, WS_W2), MT, D, KA, w.G, w.bx); pg8::EpiRes E{nullptr, nullptr, WS_PTR(bf16, WS_XRES), modl + 5 * D, FP8_FDN ? 1.0f / (FP8_SHID * FP8_SW) : 1.0f};
    pg8::gemm_phase<pg8::EpiRes, pg8::DenseOrder, true, false, FP8_FDN ? 1 : 0>(w.lds, KA, S, E);
    conv_in_tail(a, w, (MT / 256) * (D / 256), CONV_Q_FDN);
}
__device__ __forceinline__ void ph_route(const Args& a, const Wg& w) {
    if (w.bx >= 128) return;
    const int tid = w.tid, lane = w.lane, wave = w.wave;
    const int* TOKE = WS_PTR(int, WS_ROUTE + RT_TOKE); const float* TOKG = WS_PTR(float, WS_ROUTE + RT_TOKG);
    int* RIDX = WS_PTR(int, WS_ROUTE + RT_RIDX); float* RGATE = WS_PTR(float, WS_ROUTE + RT_RGATE); int* TEXP = WS_PTR(int, WS_ROUTE + RT_TEXP); int* NTL = WS_PTR(int, WS_ROUTE + RT_NT);
    const int s = w.bx >> 6, e = (w.bx >> 3) & 7, seg = w.bx & 7;
    LAS int* cnt = (LAS int*)w.lds;
    LAS int* wtot = (LAS int*)(w.lds + 64);
    if (tid < 9) cnt[tid] = 0;
    __syncthreads();
    int lc[9];
#pragma unroll
    for (int q = 0; q < 9; ++q) lc[q] = 0;
    for (int t = 4 * tid; t < NL; t += 4 * NTHR) { const int4 te = *(const int4*)(TOKE + s * NL + t); const int bef = t < seg * 4096;
#pragma unroll
        for (int q = 0; q < 8; ++q) lc[q] += (te.x == q) + (te.y == q) + (te.z == q) + (te.w == q);
        lc[8] += bef ? (te.x == e) + (te.y == e) + (te.z == e) + (te.w == e) : 0; }
#pragma unroll
    for (int q = 0; q < 9; ++q) { int v = lc[q];
#pragma unroll
        for (int o = 1; o < 64; o <<= 1) v += __shfl_xor(v, o);
        if (lane == 0) atomicAdd((int*)&cnt[q], v); }
    __syncthreads();
    int base = 0, total = 0, mycnt = 0;
    for (int q = 0; q < 8; ++q) { const int cq = cnt[q], tq = (cq + 255) >> 8; if (q < e) base += tq * 256; if (q == e) mycnt = cq; total += tq; }
    int running = cnt[8];
    for (int t0 = seg * 4096; t0 < seg * 4096 + 4096; t0 += 4 * NTHR) {
        const int t = t0 + 4 * tid; const int4 te = *(const int4*)(TOKE + s * NL + t);
        const int f0 = te.x == e, f1 = te.y == e, f2 = te.z == e, f3 = te.w == e, mine = f0 + f1 + f2 + f3;
        int incl = mine;
#pragma unroll
        for (int o = 1; o < 64; o <<= 1) { const int v = __shfl_up(incl, o); if (lane >= o) incl += v; }
        const int wt = __shfl(incl, 63);
        __syncthreads();
        if (lane == 0) wtot[wave] = wt;
        __syncthreads();
        int woff = 0, ctot = 0;
#pragma unroll
        for (int q = 0; q < 8; ++q) { const int v = wtot[q]; if (q < wave) woff += v; ctot += v; }
        int pos = s * RT_TILES * 256 + base + running + woff + incl - mine;
        int* POS = WS_PTR(int, WS_ROUTE + RT_POS) + s * NL; const int pb = s * RT_TILES * 256;
        if (f0) { RIDX[pos] = t;     RGATE[pos] = TOKG[s * NL + t];     POS[t] = pos - pb;     ++pos; }
        if (f1) { RIDX[pos] = t + 1; RGATE[pos] = TOKG[s * NL + t + 1]; POS[t + 1] = pos - pb; ++pos; }
        if (f2) { RIDX[pos] = t + 2; RGATE[pos] = TOKG[s * NL + t + 2]; POS[t + 2] = pos - pb; ++pos; }
        if (f3) { RIDX[pos] = t + 3; RGATE[pos] = TOKG[s * NL + t + 3]; POS[t + 3] = pos - pb; ++pos; }
        running += ctot; }
    if (seg == 0) {
        const int padend = base + ((mycnt + 255) >> 8) * 256;
        for (int p = base + mycnt + tid; p < padend; p += NTHR) { RIDX[s * RT_TILES * 256 + p] = -1; RGATE[s * RT_TILES * 256 + p] = 0.f; }
        for (int tl = (base >> 8) + tid; tl < (padend >> 8); tl += NTHR) TEXP[s * RT_TILES + tl] = e;
        if (e == 0 && tid == 0) NTL[s * 64] = total;
    }
    __syncthreads();
}
__device__ __forceinline__ void ph_mup(const Args& a, const Wg& w, const int skip = 0) {
    const int nt0 = __builtin_amdgcn_readfirstlane(__hip_atomic_load(WS_PTR(int, WS_ROUTE + RT_NT), __ATOMIC_RELAXED, __HIP_MEMORY_SCOPE_AGENT));
    const int nt1 = __builtin_amdgcn_readfirstlane(__hip_atomic_load(WS_PTR(int, WS_ROUTE + RT_NT) + 64, __ATOMIC_RELAXED, __HIP_MEMORY_SCOPE_AGENT));
    pg8::MoeOrder S; S.oc.init(nt0 + nt1, 2 * EFF / 256, w.G, w.bx); S.A = (const char*)WS_PTR(bf16, WS_HBUF); S.Bt = (const char*)WS_PTR(bf16, WS_MW13); S.tstepA = 0; S.tstepB = (size_t)256 * D; S.estride = (size_t)2 * EFF * D;
    S.texp = WS_PTR(int, WS_ROUTE + RT_TEXP); S.ridx = WS_PTR(int, WS_ROUTE + RT_RIDX); S.nt0 = nt0; S.gap = RT_TILES - nt0;
    pg8::EpiSwiGLU8 E{WS_PTR(unsigned char, WS_HID2), EFF, 1.0f / (FP8_SH * FP8_SW), FP8_SHID, skip};
    pg8::gemm_phase<pg8::EpiSwiGLU8, pg8::MoeOrder, true, true, 1>(w.lds, D / 2, S, E);
}
__device__ __forceinline__ void ph_mdn(const Args& a, const Wg& w, const int s) {
    const int ntl = __builtin_amdgcn_readfirstlane(__hip_atomic_load(WS_PTR(int, WS_ROUTE + RT_NT) + s * 64, __ATOMIC_RELAXED, __HIP_MEMORY_SCOPE_AGENT));
    const float* modl = WS_PTR(float, WS_MODV) + (size_t)9 * MOD6;
    pg8::MoeOrder S; S.oc.init(ntl, D / 256, w.G, w.bx); S.A = (const char*)WS_PTR(unsigned char, WS_HID2) + (size_t)s * RT_TILES * 256 * EFF; S.Bt = (const char*)WS_PTR(bf16, WS_MW2); S.tstepA = (size_t)256 * EFF; S.tstepB = (size_t)256 * EFF; S.estride = (size_t)D * EFF;
    S.texp = WS_PTR(int, WS_ROUTE + RT_TEXP) + s * RT_TILES; S.ridx = WS_PTR(int, WS_ROUTE + RT_RIDX) + s * RT_TILES * 256; S.nt0 = 1 << 30; S.gap = 0;
    pg8::EpiScatter E{WS_PTR(int, WS_ROUTE + RT_RIDX) + s * RT_TILES * 256, WS_PTR(float, WS_ROUTE + RT_RGATE) + s * RT_TILES * 256, WS_PTR(bf16, WS_XRES), modl + 5 * D, 1.0f / (FP8_SHID * FP8_SW)};
    pg8::gemm_phase<pg8::EpiScatter, pg8::MoeOrder, true, false, 1>(w.lds, EFF / 2, S, E);
}
__device__ __forceinline__ void ph_mdn2(const Args& a, const Wg& w) {
    const int nt0 = __builtin_amdgcn_readfirstlane(__hip_atomic_load(WS_PTR(int, WS_ROUTE + RT_NT), __ATOMIC_RELAXED, __HIP_MEMORY_SCOPE_AGENT));
    const int nt1 = __builtin_amdgcn_readfirstlane(__hip_atomic_load(WS_PTR(int, WS_ROUTE + RT_NT) + 64, __ATOMIC_RELAXED, __HIP_MEMORY_SCOPE_AGENT));
    pg8::MoeOrderRM S; S.nwg = (nt0 + nt1) * (D / 256); S.G = w.G; S.c = w.bx; S.A = (const char*)WS_PTR(unsigned char, WS_HID2); S.Bt = (const char*)WS_PTR(bf16, WS_MW2); S.tstepA = (size_t)256 * EFF; S.tstepB = (size_t)256 * EFF; S.estride = (size_t)D * EFF;
    S.texp = WS_PTR(int, WS_ROUTE + RT_TEXP); S.nt0 = nt0; S.gap = RT_TILES - nt0;
    pg8::EpiY E{WS_PTR(float, WS_ROUTE + RT_RGATE), WS_PTR(bf16, WS_Y0), WS_PTR(bf16, WS_HBUF), WS_PTR(bf16, WS_SLOC), 1.0f / (FP8_SHID * FP8_SW), RT_TILES, Y1_SPLIT};
    pg8::gemm_phase<pg8::EpiY, pg8::MoeOrderRM, true, false, 1>(w.lds, EFF / 2, S, E);
}
__device__ __forceinline__ void ph_final2(const Args& a, const Wg& w) {
    const int lane = w.lane; const float* fw = a.in[22]; const bf16* XRES = WS_PTR(bf16, WS_XRES); const bf16* Y0 = WS_PTR(bf16, WS_Y0);
    const bf16* Y1A = WS_PTR(bf16, WS_HBUF); const bf16* Y1B = WS_PTR(bf16, WS_SLOC) - (size_t)Y1_SPLIT * 256 * D;
    const int* POS = WS_PTR(int, WS_ROUTE + RT_POS); const float* gate = WS_PTR(float, WS_MODV) + (size_t)9 * MOD6 + 5 * D;
    f32x4 wv[4];
#pragma unroll
    for (int j = 0; j < 4; ++j) wv[j] = *(const f32x4*)(fw + 4 * lane + 256 * j);
    constexpr int TB = 2;
    int np0[TB], np1[TB];
    { const int m0 = w.gw * TB;
#pragma unroll
      for (int k = 0; k < TB; ++k) { np0[k] = m0 + k < NL ? POS[m0 + k] : 0; np1[k] = m0 + k < NL ? POS[NL + m0 + k] : 0; } }
    for (int m0 = w.gw * TB; m0 < NL; m0 += w.NGW * TB) {
        pg8::u32x2_t xr[TB][4], y0r[TB][4], y1r[TB][4];
#pragma unroll
        for (int k = 0; k < TB; ++k) { const int p0 = __builtin_amdgcn_readfirstlane(np0[k]), p1 = __builtin_amdgcn_readfirstlane(np1[k]);
            const bf16* y1p = (p1 < Y1_SPLIT * 256 ? Y1A : Y1B) + (size_t)p1 * D;
#pragma unroll
            for (int j = 0; j < 4; ++j) { const int c = 4 * lane + 256 * j; xr[k][j] = *(const pg8::u32x2_t*)(XRES + (size_t)(m0 + k) * D + c); y0r[k][j] = *(const pg8::u32x2_t*)(Y0 + (size_t)p0 * D + c); y1r[k][j] = *(const pg8::u32x2_t*)(y1p + c); } }
        { const int mn = m0 + w.NGW * TB;
#pragma unroll
          for (int k = 0; k < TB; ++k) { np0[k] = mn + k < NL ? POS[mn + k] : 0; np1[k] = mn + k < NL ? POS[NL + mn + k] : 0; } }
        const float* gp = gate + (m0 >> 12) * MOD6;
        f32x4 g[4];
#pragma unroll
        for (int j = 0; j < 4; ++j) g[j] = *(const f32x4*)(gp + 4 * lane + 256 * j);
#pragma unroll
        for (int k = 0; k < TB; ++k) {
            f32x4 v[4]; float ss = 0.f;
#pragma unroll
            for (int j = 0; j < 4; ++j) { v[j] = pg8::bf4_to_f32(xr[k][j]) + g[j] * (pg8::bf4_to_f32(y0r[k][j]) + pg8::bf4_to_f32(y1r[k][j])); ss += (v[j].x * v[j].x + v[j].y * v[j].y) + (v[j].z * v[j].z + v[j].w * v[j].w); }
            const float rstd = 1.0f / sqrtf(wave_sum(ss) * (1.0f / D) + EPS);
            float* xo = a.out + (size_t)(m0 + k) * D;
#pragma unroll
            for (int j = 0; j < 4; ++j) *(f32x4*)(xo + 4 * lane + 256 * j) = (v[j] * rstd) * wv[j]; }
    }
}
__device__ __forceinline__ void ph_final(const Args& a, const Wg& w) {
    const int lane = w.lane; const float* fw = a.in[22]; const bf16* XRES = WS_PTR(bf16, WS_XRES);
    for (int m = w.gw; m < NL; m += w.NGW) {
        float* xr = a.out + (size_t)m * D;
        f32x4 v[4]; float ss = 0.f;
#pragma unroll
        for (int j = 0; j < 4; ++j) { v[j] = pg8::bf4_to_f32(*(const pg8::u32x2_t*)(XRES + (size_t)m * D + 4 * lane + 256 * j)); ss += (v[j].x * v[j].x + v[j].y * v[j].y) + (v[j].z * v[j].z + v[j].w * v[j].w); }
        const float rstd = 1.0f / sqrtf(wave_sum(ss) * (1.0f / D) + EPS);
#pragma unroll
        for (int j = 0; j < 4; ++j) { const int c = 4 * lane + 256 * j; *(f32x4*)(xr + c) = (v[j] * rstd) * *(const f32x4*)(fw + c); }
    }
}

constexpr int NPH = 23;
__global__ void __launch_bounds__(NTHR, 2) fwd_kernel(Args args) {
    extern __shared__ __attribute__((aligned(16))) unsigned char lds_raw[];
    Wg w; w.lds = (LAS unsigned char*)lds_raw;
    volatile LAS unsigned* MISC = (volatile LAS unsigned*)(w.lds + MISC_OFF);
    w.wave = __builtin_amdgcn_readfirstlane((int)threadIdx.x >> 6); w.lane = (int)__builtin_amdgcn_mbcnt_hi(~0u, __builtin_amdgcn_mbcnt_lo(~0u, 0u)); w.tid = w.wave * 64 + w.lane;
    w.G = gridDim.x; w.bx = blockIdx.x; w.gw = w.bx * NWAVES + w.wave; w.NGW = w.G * NWAVES;
    unsigned* ctl = (unsigned*)(args.ws + WS_CTL);
    for (int u = w.tid; u < (LDS_BYTES - LDSCTL_OFF) / 4; u += NTHR) ((LAS unsigned*)(w.lds + LDSCTL_OFF))[u] = 0u;
    __syncthreads();
    XcdBarrier bar; bar.bar = ctl + CW_BAR; bar.x = 0; bar.st = nullptr;
    if (!MK_MULTI) bar = xcd_barrier_post(ctl + CW_BAR, MISC + 8);
    const int lo = args.ph_lo, hi = args.ph_hi;
#define PH(id, call) do { if (lo <= (id) && (id) < hi) { call; if (!MK_MULTI && (id) + 1 < hi) xcd_barrier(bar); } } while (0)
#define PHR(n, id, call) do { if ((n) > 1) { call; xcd_barrier(bar); } PH(id, call); } while (0)
    PHR(REP_PRO, 0, ph_prologue(args, w));
    PH(1, ph_modfin(args, w));
    PHR(REP_NORM, 2, (ph_norm(args, w, 0, 0), ph_quant(args, w)));
    PHR(REP_GIN, 3, ph_gin(args, w, 0));
    if (REP_MIXA > 1) { ph_mix_a(args, w, 0, 1, REP_MASK); xcd_barrier(bar); }
    PH(4, ph_mix_a(args, w, 0));
    PH(5, ph_gla_scan(args, w));
    if (REP_MIXC > 1) { ph_mix_c(args, w, 0, 1, REP_MASK); xcd_barrier(bar); }
    PH(6, ph_mix_c(args, w, 0));
    PHR(REP_GOUT, 7, ph_gout(args, w, 0));
    PHR(REP_NORM, 8, ph_norm(args, w, 0, 1));
    PHR(REP_FUP, 9, ph_fup(args, w));
    PH(10, ph_fdn(args, w));
    PHR(REP_NORM, 11, ph_norm(args, w, 1, 0));
    PHR(REP_GIN, 12, ph_gin(args, w, 1));
    if (REP_MIXA > 1) { ph_mix_a(args, w, 1, 1, REP_MASK); xcd_barrier(bar); }
    PH(13, ph_mix_a(args, w, 1));
    PH(14, ph_gla_scan(args, w));
    if (REP_MIXC > 1) { ph_mix_c(args, w, 1, 1, REP_MASK); xcd_barrier(bar); }
    PH(15, ph_mix_c(args, w, 1));
    PH(16, ph_gout(args, w, 1));
    PHR(REP_NORM, 17, ph_norm(args, w, 1, 1));
    PHR(REP_PRO, 18, (ph_route(args, w), conv_items(args, w, 1 << 30)));
    if (REP_MUP > 1) { ph_mup(args, w, REP_VAR); xcd_barrier(bar); } PH(19, ph_mup(args, w));
#if MDN_MERGE
    PH(20, ph_mdn2(args, w));
    PH(21, ph_final2(args, w));
#else
    PH(20, ph_mdn(args, w, 0));
    PH(21, ph_mdn(args, w, 1));
    PH(22, ph_final(args, w));
#endif
#undef PH
#undef PHR
}

extern "C" void kernel_launch(void* const* d_in, const int* in_sizes, int n_in, void* d_out, int out_size, void* d_ws, size_t ws_size, hipStream_t stream) {
    static int grid = 0;
    if (grid == 0) {
        if (n_in != 23 || out_size != NL * D || ws_size < WS_END) { fprintf(stderr, "kernel_launch: unexpected shapes (n_in %d, out %d, ws %zu < %zu); nothing launched\n", n_in, out_size, ws_size, (size_t)WS_END); grid = -1; return; }
        int dev = 0, cus = 0, per_cu = 0;
        if (hipGetDevice(&dev) != hipSuccess || hipDeviceGetAttribute(&cus, hipDeviceAttributeMultiprocessorCount, dev) != hipSuccess) { grid = -1; return; }
        if (hipFuncSetAttribute((const void*)fwd_kernel, hipFuncAttributeMaxDynamicSharedMemorySize, LDS_BYTES) != hipSuccess) { fprintf(stderr, "kernel_launch: hipFuncSetAttribute failed\n"); grid = -1; return; }
        if (hipOccupancyMaxActiveBlocksPerMultiprocessor(&per_cu, (const void*)fwd_kernel, NTHR, LDS_BYTES) != hipSuccess || per_cu < 1) { fprintf(stderr, "kernel_launch: occupancy query says %d blocks per CU\n", per_cu); }
        (void)hipGetLastError();
        grid = cus;
    }
    if (grid < 0) return;
    if (hipMemsetAsync((char*)d_ws + WS_CTL, 0, CTL_ZERO_BYTES, stream) != hipSuccess) { fprintf(stderr, "kernel_launch: memset failed\n"); return; }
    Args a{};
    for (int i = 0; i < 23; ++i) a.in[i] = (const float*)d_in[i];
    a.out = (float*)d_out; a.ws = (unsigned char*)d_ws; a.pad = 0;
#if MK_MULTI
    for (int p = 0; p < NPH; ++p) { a.ph_lo = p; a.ph_hi = p + 1; a.li = p; hipLaunchKernelGGL(fwd_kernel, dim3(grid), dim3(NTHR), LDS_BYTES, stream, a); }
#else
    a.ph_lo = 0; a.ph_hi = MDN_MERGE ? 22 : NPH; a.li = 0;
    hipLaunchKernelGGL(fwd_kernel, dim3(grid), dim3(NTHR), LDS_BYTES, stream, a);
#endif
    const hipError_t le = hipPeekAtLastError();
    if (le != hipSuccess) fprintf(stderr, "kernel_launch: launch failed: %s\n", hipGetErrorName(le));
}
```

```cpp
#include <hip/hip_runtime.h>
#include <cstdio>
#include <cstdint>

#ifndef CONV_Q_GIN
#define CONV_Q_GIN 4
#define CONV_Q_GOUT 8
#define CONV_Q_FUP 4
#define CONV_Q_FDN 7
#endif
#ifndef REP_GIN
#define REP_GIN 1
#endif
#ifndef REP_GOUT
#define REP_GOUT 1
#endif
#ifndef REP_FUP
#define REP_FUP 1
#endif
#ifndef REP_MUP
#define REP_MUP 1
#endif
#ifndef REP_GEMM
#define REP_GEMM 1
#endif
#ifndef REP_NORM
#define REP_NORM 1
#endif
#ifndef REP_MIXA
#define REP_MIXA 1
#endif
#ifndef REP_VAR
#define REP_VAR 0
#endif
#ifndef REP_MASK
#define REP_MASK 7
#endif
#ifndef REP_MIXC
#define REP_MIXC 1
#endif
#ifndef REP_PRO
#define REP_PRO 1
#endif
#ifndef I8_GIN
#define I8_GIN 1
#endif
#ifndef I8_FUP
#define I8_FUP 1
#endif
#ifndef FP8_FUP
#define FP8_FUP 0
#endif
#ifndef FP8_FDN
#define FP8_FDN 1
#endif
#ifndef MK_MULTI
#define MK_MULTI 0
#endif

constexpr int D = 1024, NB = 8, SEQ = 4096, CTXL = 256;
constexpr int NL = NB * SEQ;
constexpr int NC = NB * CTXL;
constexpr int MT = NL + NC;
constexpr int INW = 2080, INP = 2304;
constexpr int DFF = 2816, EFF = 3584, NE = 8;
constexpr int MOD6 = 6 * D;
constexpr float EPS = 1e-6f;
constexpr float FP8_SH = 16.0f, FP8_SW = 512.0f, FP8_SHID = 8.0f;
constexpr int PC_U = 0, PC_Q = 512, PC_K = 768, PC_V = 1024, PC_G = 1536, PC_LF = 2048, PC_LB = 2064;

namespace pg8 {
#define PG8_LAS __attribute__((address_space(3)))
typedef unsigned short bf16_t;
typedef short bf16x8 __attribute__((ext_vector_type(8)));
typedef float f32x4 __attribute__((ext_vector_type(4)));
typedef unsigned u32x4 __attribute__((ext_vector_type(4)));
constexpr int BM = 256, BK = 64, HALF = 128, HTB = HALF * BK * 2, STAGE_BYTES = 8 * HTB, NXCD = 8, WGM = 8;

__host__ __device__ __forceinline__ int lds_byte(int r, int c) { const int st = (r >> 4) * 2 + (c >> 5), rr = r & 15, cc = c & 31, ob = rr * 64 + cc * 2; return st * 1024 + (ob ^ (((ob >> 9) & 1) << 5)); }
__host__ __device__ __forceinline__ void stage_rc(int b, int& R, int& C) { const int st = b / 1024, sb = b % 1024, swz = sb ^ (((sb >> 9) & 1) << 5); R = (st >> 1) * 16 + swz / 64; C = (st & 1) * 32 + (swz % 64) / 2; }
__host__ __device__ __forceinline__ int perm32(int rho) { const int n = rho >> 4, i = rho & 15; return 8 * (i >> 2) + 4 * n + (i & 3); }

struct Unit { int pm, pn; const char* a; const char* b; const int* ridx; };

__device__ __forceinline__ const char* uptr(const char* p) { const unsigned long long v = (unsigned long long)p; const unsigned lo = __builtin_amdgcn_readfirstlane((unsigned)v), hi = __builtin_amdgcn_readfirstlane((unsigned)(v >> 32)); return (const char*)(((unsigned long long)hi << 32) | lo); }
__device__ __forceinline__ void glds_s(const char* base, unsigned voff, unsigned lds_dst) { unsigned keep;
    asm volatile("s_mov_b32 %0, m0\n\ts_mov_b32 m0, %3\n\ts_nop 0\n\tglobal_load_lds_dwordx4 %1, %2\n\ts_mov_b32 m0, %0" : "=&s"(keep) : "v"(voff), "s"((unsigned long long)base), "s"(lds_dst) : "memory"); }
struct OrderCore {
    int nM, nN, nwg, G, c;
    __device__ __forceinline__ void init(int nM_, int nN_, int G_, int c_) { nM = nM_; nN = nN_; nwg = nM * nN; G = G_; c = c_; }
    __device__ __forceinline__ bool tile(int i, int& pm, int& pn) const {
        const long L = (long)i * G + c; if (L >= nwg) return false;
        int wgid = (int)L; { const int q = nwg / NXCD, r = nwg % NXCD, xcd = wgid % NXCD, off = wgid / NXCD; wgid = (xcd < r ? xcd * (q + 1) : r * (q + 1) + (xcd - r) * q) + off; }
        const int nig = WGM * nN, gid = wgid / nig, fm = gid * WGM, gsz = (nM - fm) < WGM ? (nM - fm) : WGM;
        pm = fm + ((wgid % nig) % gsz); pn = (wgid % nig) / gsz; return true;
    }
};
struct DenseOrder {
    OrderCore oc; const char* A; const char* Bt; size_t tstep;
    __device__ __forceinline__ void init(const bf16_t* A_, const bf16_t* Bt_, int M, int N, int K, int G, int c) { oc.init(M / BM, N / BM, G, c); A = (const char*)A_; Bt = (const char*)Bt_; tstep = (size_t)BM * K * 2; }
    __device__ __forceinline__ bool next(int i, Unit& u) const { if (!oc.tile(i, u.pm, u.pn)) return false; u.pm = __builtin_amdgcn_readfirstlane(u.pm); u.pn = __builtin_amdgcn_readfirstlane(u.pn); u.a = uptr(A + (size_t)u.pm * tstep); u.b = uptr(Bt + (size_t)u.pn * tstep); u.ridx = nullptr; return true; }
};
struct MoeOrder {
    OrderCore oc; const char* A; const char* Bt; size_t tstepA, tstepB, estride; const int* texp; const int* ridx; int nt0, gap;
    __device__ __forceinline__ bool next(int i, Unit& u) const { if (!oc.tile(i, u.pm, u.pn)) return false;
        u.pm = u.pm < nt0 ? u.pm : u.pm + gap;
        const int e = __builtin_amdgcn_readfirstlane(__hip_atomic_load(texp + u.pm, __ATOMIC_RELAXED, __HIP_MEMORY_SCOPE_AGENT));
        u.pm = __builtin_amdgcn_readfirstlane(u.pm); u.pn = __builtin_amdgcn_readfirstlane(u.pn); u.a = uptr(A + (size_t)u.pm * tstepA); u.b = uptr(Bt + (size_t)e * estride + (size_t)u.pn * tstepB); u.ridx = (const int*)uptr((const char*)(ridx + u.pm * BM)); return true; }
};

typedef int v4i_t __attribute__((ext_vector_type(4)));
typedef int v8i_t __attribute__((ext_vector_type(8)));
__device__ __forceinline__ v8i_t cat8(const bf16x8 lo, const bf16x8 hi) { const v4i_t a = __builtin_bit_cast(v4i_t, lo), b = __builtin_bit_cast(v4i_t, hi); return __builtin_shufflevector(a, b, 0, 1, 2, 3, 4, 5, 6, 7); }
__device__ __forceinline__ void mfma8(f32x4& acc, const v8i_t a, const v8i_t b, const int sc) {
    asm volatile("v_mfma_scale_f32_16x16x128_f8f6f4 %0, %1, %2, %0, %3, %3 op_sel_hi:[0,0,0]" : "+v"(acc) : "v"(a), "v"(b), "v"(sc)); }
__device__ __forceinline__ unsigned pk4_fp8_raw(float a, float b, float c, float d) { int r = __builtin_amdgcn_cvt_pk_fp8_f32(a, b, 0, false); r = __builtin_amdgcn_cvt_pk_fp8_f32(c, d, r, true); return (unsigned)r; }
__device__ __forceinline__ unsigned pk4_fp8(float a, float b, float c, float d) { return pk4_fp8_raw(__builtin_amdgcn_fmed3f(a, -448.f, 448.f), __builtin_amdgcn_fmed3f(b, -448.f, 448.f), __builtin_amdgcn_fmed3f(c, -448.f, 448.f), __builtin_amdgcn_fmed3f(d, -448.f, 448.f)); }
__device__ __forceinline__ float clamp448(float v) { return __builtin_fminf(__builtin_fmaxf(v, -448.0f), 448.0f); }
__device__ __forceinline__ unsigned cvt_pk_bf16(float lo, float hi) { unsigned r; asm volatile("v_cvt_pk_bf16_f32 %0, %1, %2" : "=v"(r) : "v"(lo), "v"(hi)); return r; }

struct EpiBf16 {
    static constexpr bool PERM = true;
    bf16_t* O; int ldc;
    __device__ __forceinline__ void operator()(const f32x4 (&acc)[2][2][4][2], const Unit& u, int wr, int wc, int fr, int fq) const {
        const int row0 = u.pm * BM + wr * 64 + fr, col0 = u.pn * BM + wc * 32 + 8 * fq;
#pragma unroll
        for (int ai = 0; ai < 2; ++ai)
#pragma unroll
            for (int m = 0; m < 4; ++m) { bf16_t* rowp = O + (size_t)(row0 + ai * HALF + m * 16) * ldc + col0;
#pragma unroll
                for (int bj = 0; bj < 2; ++bj) { const f32x4 v0 = acc[ai][bj][m][0], v1 = acc[ai][bj][m][1];
                    u32x4 w; w.x = cvt_pk_bf16(v0[0], v0[1]); w.y = cvt_pk_bf16(v0[2], v0[3]); w.z = cvt_pk_bf16(v1[0], v1[1]); w.w = cvt_pk_bf16(v1[2], v1[3]);
                    *(u32x4*)(rowp + bj * HALF) = w; } }
    }
};
__device__ __forceinline__ float silu_f(float a) { return a * __builtin_amdgcn_rcpf(1.0f + __builtin_amdgcn_exp2f(a * -1.4426950408889634f)); }
struct EpiSwiGLU {
    static constexpr bool PERM = true;
    bf16_t* O; int ldc; float inv;
    __device__ __forceinline__ void operator()(const f32x4 (&acc)[2][2][4][2], const Unit& u, int wr, int wc, int fr, int fq) const {
        const int row0 = u.pm * BM + wr * 64 + fr, col0 = u.pn * HALF + wc * 32 + 8 * fq;
#pragma unroll
        for (int ai = 0; ai < 2; ++ai)
#pragma unroll
            for (int m = 0; m < 4; ++m) { bf16_t* rowp = O + (size_t)(row0 + ai * HALF + m * 16) * ldc + col0;
                float h[8]; typedef float f2 __attribute__((ext_vector_type(2)));
                const float kexp = inv * -1.4426950408889634f, c0 = 1.0f / (inv * inv), lc0 = __builtin_log2f(c0);
#pragma unroll
                for (int n = 0; n < 2; ++n)
#pragma unroll
                    for (int j = 0; j < 4; j += 2) { const f2 a1 = {acc[ai][0][m][n][j], acc[ai][0][m][n][j + 1]}, a3 = {acc[ai][1][m][n][j], acc[ai][1][m][n][j + 1]};
                        const f2 t = a1 * kexp + lc0; f2 d; d.x = __builtin_amdgcn_exp2f(t.x); d.y = __builtin_amdgcn_exp2f(t.y); d = d + c0;
                        f2 rr; rr.x = __builtin_amdgcn_rcpf(d.x); rr.y = __builtin_amdgcn_rcpf(d.y); const f2 hv = (a1 * a3) * rr; h[4 * n + j] = hv.x; h[4 * n + j + 1] = hv.y; }
                u32x4 w; w.x = cvt_pk_bf16(h[0], h[1]); w.y = cvt_pk_bf16(h[2], h[3]); w.z = cvt_pk_bf16(h[4], h[5]); w.w = cvt_pk_bf16(h[6], h[7]);
                *(u32x4*)rowp = w; }
    }
};
struct EpiSwiGLU8 {
    static constexpr bool PERM = true;
    unsigned char* O; int ldc; float inv, oscale; int skip;
    __device__ __forceinline__ void operator()(const f32x4 (&acc)[2][2][4][2], const Unit& u, int wr, int wc, int fr, int fq) const {
        if (skip) return;
        const int row0 = u.pm * BM + wr * 64 + fr, col0 = u.pn * HALF + wc * 32 + 8 * fq;
        const float kexp = inv * -1.4426950408889634f, c0 = 1.0f / (inv * inv * oscale), lc0 = __builtin_log2f(c0);
        typedef unsigned u32x2 __attribute__((ext_vector_type(2))); typedef float f2 __attribute__((ext_vector_type(2)));
#pragma unroll
        for (int ai = 0; ai < 2; ++ai)
#pragma unroll
            for (int m = 0; m < 4; ++m) { unsigned char* rowp = O + (size_t)(row0 + ai * HALF + m * 16) * ldc + col0;
                float h[8];
#pragma unroll
                for (int n = 0; n < 2; ++n)
#pragma unroll
                    for (int j = 0; j < 4; j += 2) { const f2 a1 = {acc[ai][0][m][n][j], acc[ai][0][m][n][j + 1]}, a3 = {acc[ai][1][m][n][j], acc[ai][1][m][n][j + 1]};
                        const f2 t = a1 * kexp + lc0; f2 d; d.x = __builtin_amdgcn_exp2f(t.x); d.y = __builtin_amdgcn_exp2f(t.y); d = d + c0;
                        f2 rr; rr.x = __builtin_amdgcn_rcpf(d.x); rr.y = __builtin_amdgcn_rcpf(d.y); const f2 hv = (a1 * a3) * rr;
                        h[4 * n + j] = __builtin_amdgcn_fmed3f(hv.x, -448.0f, 448.0f); h[4 * n + j + 1] = __builtin_amdgcn_fmed3f(hv.y, -448.0f, 448.0f); }
                *(u32x2*)rowp = (u32x2){pk4_fp8_raw(h[0], h[1], h[2], h[3]), pk4_fp8_raw(h[4], h[5], h[6], h[7])}; }
    }
};
typedef unsigned u32x2_t __attribute__((ext_vector_type(2)));
__device__ __forceinline__ f32x4 bf4_to_f32(const u32x2_t v) { f32x4 r; r.x = __uint_as_float(v.x << 16); r.y = __uint_as_float(v.x & 0xffff0000u); r.z = __uint_as_float(v.y << 16); r.w = __uint_as_float(v.y & 0xffff0000u); return r; }
__device__ __forceinline__ u32x2_t f32_to_bf4(const f32x4 v) { return (u32x2_t){cvt_pk_bf16(v.x, v.y), cvt_pk_bf16(v.z, v.w)}; }
struct EpiBf16i {
    static constexpr bool PERM = true;
    bf16_t* O; int ldc; const float* rowstep; const float* colstep;
    __device__ __forceinline__ void operator()(const f32x4 (&acc)[2][2][4][2], const Unit& u, int wr, int wc, int fr, int fq) const {
        const int row0 = u.pm * BM + wr * 64 + fr, col0 = u.pn * BM + wc * 32 + 8 * fq;
        f32x4 cs[2][2];
#pragma unroll
        for (int bj = 0; bj < 2; ++bj)
#pragma unroll
            for (int n = 0; n < 2; ++n) cs[bj][n] = *(const f32x4*)(colstep + col0 + bj * HALF + 4 * n);
#pragma unroll
        for (int ai = 0; ai < 2; ++ai)
#pragma unroll
            for (int m = 0; m < 4; ++m) { const int row = row0 + ai * HALF + m * 16; bf16_t* rowp = O + (size_t)row * ldc + col0; const float rs = rowstep[row];
#pragma unroll
                for (int bj = 0; bj < 2; ++bj) { float v[8];
#pragma unroll
                    for (int n = 0; n < 2; ++n)
#pragma unroll
                        for (int j = 0; j < 4; ++j) { const float x = acc[ai][bj][m][n][j]; v[4 * n + j] = (float)__float_as_int(x) * (rs * cs[bj][n][j]); }
                    u32x4 w; w.x = cvt_pk_bf16(v[0], v[1]); w.y = cvt_pk_bf16(v[2], v[3]); w.z = cvt_pk_bf16(v[4], v[5]); w.w = cvt_pk_bf16(v[6], v[7]);
                    *(u32x4*)(rowp + bj * HALF) = w; } }
    }
};
struct EpiSwiGLU8i {
    static constexpr bool PERM = true;
    unsigned char* O; int ldc; const float* rowstep; const float* step1; const float* step3; float oscale;
    __device__ __forceinline__ void operator()(const f32x4 (&acc)[2][2][4][2], const Unit& u, int wr, int wc, int fr, int fq) const {
        const int row0 = u.pm * BM + wr * 64 + fr, col0 = u.pn * HALF + wc * 32 + 8 * fq;
        typedef unsigned u32x2 __attribute__((ext_vector_type(2))); typedef float f2 __attribute__((ext_vector_type(2)));
        f32x4 c1[2], c3[2];
#pragma unroll
        for (int n = 0; n < 2; ++n) { c1[n] = *(const f32x4*)(step1 + col0 + 4 * n) * -1.4426950408889634f; c3[n] = *(const f32x4*)(step3 + col0 + 4 * n) * (oscale * -0.6931471805599453f); }
#pragma unroll
        for (int ai = 0; ai < 2; ++ai)
#pragma unroll
            for (int m = 0; m < 4; ++m) { const int row = row0 + ai * HALF + m * 16; unsigned char* rowp = O + (size_t)row * ldc + col0; const float rs = rowstep[row];
                float h[8];
#pragma unroll
                for (int n = 0; n < 2; ++n)
#pragma unroll
                    for (int j = 0; j < 4; j += 2) { const float x0 = acc[ai][0][m][n][j], x1 = acc[ai][0][m][n][j + 1], y0 = acc[ai][1][m][n][j], y1 = acc[ai][1][m][n][j + 1];
                        const f2 t = (f2){(float)__float_as_int(x0), (float)__float_as_int(x1)} * ((f2){c1[n][j], c1[n][j + 1]} * rs);
                        const f2 b = (f2){(float)__float_as_int(y0), (float)__float_as_int(y1)} * ((f2){c3[n][j], c3[n][j + 1]} * rs);
                        f2 d; d.x = __builtin_amdgcn_exp2f(t.x); d.y = __builtin_amdgcn_exp2f(t.y); d = d + 1.0f;
                        f2 rr; rr.x = __builtin_amdgcn_rcpf(d.x); rr.y = __builtin_amdgcn_rcpf(d.y); const f2 hv = (t * b) * rr;
                        h[4 * n + j] = __builtin_amdgcn_fmed3f(hv.x, -448.0f, 448.0f); h[4 * n + j + 1] = __builtin_amdgcn_fmed3f(hv.y, -448.0f, 448.0f); }
                *(u32x2*)rowp = (u32x2){pk4_fp8_raw(h[0], h[1], h[2], h[3]), pk4_fp8_raw(h[4], h[5], h[6], h[7])}; }
    }
};
struct EpiRes {
    static constexpr bool PERM = true;
    const float* srcL; const float* srcC; bf16_t* xres; const float* gate; float oscale;
    __device__ __forceinline__ void operator()(const f32x4 (&acc)[2][2][4][2], const Unit& u, int wr, int wc, int fr, int fq) const {
        const int pm = u.pm; const bool isc = pm >= 128; const int bidx = isc ? 8 : (pm >> 4);
        const float* s = srcL ? (isc ? srcC + (size_t)(pm - 128) * BM * D : srcL + (size_t)pm * BM * D) : nullptr;
        bf16_t* d = xres + (size_t)pm * BM * D;
        const int col0 = u.pn * BM + wc * 32 + 8 * fq; const float* gv = gate + bidx * MOD6 + col0;
        f32x4 g[2][2];
#pragma unroll
        for (int bj = 0; bj < 2; ++bj)
#pragma unroll
            for (int n = 0; n < 2; ++n) g[bj][n] = *(const f32x4*)(gv + bj * HALF + 4 * n) * oscale;
        if (s) {
#pragma unroll
            for (int am = 0; am < 4; ++am) { const int ai = am >> 1, m0 = (am & 1) * 2; f32x4 x[2][2][2];
#pragma unroll
                for (int mm = 0; mm < 2; ++mm)
#pragma unroll
                    for (int bj = 0; bj < 2; ++bj)
#pragma unroll
                        for (int n = 0; n < 2; ++n) x[mm][bj][n] = *(const f32x4*)(s + (size_t)(wr * 64 + fr + ai * HALF + (m0 + mm) * 16) * D + col0 + bj * HALF + 4 * n);
#pragma unroll
                for (int mm = 0; mm < 2; ++mm)
#pragma unroll
                    for (int bj = 0; bj < 2; ++bj) { const int m = m0 + mm; const u32x2_t p0 = f32_to_bf4(x[mm][bj][0] + g[bj][0] * acc[ai][bj][m][0]), p1 = f32_to_bf4(x[mm][bj][1] + g[bj][1] * acc[ai][bj][m][1]);
                        *(u32x4*)(d + (size_t)(wr * 64 + fr + ai * HALF + m * 16) * D + col0 + bj * HALF) = (u32x4){p0.x, p0.y, p1.x, p1.y}; }
                asm volatile("" ::: "memory"); }
        } else {
#pragma unroll
            for (int ai = 0; ai < 2; ++ai) { u32x4 x[4][2];
#pragma unroll
                for (int m = 0; m < 4; ++m)
#pragma unroll
                    for (int bj = 0; bj < 2; ++bj) x[m][bj] = *(const u32x4*)(d + (size_t)(wr * 64 + fr + ai * HALF + m * 16) * D + col0 + bj * HALF);
#pragma unroll
                for (int m = 0; m < 4; ++m)
#pragma unroll
                    for (int bj = 0; bj < 2; ++bj) { const u32x4 xv = x[m][bj];
                        const u32x2_t p0 = f32_to_bf4(bf4_to_f32((u32x2_t){xv.x, xv.y}) + g[bj][0] * acc[ai][bj][m][0]), p1 = f32_to_bf4(bf4_to_f32((u32x2_t){xv.z, xv.w}) + g[bj][1] * acc[ai][bj][m][1]);
                        *(u32x4*)(d + (size_t)(wr * 64 + fr + ai * HALF + m * 16) * D + col0 + bj * HALF) = (u32x4){p0.x, p0.y, p1.x, p1.y}; }
                asm volatile("" ::: "memory"); }
        }
    }
};
struct EpiScatter {
    static constexpr bool PERM = false;
    const int* ridx; const float* rgate; bf16_t* xres; const float* gate; float oscale;
    __device__ __forceinline__ void operator()(const f32x4 (&acc)[2][2][4][2], const Unit& u, int wr, int wc, int fr, int fq) const {
        const int col0 = u.pn * BM + wc * 32 + 4 * fq;
#pragma unroll
        for (int ai = 0; ai < 2; ++ai)
#pragma unroll
            for (int m = 0; m < 4; ++m) { const int rs = u.pm * BM + wr * 64 + fr + ai * HALF + m * 16; const int tok = ridx[rs];
                if (tok >= 0) { const float gt = rgate[rs] * oscale; const float* gv = gate + (tok >> 12) * MOD6 + col0; bf16_t* d = xres + (size_t)tok * D + col0;
#pragma unroll
                    for (int bj = 0; bj < 2; ++bj)
#pragma unroll
                        for (int n = 0; n < 2; ++n) { const f32x4 g = *(const f32x4*)(gv + bj * HALF + n * 16); const f32x4 x = bf4_to_f32(*(const u32x2_t*)(d + bj * HALF + n * 16));
                            *(u32x2_t*)(d + bj * HALF + n * 16) = f32_to_bf4(x + (g * gt) * acc[ai][bj][m][n]); } }
                asm volatile("" ::: "memory"); }
    }
};

struct MoeOrderRM {
    int nwg, G, c; const char* A; const char* Bt; size_t tstepA, tstepB, estride; const int* texp; int nt0, gap;
    __device__ __forceinline__ bool next(int i, Unit& u) const {
        const int wgid = (G & 7) ? i * G + c : i * G + (c & 7) * (G >> 3) + (c >> 3); if (wgid >= nwg) return false;
        int pm = wgid >> 2; const int pn = wgid & 3; pm = pm < nt0 ? pm : pm + gap;
        const int e = __builtin_amdgcn_readfirstlane(__hip_atomic_load(texp + pm, __ATOMIC_RELAXED, __HIP_MEMORY_SCOPE_AGENT));
        u.pm = __builtin_amdgcn_readfirstlane(pm); u.pn = __builtin_amdgcn_readfirstlane(pn); u.a = uptr(A + (size_t)u.pm * tstepA); u.b = uptr(Bt + (size_t)e * estride + (size_t)u.pn * tstepB); u.ridx = nullptr; return true; }
};
typedef unsigned u32x4_t __attribute__((ext_vector_type(4)));
struct EpiY {
    static constexpr bool PERM = true;
    const float* rgate; bf16_t* y0; bf16_t* y1a; bf16_t* y1b; float oscale; int t1, psplit;
    __device__ __forceinline__ void operator()(const f32x4 (&acc)[2][2][4][2], const Unit& u, int wr, int wc, int fr, int fq) const {
        const int col0 = u.pn * BM + wc * 32 + 8 * fq; const bool s1 = u.pm >= t1; const int p = s1 ? u.pm - t1 : u.pm;
        bf16_t* base = (s1 ? (p < psplit ? y1a + (size_t)p * BM * D : y1b + (size_t)(p - psplit) * BM * D) : y0 + (size_t)p * BM * D) + col0;
        float gt[2][4];
#pragma unroll
        for (int ai = 0; ai < 2; ++ai)
#pragma unroll
            for (int m = 0; m < 4; ++m) gt[ai][m] = rgate[u.pm * BM + wr * 64 + fr + ai * HALF + m * 16] * oscale;
#pragma unroll
        for (int ai = 0; ai < 2; ++ai)
#pragma unroll
            for (int m = 0; m < 4; ++m) { bf16_t* d = base + (size_t)(wr * 64 + fr + ai * HALF + m * 16) * D;
#pragma unroll
                for (int bj = 0; bj < 2; ++bj) { const u32x2_t p0 = f32_to_bf4(acc[ai][bj][m][0] * gt[ai][m]), p1 = f32_to_bf4(acc[ai][bj][m][1] * gt[ai][m]);
                    *(u32x4_t*)(d + bj * HALF) = (u32x4_t){p0.x, p0.y, p1.x, p1.y}; } }
    }
};

template <class Epi, class Sched, bool ALIGN_EPI, bool GATHER, int MODE = 0  >
__device__ __forceinline__ void gemm_phase(PG8_LAS unsigned char* lds, const int K, const Sched& S, const Epi& E) {
    constexpr bool FP8 = (MODE == 1);
    const int wid = __builtin_amdgcn_readfirstlane((int)threadIdx.x >> 6), lane = (int)__builtin_amdgcn_mbcnt_hi(~0u, __builtin_amdgcn_mbcnt_lo(~0u, 0u)), tid = wid * 64 + lane, wr = wid >> 2, wc = wid & 3, fr = lane & 15, fq = lane >> 4;
    const int nt = K / BK;
    unsigned voffA[2], voffB[2];
#pragma unroll
    for (int i = 0; i < 2; ++i) { int R, C; stage_rc(tid * 16 + i * 8192, R, C); const int Rb = Epi::PERM ? ((R & ~31) + perm32(R & 31)) : R;
        voffA[i] = (unsigned)(R * K + C) * 2u; voffB[i] = (unsigned)(Rb * K + C) * 2u; }
    const size_t kstep = (size_t)(BK * 2);
    const size_t hstep = (size_t)HALF * K * 2;
    const unsigned ldsw = (unsigned)wid * 1024u;
    const unsigned ldsb = __builtin_amdgcn_readfirstlane((unsigned)(size_t)lds + ldsw);
    const int aoff = lds_byte(wr * 64 + fr, fq * 8), boff = lds_byte(wc * 32 + fr, fq * 8);
    unsigned vAc[2][2], vAn[2][2];
#define PG8_SA(b, h) (((b) * 2 + (h)) * HTB)
#define PG8_SB(b, h) ((4 + (b) * 2 + (h)) * HTB)
#define PG8_STAGE(bufoff, gbase, voff) do { const char* _g = uptr((const char*)(gbase)); _Pragma("unroll") for (int _i = 0; _i < 2; ++_i) \
        glds_s(_g, (voff)[_i], ldsb + (unsigned)((bufoff) + _i * 8192)); } while (0)
#define PG8_STAGE_A(bufoff, NXT, kb, h) do { if constexpr (GATHER) { const char* _ga = uptr(gA + (kb)); _Pragma("unroll") for (int _i = 0; _i < 2; ++_i) { const unsigned _v = (NXT) ? vAn[h][_i] : vAc[h][_i]; \
        glds_s(_ga, _v, ldsb + (unsigned)((bufoff) + _i * 8192)); } } \
        else { const char* _b = ((NXT) ? nA : cA) + (kb) + (h) * hstep; PG8_STAGE(bufoff, _b, voffA); } } while (0)
#define PG8_LDA(dst, b, h) do { if constexpr (FP8) { _Pragma("unroll") for (int m = 0; m < 4; ++m) dst##8[m] = cat8(*(const PG8_LAS bf16x8*)(lds + PG8_SA(b, h) + aoff + m * 2048), *(const PG8_LAS bf16x8*)(lds + PG8_SA(b, h) + aoff + m * 2048 + 1024)); } \
        else { _Pragma("unroll") for (int m = 0; m < 4; ++m) _Pragma("unroll") for (int k = 0; k < 2; ++k) dst[m][k] = *(const PG8_LAS bf16x8*)(lds + PG8_SA(b, h) + aoff + m * 2048 + k * 1024); } } while (0)
#define PG8_LDB(dst, b, h) do { if constexpr (FP8) { _Pragma("unroll") for (int n = 0; n < 2; ++n) dst##8[n] = cat8(*(const PG8_LAS bf16x8*)(lds + PG8_SB(b, h) + boff + n * 2048), *(const PG8_LAS bf16x8*)(lds + PG8_SB(b, h) + boff + n * 2048 + 1024)); } \
        else { _Pragma("unroll") for (int n = 0; n < 2; ++n) _Pragma("unroll") for (int k = 0; k < 2; ++k) dst[n][k] = *(const PG8_LAS bf16x8*)(lds + PG8_SB(b, h) + boff + n * 2048 + k * 1024); } } while (0)
#define PG8_MMA(ai, bj, At, Bt) do { __builtin_amdgcn_s_setprio(1); if constexpr (FP8) { _Pragma("unroll") for (int m = 0; m < 4; ++m) _Pragma("unroll") for (int n = 0; n < 2; ++n) \
        mfma8(acc[ai][bj][m][n], Bt##8[n], At##8[m], sc127); } \
        else if constexpr (MODE == 2) { _Pragma("unroll") for (int m = 0; m < 4; ++m) _Pragma("unroll") for (int n = 0; n < 2; ++n) _Pragma("unroll") for (int k = 0; k < 2; ++k) \
        acc[ai][bj][m][n] = __builtin_bit_cast(f32x4, __builtin_amdgcn_mfma_i32_16x16x64_i8(__builtin_bit_cast(v4i_t, Bt[n][k]), __builtin_bit_cast(v4i_t, At[m][k]), __builtin_bit_cast(v4i_t, acc[ai][bj][m][n]), 0, 0, 0)); } \
        else { _Pragma("unroll") for (int m = 0; m < 4; ++m) _Pragma("unroll") for (int n = 0; n < 2; ++n) _Pragma("unroll") for (int k = 0; k < 2; ++k) \
        acc[ai][bj][m][n] = __builtin_amdgcn_mfma_f32_16x16x32_bf16(Bt[n][k], At[m][k], acc[ai][bj][m][n], 0, 0, 0); } __builtin_amdgcn_s_setprio(0); } while (0)
#define PG8_WAIT_V(n) asm volatile("s_waitcnt vmcnt(" #n ")" ::: "memory")
#define PG8_WAIT_L(n) asm volatile("s_waitcnt lgkmcnt(" #n ")" ::: "memory")
#define PG8_BAR __builtin_amdgcn_s_barrier()
#define PG8_SCHED __builtin_amdgcn_sched_barrier(0)
#define PG8_GOFF(dst, un) do { _Pragma("unroll") for (int _i = 0; _i < 2; ++_i) { int _R, _C; stage_rc(tid * 16 + _i * 8192, _R, _C); _Pragma("unroll") for (int _h = 0; _h < 2; ++_h) { int _r = (un).ridx[_h * HALF + _R]; _r = _r < 0 ? 0 : _r; \
        dst[_h][_i] = (unsigned)(_r * K + _C) * 2u; } } } while (0)
    Unit cur, nxt; int ui = 0;
    if (!S.next(0, cur)) return;
    f32x4 acc[2][2][4][2];
#pragma unroll
    for (int a = 0; a < 2; ++a)
#pragma unroll
        for (int b = 0; b < 2; ++b)
#pragma unroll
            for (int m = 0; m < 4; ++m)
#pragma unroll
                for (int n = 0; n < 2; ++n) acc[a][b][m][n] = (f32x4){0.f, 0.f, 0.f, 0.f};
    int sc127 = 127; if constexpr (FP8) asm volatile("" : "+v"(sc127));
    bf16x8 At[4][2], B0[2][2], B1[2][2]; v8i_t At8[4], B08[2], B18[2];
    const char* gA = cur.a;
    const char* cA = cur.a; const char* cB = cur.b;
    if constexpr (GATHER) { PG8_GOFF(vAc, cur); }
    {   const char* nA = cA;
        PG8_STAGE(PG8_SB(0, 0), cB, voffB); PG8_STAGE(PG8_SB(0, 1), cB + hstep, voffB); PG8_STAGE_A(PG8_SA(0, 0), false, 0, 0); PG8_STAGE_A(PG8_SA(0, 1), false, 0, 1);
        if (wr == 1) PG8_BAR;
        PG8_WAIT_V(2); PG8_BAR;
        PG8_STAGE(PG8_SB(1, 0), cB + kstep, voffB); PG8_STAGE_A(PG8_SA(1, 0), false, kstep, 0); PG8_STAGE(PG8_SB(1, 1), cB + hstep + kstep, voffB);
        PG8_WAIT_V(6); PG8_BAR; }
    for (;;) {
        const bool has_next = S.next(ui + 1, nxt);
        const char* nA = has_next ? nxt.a : cA; const char* nB = has_next ? nxt.b : cB;
        if constexpr (GATHER) { if (has_next) { PG8_GOFF(vAn, nxt); } else {
#pragma unroll
            for (int h = 0; h < 2; ++h)
#pragma unroll
                for (int i = 0; i < 2; ++i) vAn[h][i] = vAc[h][i]; } }
#pragma unroll 1
        for (int t = 0; t < nt; t += 2) {
            const bool last = (t == nt - 2);
            const size_t kb1 = (size_t)(t + 1) * kstep;
            const size_t kb2 = last ? 0 : (size_t)(t + 2) * kstep, kb3 = kb2 + kstep;
            const char* b2 = last ? nB : cB + (size_t)(t + 2) * kstep; const char* b3 = b2 + kstep;
            PG8_LDB(B0, 0, 0); PG8_LDB(B1, 0, 1); PG8_SCHED; PG8_LDA(At, 0, 0); PG8_STAGE_A(PG8_SA(1, 1), false, kb1, 1);
            PG8_WAIT_V(8); PG8_WAIT_L(0); PG8_BAR; PG8_MMA(0, 0, At, B0); PG8_MMA(0, 1, At, B1); PG8_BAR; PG8_SCHED;
            PG8_LDA(At, 0, 1); PG8_STAGE(PG8_SB(0, 0), b2, voffB); PG8_STAGE(PG8_SB(0, 1), b2 + hstep, voffB); PG8_STAGE_A(PG8_SA(0, 0), last, kb2, 0);
            PG8_WAIT_V(8); PG8_WAIT_L(0); PG8_BAR; PG8_MMA(1, 0, At, B0); PG8_MMA(1, 1, At, B1); PG8_BAR; PG8_SCHED;
            PG8_LDB(B0, 1, 0); PG8_LDB(B1, 1, 1); PG8_SCHED; PG8_LDA(At, 1, 0); PG8_STAGE_A(PG8_SA(0, 1), last, kb2, 1);
            PG8_WAIT_V(8); PG8_WAIT_L(0); PG8_BAR; PG8_MMA(0, 0, At, B0); PG8_MMA(0, 1, At, B1); PG8_BAR; PG8_SCHED;
            PG8_LDA(At, 1, 1); PG8_STAGE(PG8_SB(1, 0), b3, voffB); PG8_STAGE(PG8_SB(1, 1), b3 + hstep, voffB); PG8_STAGE_A(PG8_SA(1, 0), last, kb3, 0);
            PG8_WAIT_V(8); PG8_WAIT_L(0); PG8_BAR; PG8_MMA(1, 0, At, B0); PG8_MMA(1, 1, At, B1); PG8_BAR; PG8_SCHED;
        }
        if constexpr (ALIGN_EPI) { if (wr == 0) PG8_BAR; }
        if constexpr (FP8) asm volatile("s_nop 15\n\ts_nop 15" ::: "memory");
        { int efr = fr, efq = fq; asm volatile("" : "+v"(efr), "+v"(efq));
          E(acc, cur, wr, wc, efr, efq); }
        if (!has_next) break;
#pragma unroll
        for (int a = 0; a < 2; ++a)
#pragma unroll
            for (int b = 0; b < 2; ++b)
#pragma unroll
                for (int m = 0; m < 4; ++m)
#pragma unroll
                    for (int n = 0; n < 2; ++n) acc[a][b][m][n] = (f32x4){0.f, 0.f, 0.f, 0.f};
        cur = nxt; cA = nA; cB = nB; ++ui;
        if constexpr (GATHER) {
#pragma unroll
            for (int h = 0; h < 2; ++h)
#pragma unroll
                for (int i = 0; i < 2; ++i) vAc[h][i] = vAn[h][i]; }
        if constexpr (ALIGN_EPI) { if (wr == 1) PG8_BAR; }
    }
    PG8_WAIT_V(0);
    if constexpr (!ALIGN_EPI) { if (wr == 0) PG8_BAR; }
    PG8_BAR;
#undef PG8_SA
#undef PG8_SB
#undef PG8_STAGE
#undef PG8_STAGE_A
#undef PG8_LDA
#undef PG8_LDB
#undef PG8_MMA
#undef PG8_WAIT_V
#undef PG8_WAIT_L
#undef PG8_BAR
#undef PG8_SCHED
#undef PG8_GOFF
}
}

constexpr int NWAVES = 8, NTHR = NWAVES * 64;
constexpr size_t MiB = 1u << 20;
constexpr int RT_TILES_C = 136;
constexpr size_t WS_CTL = 0, CTL_ZERO_BYTES = 1 * MiB;
constexpr size_t WS_MODP = 1 * MiB;
constexpr size_t WS_MODV = 5 * MiB;
constexpr size_t WS_ROUTE = 6 * MiB;
constexpr size_t WS_WIN = 8 * MiB;
constexpr size_t WS_WOUT = 17 * MiB;
constexpr size_t WS_W13 = 21 * MiB;
constexpr size_t WS_W2 = 32 * MiB;
constexpr size_t WS_MW13 = 38 * MiB;
constexpr size_t WS_MW2 = 94 * MiB;
constexpr size_t WS_CTXRES = 122 * MiB;
constexpr size_t WS_HBUF = 130 * MiB;
constexpr size_t WS_PBUF = 198 * MiB;
constexpr size_t WS_MIX = 351 * MiB;
constexpr size_t WS_XRES = 419 * MiB;
constexpr size_t WS_SLOC = 487 * MiB;
constexpr size_t WS_DTOT = 521 * MiB;
constexpr size_t WS_HID = 198 * MiB;
constexpr size_t WS_HID2 = 164 * MiB;
constexpr size_t WS_ZBUF = WS_HBUF;
constexpr size_t WS_XBC = WS_HBUF + 64 * MiB;
constexpr size_t WS_END = 522 * MiB;
static_assert(WS_HID + (size_t)MT * EFF <= WS_XRES && WS_HID + (size_t)MT * DFF * 2 <= WS_XRES && WS_MIX + (size_t)MT * D * 2 <= WS_XRES && WS_PBUF + (size_t)MT * INP * 2 <= WS_MIX && WS_HBUF + (size_t)MT * D * 2 <= WS_PBUF, "ws map");
static_assert(WS_HID2 + (size_t)2 * RT_TILES_C * 256 * EFF <= WS_XRES && WS_HBUF + (size_t)NL * D <= WS_HID2, "MoE hidden");
static_assert(WS_XRES + (size_t)MT * D * 2 <= WS_SLOC && (size_t)MT * 512 * 4 <= (size_t)NL * D * 4 && WS_SLOC + (size_t)64 * 17 * 8192 * 4 <= WS_DTOT && WS_DTOT + (size_t)64 * 17 * 64 * 4 <= WS_END, "GLA scratch");
static_assert(WS_MW2 + (size_t)NE * D * EFF <= WS_CTXRES && WS_MW13 + (size_t)NE * 2 * EFF * D <= WS_MW2 && WS_W13 + (size_t)2 * DFF * D * 2 <= WS_W2 && WS_W2 + (size_t)D * DFF * 2 <= WS_MW13 && WS_CTXRES + (size_t)NC * D * 4 <= WS_HBUF, "ws map 2");
constexpr int RT_TILES = 136;
constexpr size_t RT_TOKE = 0;
constexpr size_t RT_TOKG = 262144;
constexpr size_t RT_RIDX = 524288;
constexpr size_t RT_RGATE = RT_RIDX + 2 * RT_TILES * 256 * 4;
constexpr size_t RT_TEXP = RT_RGATE + 2 * RT_TILES * 256 * 4;
constexpr size_t RT_NT = RT_TEXP + 2 * RT_TILES * 4;
constexpr size_t WS_WCS = WS_ROUTE + 1536 * 1024;
constexpr int WCS_IN = 0, WCS_W1 = 2 * 2304, WCS_W3 = 2 * 2304 + 2816;
constexpr size_t RT_POS = 1664 * 1024;
constexpr size_t WS_RS = WS_ROUTE + 1280 * 1024;
static_assert(RT_NT + 1024 <= 2 * MiB, "route tables");
constexpr int CW_BAR = 4096, CW_Q = 8192, CW_CONVQ = 12288, CW_WABS = 12800, CW_DONE0 = 16384, CW_FINQ = 16448, CW_DONE1 = 16512;
constexpr size_t WS_Y0 = 8 * MiB;
constexpr int Y1_SPLIT = 68;
static_assert((size_t)Y1_SPLIT * 256 * 1024 * 2 <= 34 * MiB && WS_Y0 + (size_t)136 * 256 * 1024 * 2 <= 94 * MiB, "MoE down product buffers");
#define MDN_MERGE 1
constexpr int RING_BYTES = 131072, LDS_BYTES = 163840, LDSCTL_OFF = LDS_BYTES - 1024, MISC_OFF = LDSCTL_OFF + 320;

#define GAS __attribute__((address_space(1)))
#define LAS __attribute__((address_space(3)))
typedef unsigned short bf16;
typedef unsigned v4u __attribute__((ext_vector_type(4)));
typedef unsigned v2u __attribute__((ext_vector_type(2)));
typedef float f32x4 __attribute__((ext_vector_type(4)));
typedef float f32x2 __attribute__((ext_vector_type(2)));
#define LDS_WAIT() asm volatile("s_waitcnt lgkmcnt(0)" ::: "memory")
__device__ __forceinline__ unsigned f2bf(float f) { unsigned u = __builtin_bit_cast(unsigned, f); return (u + 0x7fffu + ((u >> 16) & 1u)) >> 16; }
__device__ __forceinline__ unsigned pk2(float lo, float hi) { return f2bf(lo) | (f2bf(hi) << 16); }
__device__ __forceinline__ float bf2f(unsigned b) { return __builtin_bit_cast(float, b << 16); }
__device__ __forceinline__ float bflo(unsigned w) { return __builtin_bit_cast(float, w << 16); }
__device__ __forceinline__ float bfhi(unsigned w) { return __builtin_bit_cast(float, w & 0xffff0000u); }
typedef short bf16x8 __attribute__((ext_vector_type(8)));
typedef float f32x16 __attribute__((ext_vector_type(16)));
typedef __bf16 bf16x2_t __attribute__((ext_vector_type(2)));
__device__ __forceinline__ unsigned cvtpk(float lo, float hi) { const f32x2 v = {lo, hi}; return __builtin_bit_cast(unsigned, __builtin_convertvector(v, bf16x2_t)); }
__device__ __forceinline__ bf16 bf1(float x) { return (bf16)(cvtpk(x, x) & 0xffffu); }
__device__ __forceinline__ float silu_fast(float a) { return a * __builtin_amdgcn_rcpf(1.0f + __builtin_amdgcn_exp2f(a * -1.4426950408889634f)); }
__device__ __forceinline__ float cosrev(float f) { return __builtin_amdgcn_cosf(f); }
__device__ __forceinline__ float sinrev(float f) { return __builtin_amdgcn_sinf(f); }
__device__ __forceinline__ int crow32(int reg, int h) { return (reg & 3) + 8 * (reg >> 2) + 4 * h; }
#define MFMA32(a, b, c) __builtin_amdgcn_mfma_f32_32x32x16_bf16((a), (b), (c), 0, 0, 0)

#define XB_TMO      128
#define XB_XCNT(j)  (256  + 64 * (j))
#define XB_XSUB(j)  (1280 + 64 * (j))
#define XB_XGEN(j)  (2304 + 64 * (j))
#define XB_TOP      3328
#define XB_TOPGEN   3392
#define XCD_BAR_WORDS 3456
#define XB_SPIN_CAP (1u << 20)
__device__ __forceinline__ unsigned xb_ld(unsigned* p)              { return __hip_atomic_load(p, __ATOMIC_RELAXED, __HIP_MEMORY_SCOPE_AGENT); }
__device__ __forceinline__ unsigned xb_add(unsigned* p, unsigned v) { return __hip_atomic_fetch_add(p, v, __ATOMIC_RELAXED, __HIP_MEMORY_SCOPE_AGENT); }
__device__ __forceinline__ unsigned xb_xcc_id() { return (unsigned)__builtin_amdgcn_s_getreg((3 << 11) | 20) & 0xFu; }
#define XB_SPIN(cond, bar) do { unsigned _sp = 0; while (cond) { __builtin_amdgcn_s_sleep(1); \
    if ((++_sp & 255u) == 0u) { if (xb_ld(&(bar)[XB_TMO])) break; if (_sp > XB_SPIN_CAP) { atomicAdd(&(bar)[XB_TMO], 1u); break; } } } } while (0)
struct XcdBarrier { unsigned* bar; unsigned x; volatile LAS unsigned* st; };
__device__ __forceinline__ XcdBarrier xcd_barrier_post(unsigned* bar, volatile LAS unsigned* st) {
    XcdBarrier b; b.bar = bar; b.x = xb_xcc_id(); b.st = st;
    if (threadIdx.x == 0) (void)xb_add(&bar[XB_XCNT(b.x)], 1u);
    return b;
}
__device__ __forceinline__ void xcd_barrier_complete(unsigned* bar, unsigned x, unsigned& nloc, unsigned& nx) {
    const unsigned G = gridDim.x * gridDim.y * gridDim.z;
    unsigned sum, cnt, mine, sp = 0u;
    for (;;) {
        sum = 0u; cnt = 0u; mine = 0u;
#pragma unroll
        for (unsigned j = 0; j < 16; ++j) { const unsigned c = xb_ld(&bar[XB_XCNT(j)]); sum += c; cnt += (c > 0u) ? 1u : 0u; mine = (j == x) ? c : mine; }
        if (sum == G) break;
        __builtin_amdgcn_s_sleep(1);
        if ((++sp & 255u) == 0u) { if (xb_ld(&bar[XB_TMO])) break; if (sp > XB_SPIN_CAP) { atomicAdd(&bar[XB_TMO], 1u); break; } }
    }
    nloc = mine > 0u ? mine : 1u; nx = cnt > 0u ? cnt : 1u;
}
__device__ __forceinline__ void xcd_barrier(const XcdBarrier& b) {
    asm volatile("s_waitcnt vmcnt(0)" ::: "memory");
    __syncthreads();
    if (threadIdx.x == 0) {
        unsigned* bar = b.bar;
        __builtin_amdgcn_s_waitcnt(0);
        unsigned nloc = b.st[0], nx = b.st[1];
        if (nloc == 0u) { xcd_barrier_complete(bar, b.x, nloc, nx); b.st[0] = nloc; b.st[1] = nx; }
        const unsigned old = xb_add(&bar[XB_XSUB(b.x)], 1u);
        const unsigned gen = old / nloc;
        if (old + 1u == (gen + 1u) * nloc) {
            __builtin_amdgcn_fence(__ATOMIC_RELEASE, "agent");
            asm volatile("s_waitcnt vmcnt(0)" ::: "memory");
            const unsigned og = xb_add(&bar[XB_TOP], 1u);
            const unsigned tg = og / nx;
            if (og + 1u == (tg + 1u) * nx) xb_add(&bar[XB_TOPGEN], 1u);
            else XB_SPIN(xb_ld(&bar[XB_TOPGEN]) == tg, bar);
            __builtin_amdgcn_fence(__ATOMIC_ACQUIRE, "agent");
            xb_add(&bar[XB_XGEN(b.x)], 1u);
            asm volatile("s_waitcnt vmcnt(0)" ::: "memory");
        } else {
            XB_SPIN(xb_ld(&bar[XB_XGEN(b.x)]) == gen, bar);
            __builtin_amdgcn_fence(__ATOMIC_ACQUIRE, "agent");
            asm volatile("s_waitcnt vmcnt(0)" ::: "memory");
        }
    }
    __syncthreads();
}

struct Args { const float* in[23]; float* out; unsigned char* ws; int ph_lo, ph_hi, li, pad; };

__device__ __forceinline__ float wave_sum(float v) {
#pragma unroll
    for (int o = 1; o < 64; o <<= 1) v += __shfl_xor(v, o);
    return v;
}

__device__ __forceinline__ void transpose_item(const float* W, int K, int N, bf16* WT, int row_off, int mode, LAS float* scr, int item, int lane) {
    const int nblk = N / 32, kb = item / nblk, nb = item % nblk, k0 = 64 * kb, n0 = 32 * nb;
    { float tv[32];
#pragma unroll
      for (int i = 0; i < 32; ++i) tv[i] = W[(size_t)(k0 + 2 * i + (lane >> 5)) * N + n0 + (lane & 31)];
#pragma unroll
      for (int i = 0; i < 32; ++i) scr[(2 * i + (lane >> 5)) * 33 + (lane & 31)] = tv[i]; }
    LDS_WAIT(); asm volatile("" ::: "memory");
    const int r0 = mode == 0 ? row_off + n0 : row_off + (n0 >> 7) * 256 + (n0 & 127) + (mode == 2 ? 128 : 0);
    const int c = lane & 7;
#pragma unroll
    for (int j = 0; j < 4; ++j) { const int n = (lane >> 3) + 8 * j; const LAS float* s = scr + (8 * c) * 33 + n;
        v4u o; o.x = cvtpk(s[0 * 33], s[1 * 33]); o.y = cvtpk(s[2 * 33], s[3 * 33]); o.z = cvtpk(s[4 * 33], s[5 * 33]); o.w = cvtpk(s[6 * 33], s[7 * 33]);
        *(GAS v4u*)(WT + (size_t)(r0 + n) * K + k0 + 8 * c) = o; }
    LDS_WAIT(); asm volatile("" ::: "memory");
}

__device__ __forceinline__ void transpose_item8(const float* W, int K, int N, unsigned char* WT, int row_off, int mode, float sc, LAS float* scr, int item, int lane) {
    const int nblk = N / 32, kb = item / nblk, nb = item % nblk, k0 = 64 * kb, n0 = 32 * nb;
    { float tv[32];
#pragma unroll
      for (int i = 0; i < 32; ++i) tv[i] = W[(size_t)(k0 + 2 * i + (lane >> 5)) * N + n0 + (lane & 31)];
#pragma unroll
      for (int i = 0; i < 32; ++i) scr[(2 * i + (lane >> 5)) * 33 + (lane & 31)] = tv[i]; }
    LDS_WAIT(); asm volatile("" ::: "memory");
    const int r0 = mode == 0 ? row_off + n0 : row_off + (n0 >> 7) * 256 + (n0 & 127) + (mode == 2 ? 128 : 0);
    const int c = lane & 7;
#pragma unroll
    for (int j = 0; j < 4; ++j) { const int n = (lane >> 3) + 8 * j; const LAS float* s = scr + (8 * c) * 33 + n;
        v2u o; o.x = pg8::pk4_fp8(s[0 * 33] * sc, s[1 * 33] * sc, s[2 * 33] * sc, s[3 * 33] * sc); o.y = pg8::pk4_fp8(s[4 * 33] * sc, s[5 * 33] * sc, s[6 * 33] * sc, s[7 * 33] * sc);
        *(GAS v2u*)(WT + (size_t)(r0 + n) * K + k0 + 8 * c) = o; }
    LDS_WAIT(); asm volatile("" ::: "memory");
}

__device__ __forceinline__ unsigned pk4_i8(float a, float b, float c, float d) {
    const int ia = (int)__builtin_rintf(__builtin_amdgcn_fmed3f(a, -127.f, 127.f)), ib = (int)__builtin_rintf(__builtin_amdgcn_fmed3f(b, -127.f, 127.f)), ic = (int)__builtin_rintf(__builtin_amdgcn_fmed3f(c, -127.f, 127.f)), id = (int)__builtin_rintf(__builtin_amdgcn_fmed3f(d, -127.f, 127.f));
    return (unsigned)(ia & 0xff) | ((unsigned)(ib & 0xff) << 8) | ((unsigned)(ic & 0xff) << 16) | ((unsigned)id << 24); }
__device__ __forceinline__ void transpose_item_i8(const float* W, int K, int N, unsigned char* WT, int row_off, int mode, const float* steps, LAS float* scr, int item, int lane) {
    const int nblk = N / 32, kb = item / nblk, nb = item % nblk, k0 = 64 * kb, n0 = 32 * nb;
    { float tv[32];
#pragma unroll
      for (int i = 0; i < 32; ++i) tv[i] = W[(size_t)(k0 + 2 * i + (lane >> 5)) * N + n0 + (lane & 31)];
#pragma unroll
      for (int i = 0; i < 32; ++i) scr[(2 * i + (lane >> 5)) * 33 + (lane & 31)] = tv[i]; }
    LDS_WAIT(); asm volatile("" ::: "memory");
    const int r0 = mode == 0 ? row_off + n0 : row_off + (n0 >> 7) * 256 + (n0 & 127) + (mode == 2 ? 128 : 0);
    const int c = lane & 7;
#pragma unroll
    for (int j = 0; j < 4; ++j) { const int n = (lane >> 3) + 8 * j; const LAS float* s = scr + (8 * c) * 33 + n; const float st = steps[n0 + n], sc = st > 0.f ? 1.0f / st : 0.f;
        v2u o; o.x = pk4_i8(s[0 * 33] * sc, s[1 * 33] * sc, s[2 * 33] * sc, s[3 * 33] * sc); o.y = pk4_i8(s[4 * 33] * sc, s[5 * 33] * sc, s[6 * 33] * sc, s[7 * 33] * sc);
        *(GAS v2u*)(WT + (size_t)(r0 + n) * K + k0 + 8 * c) = o; }
    LDS_WAIT(); asm volatile("" ::: "memory");
}
__device__ __forceinline__ void colmax_item(const float* W, int K, int N, float* steps, int blk, LAS float* red, int wave, int lane) {
    const int n = blk * 64 + lane; float m = 0.f;
    if (n < N) { const float* p = W + (size_t)(wave * (K / 8)) * N + n;
#pragma unroll 1
        for (int k0 = 0; k0 < K / 8; k0 += 32) { float tv[32];
#pragma unroll
            for (int k = 0; k < 32; ++k) tv[k] = p[(size_t)(k0 + k) * N];
#pragma unroll
            for (int k = 0; k < 32; ++k) m = fmaxf(m, fabsf(tv[k])); } }
    red[wave * 64 + lane] = m;
    __syncthreads();
    if (wave == 0) { float mm = m;
#pragma unroll
        for (int q = 1; q < 8; ++q) mm = fmaxf(mm, red[q * 64 + lane]);
        if (n < N) steps[n] = mm * (1.0f / 127.0f); }
    __syncthreads();
}
__device__ __forceinline__ void absmax_pass(const float* W, size_t n4, unsigned* dst, int gtid, int gthreads, int lane) {
    float m = 0.f;
    for (size_t i = gtid; i < n4; i += gthreads) { const f32x4 v = ((const f32x4*)W)[i]; m = fmaxf(fmaxf(fmaxf(fabsf(v.x), fabsf(v.y)), fmaxf(fabsf(v.z), fabsf(v.w))), m); }
#pragma unroll
    for (int o = 1; o < 64; o <<= 1) m = fmaxf(m, __shfl_xor(m, o));
    if (lane == 0) atomicMax(dst, __float_as_uint(m));
}

struct Wg { LAS unsigned char* lds; int tid, lane, wave, G, bx, gw, NGW; };
#define WS_PTR(T, off) ((T*)(a.ws + (off)))
__device__ __forceinline__ void conv_in_tail(const Args& a, const Wg& w, const int nunits, const int quota);

__device__ __forceinline__ void ph_prologue(const Args& a, const Wg& w) {
    const int tid = w.tid, lane = w.lane, wave = w.wave;
    const float* c_in = a.in[1]; const float* cctx_in = a.in[3]; const float* w_mod = a.in[4];
    const float* w_in = a.in[8]; const float* w_out = a.in[14]; const float* ffn_w1 = a.in[15]; const float* ffn_w3 = a.in[16]; const float* ffn_w2 = a.in[17];
    float* MODP = WS_PTR(float, WS_MODP); bf16* WIN = WS_PTR(bf16, WS_WIN); bf16* WOUT = WS_PTR(bf16, WS_WOUT); bf16* W13 = WS_PTR(bf16, WS_W13); bf16* W2 = WS_PTR(bf16, WS_W2);
    LAS float* scr = (LAS float*)(w.lds + wave * 8448);
    LAS float* sil = (LAS float*)(w.lds + 69632);
    for (int i = tid; i < 9 * D; i += NTHR) { const float v = i < 8 * D ? c_in[i] : cctx_in[i - 8 * D]; sil[i] = v / (1.0f + __expf(-v)); }
    __syncthreads();
    constexpr int I_IN = 16 * 65, I_OUT = 16 * 32, I_F13 = 16 * 88, I_F2 = 44 * 32, I_MOD = 2 * 8 * 96;
    constexpr int NITEMS = I_MOD + 2 * I_IN + 2 * I_OUT + 2 * I_F13 + I_F2;
    for (int it = w.gw; it < NITEMS; it += w.NGW) {
        int r = it;
        if (r < I_MOD) {
            const int l = r / 768, kc = (r % 768) / 96, nb = r % 96, n = nb * 64 + lane;
            float acc[9];
#pragma unroll
            for (int b = 0; b < 9; ++b) acc[b] = 0.f;
            const float* wp = w_mod + ((size_t)l * D + kc * 128) * MOD6 + n;
#pragma unroll 1
            for (int k0 = 0; k0 < 128; k0 += 32) { float wv[32];
#pragma unroll
                for (int k = 0; k < 32; ++k) wv[k] = wp[(size_t)(k0 + k) * MOD6];
#pragma unroll
                for (int k = 0; k < 32; ++k)
#pragma unroll
                    for (int b = 0; b < 9; ++b) acc[b] += sil[b * D + kc * 128 + k0 + k] * wv[k]; }
#pragma unroll
            for (int b = 0; b < 9; ++b) MODP[(((size_t)l * 8 + kc) * 9 + b) * MOD6 + n] = acc[b];
            continue; }
        r -= I_MOD;
        if (r < 2 * I_IN) { const int l = r / I_IN; if (!I8_GIN) transpose_item(w_in + (size_t)l * D * INW, D, INW, WIN + (size_t)l * INP * D, 0, 0, scr, r % I_IN, lane); continue; } r -= 2 * I_IN;
        if (r < 2 * I_OUT) { const int l = r / I_OUT; transpose_item(w_out + (size_t)l * D * D, D, D, WOUT + (size_t)l * D * D, 0, 0, scr, r % I_OUT, lane); continue; } r -= 2 * I_OUT;
        if (r < I_F13) { if (I8_FUP) {} else if (FP8_FUP) transpose_item8(ffn_w1, D, DFF, (unsigned char*)W13, 0, 1, FP8_SW, scr, r, lane); else transpose_item(ffn_w1, D, DFF, W13, 0, 1, scr, r, lane); continue; } r -= I_F13;
        if (r < I_F13) { if (I8_FUP) {} else if (FP8_FUP) transpose_item8(ffn_w3, D, DFF, (unsigned char*)W13, 0, 2, FP8_SW, scr, r, lane); else transpose_item(ffn_w3, D, DFF, W13, 0, 2, scr, r, lane); continue; } r -= I_F13;
        if (FP8_FDN) transpose_item8(ffn_w2, DFF, D, (unsigned char*)W2, 0, 0, FP8_SW, scr, r, lane); else transpose_item(ffn_w2, DFF, D, W2, 0, 0, scr, r, lane);
    }
    {
        float* WCS = WS_PTR(float, WS_WCS); LAS float* red = (LAS float*)(w.lds + 110 * 1024);
        constexpr int B_IN = (INW + 63) / 64, B_F = DFF / 64, NB = (I8_GIN ? 2 * B_IN : 0) + (I8_FUP ? 2 * B_F : 0);
        __syncthreads();
        for (int it = w.bx; it < NB; it += w.G) { int r = it;
            if (I8_GIN) { if (r < 2 * B_IN) { const int l = r / B_IN; colmax_item(w_in + (size_t)l * D * INW, D, INW, WCS + WCS_IN + l * 2304, r % B_IN, red, wave, lane); continue; } r -= 2 * B_IN; }
            if (r < B_F) colmax_item(ffn_w1, D, DFF, WCS + WCS_W1, r, red, wave, lane); else colmax_item(ffn_w3, D, DFF, WCS + WCS_W3, r - B_F, red, wave, lane); }
        if (I8_GIN) for (int i = w.bx * NTHR + tid; i < 2 * (INP - INW); i += w.G * NTHR) WCS[WCS_IN + (i / (INP - INW)) * 2304 + INW + i % (INP - INW)] = 0.f;
    }
    for (int i = w.bx * NTHR + tid; i < 2 * (INP - INW) * D / 8; i += w.G * NTHR) { const int l = i / ((INP - INW) * D / 8), o = i % ((INP - INW) * D / 8);
        if (I8_GIN) { if (o < (INP - INW) * D / 16) *(GAS v4u*)((unsigned char*)WIN + (size_t)l * INP * D + (size_t)INW * D + (size_t)o * 16) = (v4u){0u, 0u, 0u, 0u}; }
        else *(GAS v4u*)(WIN + (size_t)l * INP * D + (size_t)INW * D + (size_t)o * 8) = (v4u){0u, 0u, 0u, 0u}; }
    __syncthreads();
}
__device__ __forceinline__ void ph_modfin(const Args& a, const Wg& w) {
    const float* b_mod = a.in[5]; const float* MODP = WS_PTR(float, WS_MODP); float* MODV = WS_PTR(float, WS_MODV);
    for (int i = w.bx * NTHR + w.tid; i < 2 * 9 * MOD6; i += w.G * NTHR) { const int l = i / (9 * MOD6), r = i % (9 * MOD6), n = r % MOD6;
        float s = b_mod[l * MOD6 + n];
#pragma unroll
        for (int kc = 0; kc < 8; ++kc) s += MODP[((size_t)l * 8 + kc) * 9 * MOD6 + r];
        MODV[i] = s; }
}
__device__ __forceinline__ void ph_quant(const Args& a, const Wg& w) {
    __syncthreads();
    if (I8_GIN) {
        LAS float* scr = (LAS float*)(w.lds + w.wave * 8448); constexpr int I_IN = 16 * 65;
        for (int it = w.gw; it < 2 * I_IN; it += w.NGW) { const int l = it / I_IN;
            transpose_item_i8(a.in[8] + (size_t)l * D * INW, D, INW, WS_PTR(unsigned char, WS_WIN) + (size_t)l * INP * D, 0, 0, WS_PTR(float, WS_WCS) + WCS_IN + l * 2304, scr, it % I_IN, w.lane); }
        __syncthreads(); }
    if (I8_FUP) {
        LAS float* scr = (LAS float*)(w.lds + w.wave * 8448); constexpr int I_F13 = 16 * 88;
        for (int it = w.gw; it < 2 * I_F13; it += w.NGW) { if (it < I_F13) transpose_item_i8(a.in[15], D, DFF, WS_PTR(unsigned char, WS_W13), 0, 1, WS_PTR(float, WS_WCS) + WCS_W1, scr, it, w.lane); else transpose_item_i8(a.in[16], D, DFF, WS_PTR(unsigned char, WS_W13), 0, 2, WS_PTR(float, WS_WCS) + WCS_W3, scr, it - I_F13, w.lane); }
        __syncthreads(); }
}
__device__ __forceinline__ void ph_norm(const Args& a, const Wg& w, const int l, const int which) {
    const int lane = w.lane;
    const float* modl = WS_PTR(float, WS_MODV) + (size_t)l * 9 * MOD6;
    const bool fin = (l == 0 && which == 0);
    const float* resL = a.in[0]; const float* resC = a.in[2]; const bf16* XRES = WS_PTR(bf16, WS_XRES);
    const float* nw = (which == 0 ? a.in[6] : a.in[7]) + l * D;
    bf16* HBUF = WS_PTR(bf16, WS_HBUF);
    const bool route = (l == 1 && which == 1);
    LAS float* rw = (LAS float*)w.lds;
    if (route) { const float* router_w = a.in[18]; for (int i = w.tid; i < D * NE / 4; i += NTHR) ((LAS f32x4*)rw)[i] = ((const f32x4*)router_w)[i]; }
    __syncthreads();
    int* TOKE = WS_PTR(int, WS_ROUTE + RT_TOKE); float* TOKG = WS_PTR(float, WS_ROUTE + RT_TOKG);
    const int Mrows = (l == 1 && which == 1) ? NL : MT;
    for (int m = w.gw; m < Mrows; m += w.NGW) {
        const bool isc = m >= NL; const int bidx = isc ? 8 : (m >> 12);
        const float* xr = isc ? resC + (size_t)(m - NL) * D : resL + (size_t)m * D;
        const float* sh = modl + bidx * MOD6 + which * 3 * D, *sc = sh + D;
        f32x4 v[4]; float ss = 0.f;
#pragma unroll
        for (int j = 0; j < 4; ++j) { v[j] = fin ? *(const f32x4*)(xr + 4 * lane + 256 * j) : pg8::bf4_to_f32(*(const pg8::u32x2_t*)(XRES + (size_t)m * D + 4 * lane + 256 * j)); ss += (v[j].x * v[j].x + v[j].y * v[j].y) + (v[j].z * v[j].z + v[j].w * v[j].w); }
        const float rstd = 1.0f / sqrtf(wave_sum(ss) * (1.0f / D) + EPS);
        float lg[8];
#pragma unroll
        for (int e = 0; e < 8; ++e) lg[e] = 0.f;
        f32x4 hq[4]; float amax = 0.f;
#pragma unroll
        for (int j = 0; j < 4; ++j) { const int c = 4 * lane + 256 * j; const f32x4 wv = *(const f32x4*)(nw + c), s1 = *(const f32x4*)(sc + c), s0 = *(const f32x4*)(sh + c);
            const f32x4 h = (v[j] * rstd) * wv * (s1 + 1.0f) + s0; hq[j] = h;
            amax = fmaxf(amax, fmaxf(fmaxf(fabsf(h.x), fabsf(h.y)), fmaxf(fabsf(h.z), fabsf(h.w))));
            if (route) {
#pragma unroll
                for (int q = 0; q < 4; ++q) { const f32x4 r0 = *(const LAS f32x4*)(rw + (c + q) * 8), r1 = *(const LAS f32x4*)(rw + (c + q) * 8 + 4); const float hv = h[q];
                    lg[0] += hv * r0.x; lg[1] += hv * r0.y; lg[2] += hv * r0.z; lg[3] += hv * r0.w; lg[4] += hv * r1.x; lg[5] += hv * r1.y; lg[6] += hv * r1.z; lg[7] += hv * r1.w; } } }
        if ((which == 1 && l == 0 && I8_FUP) || (which == 0 && I8_GIN)) {
#pragma unroll
            for (int o = 1; o < 64; o <<= 1) amax = fmaxf(amax, __shfl_xor(amax, o));
            const float qs = amax > 1e-30f ? 127.0f / amax : 0.f;
            if (lane == 0) WS_PTR(float, WS_RS)[m] = amax * (1.0f / 127.0f);
#pragma unroll
            for (int j = 0; j < 4; ++j) *(unsigned*)((unsigned char*)HBUF + (size_t)m * D + 4 * lane + 256 * j) = pk4_i8(hq[j].x * qs, hq[j].y * qs, hq[j].z * qs, hq[j].w * qs);
        } else {
#pragma unroll
            for (int j = 0; j < 4; ++j) { const int c = 4 * lane + 256 * j; const f32x4 h = hq[j];
                if (which == 0 || (l == 0 && !FP8_FUP)) *(v2u*)(HBUF + (size_t)m * D + c) = (v2u){cvtpk(h.x, h.y), cvtpk(h.z, h.w)};
                else *(unsigned*)((unsigned char*)HBUF + (size_t)m * D + c) = pg8::pk4_fp8(h.x * FP8_SH, h.y * FP8_SH, h.z * FP8_SH, h.w * FP8_SH); } }
        if (route) {
#pragma unroll
            for (int e = 0; e < 8; ++e) lg[e] = wave_sum(lg[e]);
            int e0 = 0; float v0 = lg[0];
#pragma unroll
            for (int e = 1; e < 8; ++e) if (lg[e] > v0) { v0 = lg[e]; e0 = e; }
            int e1 = -1; float v1 = -3.0e38f;
#pragma unroll
            for (int e = 0; e < 8; ++e) if (e != e0 && lg[e] > v1) { v1 = lg[e]; e1 = e; }
            const float g0 = 1.0f / (1.0f + __expf(v1 - v0)), g1 = 1.0f - g0;
            if (lane == 0) { TOKE[m] = e0; TOKE[NL + m] = e1; TOKG[m] = g0; TOKG[NL + m] = g1; }
        }
    }
    __syncthreads();
}
__device__ __forceinline__ void ph_gin(const Args& a, const Wg& w, const int l) {
    if constexpr (I8_GIN) { pg8::DenseOrder S; S.init(WS_PTR(bf16, WS_HBUF), (const bf16*)(WS_PTR(unsigned char, WS_WIN) + (size_t)l * INP * D), MT, INP, D / 2, w.G, w.bx);
        pg8::EpiBf16i E{WS_PTR(bf16, WS_PBUF), INP, WS_PTR(float, WS_RS), WS_PTR(float, WS_WCS) + WCS_IN + l * 2304};
        pg8::gemm_phase<pg8::EpiBf16i, pg8::DenseOrder, true, false, 2>(w.lds, D / 2, S, E); }
    else { pg8::DenseOrder S; S.init(WS_PTR(bf16, WS_HBUF), WS_PTR(bf16, WS_WIN) + (size_t)l * INP * D, MT, INP, D, w.G, w.bx); pg8::EpiBf16 E{WS_PTR(bf16, WS_PBUF), INP};
        pg8::gemm_phase<pg8::EpiBf16, pg8::DenseOrder, true, false>(w.lds, D, S, E); }
    conv_in_tail(a, w, (MT / 256) * (INP / 256), CONV_Q_GIN);
}
__device__ __forceinline__ int wq_next(unsigned* ctr, volatile LAS int* slot, int tid) {
    __syncthreads();
    if (tid == 0) *slot = (int)__hip_atomic_fetch_add(ctr, 1u, __ATOMIC_RELAXED, __HIP_MEMORY_SCOPE_AGENT);
    __syncthreads();
    return __builtin_amdgcn_readfirstlane(*slot);
}
__device__ __forceinline__ int wq_claim(unsigned* ctr, int tid) { return tid == 0 ? (int)__hip_atomic_fetch_add(ctr, 1u, __ATOMIC_RELAXED, __HIP_MEMORY_SCOPE_AGENT) : 0; }
__device__ __forceinline__ int wq_take(volatile LAS int* slot, int& par, int claimed, int tid) {
    if (tid == 0) slot[par] = claimed;
    __syncthreads();
    const int v = __builtin_amdgcn_readfirstlane(slot[par]); par ^= 1; return v;
}
#define MFMA16(a, b, c) __builtin_amdgcn_mfma_f32_16x16x32_bf16((a), (b), (c), 0, 0, 0)
constexpr int GL_QE = 0, GL_KE = 18432, GL_KDT = 36864, GL_P = 55296, GL_VT = 73728, GL_OS = 110592, GL_DEC = 144384, GL_SLOT = 160000;
static_assert(GL_DEC + 512 <= GL_SLOT && GL_SLOT + 64 <= LDSCTL_OFF, "GLA LDS map");
#define BB16 1
#if BB16
typedef _Float16 bb_t;
#else
typedef float bb_t;
#endif
constexpr size_t GSCR_OFF = (size_t)72 * MiB;
constexpr int NG1 = 64 * 17;
__device__ __forceinline__ int gla_run_row0(int b, int run) { return run == 0 ? NL + b * CTXL : b * SEQ + (run - 1) * 256; }
__device__ __forceinline__ float log_sigmoid_f(float z) { return fminf(z, 0.f) - log1pf(__expf(-fabsf(z))); }
__device__ __forceinline__ void gla_vt_image(const bf16* PBUF, LAS unsigned char* lds, int row0, int h, int tid) {
    const int dv = tid & 127, t4 = tid >> 7; unsigned pk[8];
    const bf16* p = PBUF + (size_t)(row0 + 16 * t4) * INP + PC_V + h * 128 + dv;
#pragma unroll
    for (int e = 0; e < 8; ++e) pk[e] = (unsigned)p[(size_t)(2 * e) * INP] | ((unsigned)p[(size_t)(2 * e + 1) * INP] << 16);
    *(LAS v4u*)(lds + GL_VT + dv * 144 + 32 * t4) = (v4u){pk[0], pk[1], pk[2], pk[3]};
    *(LAS v4u*)(lds + GL_VT + dv * 144 + 32 * t4 + 16) = (v4u){pk[4], pk[5], pk[6], pk[7]};
}
__device__ __forceinline__ bf16x8 tr_frag16(unsigned img, int pitch, int row0, int col0, int lane) {
    const int g = lane >> 4, qq = (lane & 15) >> 2, pp = lane & 3; const unsigned a0 = img + (unsigned)((row0 + 8 * g + qq) * pitch + (col0 + 4 * pp) * 2);
    v2u lo, hi;
    asm volatile("ds_read_b64_tr_b16 %0, %2\n\tds_read_b64_tr_b16 %1, %3\n\ts_waitcnt lgkmcnt(0)" : "=&v"(lo), "=&v"(hi) : "v"(a0), "v"(a0 + 4u * (unsigned)pitch) : "memory");
    return __builtin_bit_cast(bf16x8, (v4u){lo.x, lo.y, hi.x, hi.y});
}
__device__ __forceinline__ bf16x8 tr_frag32(unsigned img, int pitch, int row0, int col0, int lane) {
    const int hh = lane >> 5, blk = (lane >> 4) & 1, qq = (lane & 15) >> 2, pp = lane & 3; const unsigned a0 = img + (unsigned)((row0 + 8 * hh + qq) * pitch + (col0 + 16 * blk + 4 * pp) * 2);
    v2u lo, hi;
    asm volatile("ds_read_b64_tr_b16 %0, %2\n\tds_read_b64_tr_b16 %1, %3\n\ts_waitcnt lgkmcnt(0)" : "=&v"(lo), "=&v"(hi) : "v"(a0), "v"(a0 + 4u * (unsigned)pitch) : "memory");
    return __builtin_bit_cast(bf16x8, (v4u){lo.x, lo.y, hi.x, hi.y});
}
__device__ __forceinline__ void gla_state_update(f32x4 (&S)[4], LAS unsigned char* lds, int wave, int r, int q, int o_kdt, int o_vt, int o_dec) {
    const LAS float* dec = (const LAS float*)(lds + o_dec);
#pragma unroll
    for (int kt = 0; kt < 4; ++kt) { const f32x4 d = *(const LAS f32x4*)(dec + 16 * kt + 4 * q); S[kt] = S[kt] * d; }
#pragma unroll
    for (int ks = 0; ks < 2; ++ks) { const bf16x8 B = *(const LAS bf16x8*)(lds + o_vt + (16 * wave + r) * 144 + (32 * ks + 8 * q) * 2);
#pragma unroll
        for (int kt = 0; kt < 4; ++kt) { const bf16x8 A = *(const LAS bf16x8*)(lds + o_kdt + (16 * kt + r) * 144 + (32 * ks + 8 * q) * 2); S[kt] = MFMA16(A, B, S[kt]); } }
}
struct G1Raw { v4u lfa[2]; v4u kr, v0, v1; };
__device__ __forceinline__ void g1_load(G1Raw& r, const bf16* PBUF, int row0, int h, int dir, int tid) {
    const int tok = tid >> 3, k0 = (tid & 7) * 8;
    { const int wv = tid >> 6, ln = tid & 63;
#pragma unroll
      for (int t = 0; t < 2; ++t) r.lfa[t] = *(const v4u*)(PBUF + (size_t)(row0 + 16 * (2 * (wv >> 2) + t) + (ln & 15)) * INP + PC_LF + dir * 16 + 8 * ((ln >> 4) & 1)); }
    r.kr = *(const v4u*)(PBUF + (size_t)(row0 + tok) * INP + PC_K + h * 64 + k0);
    const bf16* pv = PBUF + (size_t)(row0 + tok) * INP + PC_V + h * 128 + 2 * k0;
    r.v0 = *(const v4u*)pv; r.v1 = *(const v4u*)(pv + 8);
}
__device__ __forceinline__ float log_sigmoid_fast(float z) { return fminf(z, 0.f) - 0.6931471805599453f * __builtin_amdgcn_logf(1.0f + __builtin_amdgcn_exp2f(fabsf(z) * -1.4426950408889634f)); }
constexpr int G1_VT = 0, G1_KDT = 36864, G1_LF = 55296, G1_T = 63488, G1_DEC = 67584, G1_Z = 69632, G1_KR = 87040, G1_BI = 96256;
__device__ __forceinline__ void gla_g1_job(const Args& a, const Wg& w, const int l, const int job, const int var = 0) {
    const int tid = w.tid, lane = w.lane, wave = w.wave, r = lane & 15, q = lane >> 4, k = tid & 63, tg = tid >> 6;
    const int seq = job / 17, step = job - seq * 17, b = seq >> 3, h = (seq >> 1) & 3, dir = seq & 1;
    const int run = step == 0 ? 0 : (dir ? 17 - step : step), rrow0 = gla_run_row0(b, run);
    const bf16* PBUF = WS_PTR(bf16, WS_PBUF); bb_t* BBUF = (bb_t*)a.out; float* SLOC = WS_PTR(float, WS_SLOC); float* DTOT = WS_PTR(float, WS_DTOT);
    LAS unsigned char* lds = w.lds;
    bf16x8 WB;
    { const int kgrp = lane >> 4, r0 = 8 * (kgrp & 1); const float* wgp = (dir ? a.in[11] : a.in[9]) + (size_t)l * 16 * 256 + h * 64 + 16 * (wave & 3) + (lane & 15);
      unsigned pkw[4];
#pragma unroll
      for (int jj = 0; jj < 8; jj += 2) { unsigned hv[2];
#pragma unroll
          for (int u = 0; u < 2; ++u) { const float wv = wgp[(r0 + jj + u) * 256]; const unsigned hb = cvtpk(wv, wv) & 0xffffu; const float lo = wv - __uint_as_float(hb << 16); hv[u] = (kgrp >> 1) ? (cvtpk(lo, lo) & 0xffffu) : hb; }
          pkw[jj >> 1] = hv[0] | (hv[1] << 16); }
      WB = __builtin_bit_cast(bf16x8, (v4u){pkw[0], pkw[1], pkw[2], pkw[3]}); }
    const float bias = (dir ? a.in[12] : a.in[10])[l * 256 + h * 64 + k];
    f32x4 S[4];
#pragma unroll
    for (int kt = 0; kt < 4; ++kt) S[kt] = (f32x4){0.f, 0.f, 0.f, 0.f};
    float logtot = 0.f;
    G1Raw cur; g1_load(cur, PBUF, rrow0 + (dir ? 3 : 0) * 64, h, dir, tid);
    for (int pc = 0; pc < ((var & 8) ? 0 : 4); ++pc) {
        const int par = pc & 1, row0 = rrow0 + (dir ? 3 - pc : pc) * 64;
        LAS unsigned char* VT = lds + G1_VT + par * 18432; LAS unsigned char* KDT = lds + G1_KDT + par * 9216; LAS float* Z = (LAS float*)(lds + G1_Z);
        LAS float* T = (LAS float*)(lds + G1_T + par * 2048); LAS float* DEC = (LAS float*)(lds + G1_DEC + par * 256);
        { f32x4 z0 = (f32x4){0.f, 0.f, 0.f, 0.f}, z1 = z0;
          z0 = MFMA16(__builtin_bit_cast(bf16x8, cur.lfa[0]), WB, z0); z1 = MFMA16(__builtin_bit_cast(bf16x8, cur.lfa[1]), WB, z1);
          LAS float* zp = Z + (32 * (wave >> 2) + 4 * q) * 68 + 16 * (wave & 3) + r;
#pragma unroll
          for (int i = 0; i < 4; ++i) { zp[i * 68] = z0[i]; zp[(16 + i) * 68] = z1[i]; } }
        { const int tok = tid >> 3, k0 = (tid & 7) * 8;
          *(LAS v4u*)(VT + tok * 288 + 4 * k0) = cur.v0; *(LAS v4u*)(VT + tok * 288 + 4 * k0 + 16) = cur.v1;
          *(LAS v4u*)(lds + G1_KR + tok * 144 + 2 * k0) = cur.kr; }
        __syncthreads();
        if (pc < 3) g1_load(cur, PBUF, rrow0 + (dir ? 2 - pc : pc + 1) * 64, h, dir, tid);
        float gv[8];
#pragma unroll
        for (int e = 0; e < 8; ++e) { gv[e] = log_sigmoid_fast(Z[(8 * tg + e) * 68 + k] + bias) * (1.0f / 16.0f); if (var & 1) break; }
        if (var & 1) {
#pragma unroll
            for (int e = 1; e < 8; ++e) gv[e] = gv[0]; }
        float runs = 0.f;
        if (!dir) {
#pragma unroll
            for (int e = 0; e < 8; ++e) { runs += gv[e]; gv[e] = runs; } }
        else {
#pragma unroll
            for (int e = 7; e >= 0; --e) { runs += gv[e]; gv[e] = runs; } }
        T[tg * 64 + k] = runs;
        __syncthreads();
        float off = 0.f, tot = 0.f;
#pragma unroll
        for (int t2 = 0; t2 < 8; ++t2) { const float v = T[t2 * 64 + k]; tot += v; const bool before = dir ? (t2 > tg) : (t2 < tg); off += before ? v : 0.f; }
        unsigned pk[4];
#pragma unroll
        for (int e2 = 0; e2 < 4; ++e2) { const float B0 = gv[2 * e2] + off, B1 = gv[2 * e2 + 1] + off; const int tk = 8 * tg + 2 * e2;
            *(LAS bb_t*)(lds + G1_BI + tk * 144 + 2 * k) = (bb_t)B0; *(LAS bb_t*)(lds + G1_BI + (tk + 1) * 144 + 2 * k) = (bb_t)B1;
            const float kv0 = bf2f(*(const LAS bf16*)(lds + G1_KR + tk * 144 + 2 * k)), kv1 = bf2f(*(const LAS bf16*)(lds + G1_KR + (tk + 1) * 144 + 2 * k));
            pk[e2] = cvtpk(kv0 * __expf(tot - B0), kv1 * __expf(tot - B1)); }
        *(LAS v4u*)(KDT + k * 144 + 16 * tg) = (v4u){pk[0], pk[1], pk[2], pk[3]};
        if (tg == 0) DEC[k] = __expf(tot);
        logtot += tot;
        __syncthreads();
        if (!(var & 4)) { const int tok = tid >> 3, k0 = (tid & 7) * 8; *(v4u*)(BBUF + (size_t)(row0 + tok) * 512 + dir * 256 + h * 64 + k0) = *(const LAS v4u*)(lds + G1_BI + tok * 144 + 2 * k0); }
        if (!(var & 2)) {
#pragma unroll
            for (int kt = 0; kt < 4; ++kt) { const f32x4 d = *(const LAS f32x4*)(DEC + 16 * kt + 4 * q); S[kt] = S[kt] * d; }
#pragma unroll
            for (int ks = 0; ks < 2; ++ks) { const bf16x8 Bf = tr_frag16((unsigned)(size_t)VT, 288, 32 * ks, 16 * wave, lane);
#pragma unroll
                for (int kt = 0; kt < 4; ++kt) { const bf16x8 Af = *(const LAS bf16x8*)(KDT + (16 * kt + r) * 144 + (32 * ks + 8 * q) * 2); S[kt] = MFMA16(Af, Bf, S[kt]); } }
        }
    }
    const size_t idx = (size_t)seq * 17 + step;
#pragma unroll
    for (int kt = 0; kt < 4; ++kt)
#pragma unroll
        for (int i = 0; i < 4; ++i) SLOC[idx * 8192 + (size_t)(16 * kt + 4 * q + i) * 128 + 16 * wave + r] = S[kt][i];
    if (tg == 0) DTOT[idx * 64 + k] = __expf(logtot);
}
__device__ __forceinline__ void ph_gla_scan(const Args& a, const Wg& w) {
    float* SLOC = WS_PTR(float, WS_SLOC); const float* DTOT = WS_PTR(float, WS_DTOT);
    for (int ge = w.bx * NTHR + w.tid; ge < 64 * 8192; ge += w.G * NTHR) { const int seq = ge >> 13, e = ge & 8191;
        float* p = SLOC + (size_t)seq * 17 * 8192 + e; const float* d = DTOT + (size_t)seq * 17 * 64 + (e >> 7);
        float tv[17], dv[17];
#pragma unroll
        for (int st = 0; st < 17; ++st) { tv[st] = p[(size_t)st * 8192]; dv[st] = d[st * 64]; }
        float s = 0.f;
#pragma unroll
        for (int st = 0; st < 17; ++st) { p[(size_t)st * 8192] = s; s = dv[st] * s + tv[st]; } }
}
struct G3Raw { v4u q, k, B, Bl, v0, v1; };
static_assert(BB16, "g3_load reads the log-decay buffer as f16 rows");
__device__ __forceinline__ void g3_load(G3Raw& r, const bf16* PBUF, const bb_t* BBUF, int row0, int h, int dir, int tid) {
    const int tok = tid >> 3, k0 = (tid & 7) * 8;
    r.q = *(const v4u*)(PBUF + (size_t)(row0 + tok) * INP + PC_Q + h * 64 + k0);
    r.k = *(const v4u*)(PBUF + (size_t)(row0 + tok) * INP + PC_K + h * 64 + k0);
    r.B = *(const v4u*)(BBUF + (size_t)(row0 + tok) * 512 + dir * 256 + h * 64 + k0);
    r.Bl = *(const v4u*)(BBUF + (size_t)(row0 + (dir ? 0 : 63)) * 512 + dir * 256 + h * 64 + k0);
    const bf16* pv = PBUF + (size_t)(row0 + tok) * INP + PC_V + h * 128 + 2 * k0;
    r.v0 = *(const v4u*)pv; r.v1 = *(const v4u*)(pv + 8);
}
__device__ __forceinline__ void gla_g3_job(const Args& a, const Wg& w, const int l, const int job, const int var = 0) {
    const int tid = w.tid, lane = w.lane, wave = w.wave, r = lane & 15, q = lane >> 4, k = tid & 63, tg = tid >> 6;
    const int b = job / 68, h = (job / 17) & 3, run = job % 17, rrow0 = gla_run_row0(b, run);
    const bf16* PBUF = WS_PTR(bf16, WS_PBUF); const bb_t* BBUF = (const bb_t*)a.out; const float* SLOC = WS_PTR(float, WS_SLOC); bf16* MIX = WS_PTR(bf16, WS_MIX);
    v4u* OFS = (v4u*)((unsigned char*)a.out + GSCR_OFF) + ((size_t)job * 4 * NTHR + tid) * 2;
    const float* gnw = a.in[13] + l * 128 + (tid & 7) * 16;
    f32x4 gw4[4];
#pragma unroll
    for (int j = 0; j < 4; ++j) gw4[j] = *(const f32x4*)(gnw + 4 * j);
    LAS unsigned char* lds = w.lds; LAS float* OS = (LAS float*)(lds + GL_OS);
    f32x4 S[4];
    { const size_t idx = (size_t)((b * 4 + h) * 2 + 0) * 17 + run;
#pragma unroll
      for (int kt = 0; kt < 4; ++kt)
#pragma unroll
          for (int i = 0; i < 4; ++i) S[kt][i] = SLOC[idx * 8192 + (size_t)(16 * kt + 4 * q + i) * 128 + 16 * wave + r]; }
    G3Raw cur; g3_load(cur, PBUF, BBUF, rrow0, h, 0, tid);
    for (int s = 0; s < ((var & 8) ? 0 : 8); ++s) {
        const int dir = s >> 2, pc = s & 3, cidx = dir ? 3 - pc : pc, row0 = rrow0 + cidx * 64, par = s & 1;
        const int oQE = GL_QE + par * 9216, oKE = GL_KE + par * 9216, oKDT = GL_KDT + par * 9216, oP = GL_P + par * 9216, oVT = GL_VT + par * 18432, oDEC = GL_DEC + par * 256;
        if (s == 4) { const size_t idx = (size_t)((b * 4 + h) * 2 + 1) * 17 + (run == 0 ? 0 : 17 - run);
#pragma unroll
            for (int kt = 0; kt < 4; ++kt)
#pragma unroll
                for (int i = 0; i < 4; ++i) S[kt][i] = SLOC[idx * 8192 + (size_t)(16 * kt + 4 * q + i) * 128 + 16 * wave + r]; }
        {
            const int tok = tid >> 3, k0 = (tid & 7) * 8;
            const unsigned qw[4] = {cur.q.x, cur.q.y, cur.q.z, cur.q.w}, kw[4] = {cur.k.x, cur.k.y, cur.k.z, cur.k.w}, bw[4] = {cur.B.x, cur.B.y, cur.B.z, cur.B.w}, lw[4] = {cur.Bl.x, cur.Bl.y, cur.Bl.z, cur.Bl.w};
            unsigned qe[4], ke[4]; float dl[8];
#pragma unroll
            for (int j2 = 0; j2 < 4; ++j2) { typedef _Float16 h2 __attribute__((ext_vector_type(2)));
                const h2 bh = __builtin_bit_cast(h2, bw[j2]), lh = __builtin_bit_cast(h2, lw[j2]);
                const float B0 = (float)bh.x, B1 = (float)bh.y, L0 = (float)lh.x, L1 = (float)lh.y;
                const float q0 = bflo(qw[j2]), q1 = bfhi(qw[j2]), kv0 = bflo(kw[j2]), kv1 = bfhi(kw[j2]);
                qe[j2] = cvtpk(q0 * 0.125f * __expf(B0), q1 * 0.125f * __expf(B1)); ke[j2] = cvtpk(kv0 * __expf(-B0), kv1 * __expf(-B1));
                const unsigned kd2 = cvtpk(kv0 * __expf(L0 - B0), kv1 * __expf(L1 - B1));
                *(LAS bf16*)(lds + oKDT + (k0 + 2 * j2) * 144 + 2 * tok) = (bf16)(kd2 & 0xffffu); *(LAS bf16*)(lds + oKDT + (k0 + 2 * j2 + 1) * 144 + 2 * tok) = (bf16)(kd2 >> 16);
                dl[2 * j2] = L0; dl[2 * j2 + 1] = L1; }
            *(LAS v4u*)(lds + oQE + tok * 144 + 2 * k0) = (v4u){qe[0], qe[1], qe[2], qe[3]};
            *(LAS v4u*)(lds + oKE + tok * 144 + 2 * k0) = (v4u){ke[0], ke[1], ke[2], ke[3]};
            if (tok == 0) { *(LAS f32x4*)(lds + oDEC + 4 * k0) = (f32x4){__expf(dl[0]), __expf(dl[1]), __expf(dl[2]), __expf(dl[3])}; *(LAS f32x4*)(lds + oDEC + 4 * k0 + 16) = (f32x4){__expf(dl[4]), __expf(dl[5]), __expf(dl[6]), __expf(dl[7])}; }
            *(LAS v4u*)(lds + oVT + tok * 288 + 4 * k0) = cur.v0; *(LAS v4u*)(lds + oVT + tok * 288 + 4 * k0 + 16) = cur.v1;
        }
        __syncthreads();
        if (s < 7) { const int s1 = s + 1, d1 = s1 >> 2, p1 = s1 & 3; g3_load(cur, PBUF, BBUF, rrow0 + (d1 ? 3 - p1 : p1) * 64, h, d1, tid); }
        v4u of0 = (v4u){0u, 0u, 0u, 0u}, of1 = of0, gA = of0, gB = of0;
        if (dir) { const v4u* op = OFS + (size_t)cidx * NTHR * 2; of0 = op[0]; of1 = op[1];
            const bf16* pg = PBUF + (size_t)(row0 + (tid >> 3)) * INP + PC_G + h * 128 + (tid & 7) * 16; gA = *(const v4u*)pg; gB = *(const v4u*)(pg + 8); }
#pragma unroll
        for (int t = 0; t < 2; ++t) { const int id = 2 * wave + t, st = id >> 2, tt = id & 3;
            f32x4 pa = (f32x4){0.f, 0.f, 0.f, 0.f};
            if (dir ? (st >= tt) : (st <= tt)) {
#pragma unroll
                for (int ks = 0; ks < 2; ++ks) { const bf16x8 A = *(const LAS bf16x8*)(lds + oKE + (16 * st + r) * 144 + (32 * ks + 8 * q) * 2), B = *(const LAS bf16x8*)(lds + oQE + (16 * tt + r) * 144 + (32 * ks + 8 * q) * 2);
                    pa = MFMA16(A, B, pa); }
                const int tau = 16 * tt + r;
#pragma unroll
                for (int i = 0; i < 4; ++i) { const int sg = 16 * st + 4 * q + i; const bool keep = dir ? (sg >= tau) : (sg <= tau); pa[i] = keep ? pa[i] : 0.f; } }
            *(LAS v2u*)(lds + oP + (16 * tt + r) * 144 + (16 * st + 4 * q) * 2) = (v2u){cvtpk(pa[0], pa[1]), cvtpk(pa[2], pa[3])}; }
        __syncthreads();
        f32x4 o[4];
#pragma unroll
        for (int tt = 0; tt < 4; ++tt) o[tt] = (f32x4){0.f, 0.f, 0.f, 0.f};
#pragma unroll
        for (int ks = 0; ks < 2; ++ks) {
            const bf16x8 Bs = __builtin_bit_cast(bf16x8, (v4u){cvtpk(S[2 * ks][0], S[2 * ks][1]), cvtpk(S[2 * ks][2], S[2 * ks][3]), cvtpk(S[2 * ks + 1][0], S[2 * ks + 1][1]), cvtpk(S[2 * ks + 1][2], S[2 * ks + 1][3])});
#pragma unroll
            for (int tt = 0; tt < 4; ++tt) { const v2u alo = *(const LAS v2u*)(lds + oQE + (16 * tt + r) * 144 + (32 * ks + 4 * q) * 2), ahi = *(const LAS v2u*)(lds + oQE + (16 * tt + r) * 144 + (32 * ks + 16 + 4 * q) * 2);
                o[tt] = MFMA16(__builtin_bit_cast(bf16x8, (v4u){alo.x, alo.y, ahi.x, ahi.y}), Bs, o[tt]); } }
        bf16x8 Bv[2];
#pragma unroll
        for (int ks = 0; ks < 2; ++ks) Bv[ks] = tr_frag16((unsigned)(size_t)(lds + oVT), 288, 32 * ks, 16 * wave, lane);
#pragma unroll
        for (int ks = 0; ks < 2; ++ks) {
#pragma unroll
            for (int tt = 0; tt < 4; ++tt) { const bf16x8 A = *(const LAS bf16x8*)(lds + oP + (16 * tt + r) * 144 + (32 * ks + 8 * q) * 2); o[tt] = MFMA16(A, Bv[ks], o[tt]); } }
        { const LAS float* dec = (const LAS float*)(lds + oDEC);
#pragma unroll
          for (int kt = 0; kt < 4; ++kt) { const f32x4 dd = *(const LAS f32x4*)(dec + 16 * kt + 4 * q); S[kt] = S[kt] * dd; }
#pragma unroll
          for (int ks = 0; ks < 2; ++ks)
#pragma unroll
              for (int kt = 0; kt < 4; ++kt) { const bf16x8 A = *(const LAS bf16x8*)(lds + oKDT + (16 * kt + r) * 144 + (32 * ks + 8 * q) * 2); S[kt] = MFMA16(A, Bv[ks], S[kt]); } }
        if (dir == 0) {
            v4u* op = OFS + (size_t)cidx * NTHR * 2;
            op[0] = (v4u){cvtpk(o[0][0], o[0][1]), cvtpk(o[0][2], o[0][3]), cvtpk(o[1][0], o[1][1]), cvtpk(o[1][2], o[1][3])};
            op[1] = (v4u){cvtpk(o[2][0], o[2][1]), cvtpk(o[2][2], o[2][3]), cvtpk(o[3][0], o[3][1]), cvtpk(o[3][2], o[3][3])};
        } else {
            const unsigned ofw[8] = {of0.x, of0.y, of0.z, of0.w, of1.x, of1.y, of1.z, of1.w};
#pragma unroll
            for (int tt = 0; tt < 4; ++tt)
#pragma unroll
                for (int i = 0; i < 4; ++i) { const int tk = 16 * tt + 4 * q + i; const unsigned wv = ofw[2 * tt + (i >> 1)]; OS[tk * 132 + 16 * wave + r] = o[tt][i] + ((i & 1) ? bfhi(wv) : bflo(wv)); }
            __syncthreads();
            const int tk = tid >> 3, dv0 = (tid & 7) * 16; const size_t row = (size_t)(row0 + tk);
            f32x4 ov[4]; float ss = 0.f;
#pragma unroll
            for (int j = 0; j < 4; ++j) { ov[j] = *(const LAS f32x4*)(OS + tk * 132 + dv0 + 4 * j); ss += (ov[j].x * ov[j].x + ov[j].y * ov[j].y) + (ov[j].z * ov[j].z + ov[j].w * ov[j].w); }
            ss += __shfl_xor(ss, 1); ss += __shfl_xor(ss, 2); ss += __shfl_xor(ss, 4);
            const float rstd = __builtin_amdgcn_rsqf(ss * (1.0f / 128.0f) + EPS);
            const unsigned gq[8] = {gA.x, gA.y, gA.z, gA.w, gB.x, gB.y, gB.z, gB.w}; unsigned yo[8];
#pragma unroll
            for (int j = 0; j < 4; ++j) { const f32x4 wv = gw4[j];
                const float ga = bflo(gq[2 * j]), gb = bfhi(gq[2 * j]), gc = bflo(gq[2 * j + 1]), gd = bfhi(gq[2 * j + 1]);
                yo[2 * j] = cvtpk(ov[j].x * rstd * wv.x * silu_fast(ga), ov[j].y * rstd * wv.y * silu_fast(gb));
                yo[2 * j + 1] = cvtpk(ov[j].z * rstd * wv.z * silu_fast(gc), ov[j].w * rstd * wv.w * silu_fast(gd)); }
            bf16* mo = MIX + row * D + 512 + h * 128 + dv0;
            *(v4u*)mo = (v4u){yo[0], yo[1], yo[2], yo[3]}; *(v4u*)(mo + 8) = (v4u){yo[4], yo[5], yo[6], yo[7]};
        }
    }
}
__device__ __forceinline__ void four_t1_setup(const Wg& w, bf16x8 (&T1)[8]) {
    const int lane = w.lane, wave = w.wave, r = lane & 31, h = lane >> 5;
    const int k2c = 32 * wave + r, k2 = k2c & 127;
#pragma unroll
    for (int s = 0; s < 8; ++s) { unsigned pk[4];
#pragma unroll
        for (int j = 0; j < 4; ++j) { const int n0 = 16 * s + 8 * h + 2 * j; const float f0 = (float)((n0 * k2) & 127) * (1.0f / 128.0f), f1 = (float)(((n0 + 1) * k2) & 127) * (1.0f / 128.0f);
            pk[j] = k2c < 128 ? cvtpk(cosrev(f0), cosrev(f1)) : cvtpk(-sinrev(f0), -sinrev(f1)); }
        T1[s] = __builtin_bit_cast(bf16x8, (v4u){pk[0], pk[1], pk[2], pk[3]}); }
}
__device__ __forceinline__ void ctx_dft1_item(const Args& a, const Wg& w, const bf16x8 (&T1)[8], const int item) {
    const int tid = w.tid, lane = w.lane, wave = w.wave, r = lane & 31, h = lane >> 5;
    const bf16* PBUF = WS_PTR(bf16, WS_PBUF); bf16* XB = WS_PTR(bf16, WS_XBC) - (size_t)NL * 4 * 256;
    LAS unsigned char* U = w.lds;
    const int g = item & 3, m0 = NL + (item >> 2) * 64;
    __syncthreads();
#pragma unroll
    for (int i = 0; i < 2; ++i) { const int id = tid + NTHR * i, aa = id >> 4, ch = id & 15;
        const v4u v = *(const v4u*)(PBUF + (size_t)(m0 + aa) * INP + PC_U + g * 128 + ch * 8);
        *(LAS v4u*)(U + aa * 272 + ch * 16) = v; }
    __syncthreads();
    f32x16 x0, x1;
#pragma unroll
    for (int i = 0; i < 16; ++i) { x0[i] = 0.f; x1[i] = 0.f; }
#pragma unroll
    for (int s = 0; s < 8; ++s) { const bf16x8 A0 = *(const LAS bf16x8*)(U + r * 272 + (16 * s + 8 * h) * 2), A1 = *(const LAS bf16x8*)(U + (32 + r) * 272 + (16 * s + 8 * h) * 2);
        x0 = MFMA32(A0, T1[s], x0); x1 = MFMA32(A1, T1[s], x1); }
    bf16* xo = XB + ((size_t)m0 * 4 + g) * 256 + 32 * wave + r;
#pragma unroll
    for (int i = 0; i < 16; ++i) { xo[(size_t)crow32(i, h) * 1024] = bf1(x0[i]); xo[(size_t)(32 + crow32(i, h)) * 1024] = bf1(x1[i]); }
}
__device__ __forceinline__ void ctx_dft2_item(const Args& a, const Wg& w, const int it) {
    const int tid = w.tid, lane = w.lane, wave = w.wave, r = lane & 31, h = lane >> 5, dt = wave >> 2, ct = wave & 3;
    const bf16* XB = WS_PTR(bf16, WS_XBC) - (size_t)NL * 4 * 256; bf16* MIX = WS_PTR(bf16, WS_MIX);
    const int b = it >> 4, g = (it >> 2) & 3, kq = it & 3, row0 = NL + b * CTXL;
    LAS unsigned char* T = w.lds; constexpr int P = 528;
    __syncthreads();
    v4u v[16];
#pragma unroll
    for (int i = 0; i < 16; ++i) { const int id = tid + NTHR * i, row = id >> 5, ch = id & 31; v[i] = *(const v4u*)(XB + ((size_t)(row0 + row) * 4 + g) * 256 + ch * 8); }
#pragma unroll
    for (int i = 0; i < 16; ++i) { const int id = tid + NTHR * i, row = id >> 5, ch = id & 31; *(LAS v4u*)(T + row * P + ch * 16) = v[i]; }
    __syncthreads();
    f32x16 y;
#pragma unroll
    for (int i = 0; i < 16; ++i) y[i] = 0.f;
    const int k1 = kq * 64 + dt * 32 + r;
#pragma unroll 4
    for (int s = 0; s < 32; ++s) { unsigned pa[4], pb[4];
#pragma unroll
        for (int jj = 0; jj < 4; ++jj) { const int n1 = 8 * s + 4 * h + jj; const float f = (float)((k1 * n1) & 255) * (1.0f / 256.0f); pa[jj] = cvtpk(cosrev(f), sinrev(f));
            const LAS unsigned char* p = T + n1 * P + (32 * ct + r) * 2; pb[jj] = (unsigned)*(const LAS bf16*)p | ((unsigned)*(const LAS bf16*)(p + 256) << 16); }
        y = MFMA32(__builtin_bit_cast(bf16x8, (v4u){pa[0], pa[1], pa[2], pa[3]}), __builtin_bit_cast(bf16x8, (v4u){pb[0], pb[1], pb[2], pb[3]}), y); }
    const float sc = 1.0f / sqrtf((float)CTXL * 128.0f);
    bf16* mo = MIX + (size_t)(row0 + kq * 64 + 32 * dt) * D + g * 128 + 32 * ct + r;
#pragma unroll
    for (int i = 0; i < 16; ++i) mo[(size_t)crow32(i, h) * D] = bf1(y[i] * sc);
}
__device__ __forceinline__ void four_a_setup(const Wg& w, bf16x8 (&T1)[8]) {
    const int tid = w.tid;
    LAS unsigned char* M64 = w.lds;
    __syncthreads();
    for (int i = tid; i < 128 * 128; i += NTHR) { const int row = i >> 7, col = i & 127, c = row & 63, ri = row >> 6, aa = col & 63, ri2 = col >> 6;
        const float f = (float)((c * aa) & 63) * (1.0f / 64.0f), cs = cosrev(f), sn = sinrev(f); const float v = (ri == ri2) ? cs : (ri == 0 ? sn : -sn);
        *(LAS bf16*)(M64 + row * 272 + col * 2) = (bf16)f2bf(v); }
    four_t1_setup(w, T1);
    __syncthreads();
}
__device__ __forceinline__ void four_a_item(const Args& a, const Wg& w, const bf16x8 (&T1)[8], const int item) {
    const int tid = w.tid, lane = w.lane, wave = w.wave, r = lane & 31, h = lane >> 5;
    const bf16* PBUF = WS_PTR(bf16, WS_PBUF); bf16* ZB = WS_PTR(bf16, WS_ZBUF);
    LAS unsigned char* M64 = w.lds; LAS unsigned char* U = w.lds + 34816; LAS unsigned char* XT = w.lds + 52224;
    const int b = item >> 8, g = (item >> 6) & 3, bcol = item & 63;
#pragma unroll
    for (int i = 0; i < 2; ++i) { const int id = tid + NTHR * i, aa = id >> 4, ch = id & 15;
        const v4u v = *(const v4u*)(PBUF + (size_t)(b * SEQ + 64 * aa + bcol) * INP + PC_U + g * 128 + ch * 8);
        *(LAS v4u*)(U + aa * 272 + ch * 16) = v; }
    __syncthreads();
    f32x16 x0, x1;
#pragma unroll
    for (int i = 0; i < 16; ++i) { x0[i] = 0.f; x1[i] = 0.f; }
#pragma unroll
    for (int s = 0; s < 8; ++s) { const bf16x8 A0 = *(const LAS bf16x8*)(U + r * 272 + (16 * s + 8 * h) * 2), A1 = *(const LAS bf16x8*)(U + (32 + r) * 272 + (16 * s + 8 * h) * 2);
        x0 = MFMA32(A0, T1[s], x0); x1 = MFMA32(A1, T1[s], x1); }
    { const int k2 = (32 * wave + r) & 127, ri2 = wave >> 2;
#pragma unroll
      for (int qq = 0; qq < 4; ++qq) {
          *(LAS v2u*)(XT + k2 * 272 + (ri2 * 64 + 8 * qq + 4 * h) * 2) = (v2u){cvtpk(x0[4 * qq], x0[4 * qq + 1]), cvtpk(x0[4 * qq + 2], x0[4 * qq + 3])};
          *(LAS v2u*)(XT + k2 * 272 + (ri2 * 64 + 32 + 8 * qq + 4 * h) * 2) = (v2u){cvtpk(x1[4 * qq], x1[4 * qq + 1]), cvtpk(x1[4 * qq + 2], x1[4 * qq + 3])}; } }
    __syncthreads();
    const int ct = wave & 3, rt = wave >> 2;
    f32x16 zr, zi;
#pragma unroll
    for (int i = 0; i < 16; ++i) { zr[i] = 0.f; zi[i] = 0.f; }
#pragma unroll
    for (int s = 0; s < 8; ++s) { const bf16x8 B = *(const LAS bf16x8*)(XT + (32 * ct + r) * 272 + (16 * s + 8 * h) * 2);
        const bf16x8 Ar = *(const LAS bf16x8*)(M64 + (32 * rt + r) * 272 + (16 * s + 8 * h) * 2), Ai = *(const LAS bf16x8*)(M64 + (64 + 32 * rt + r) * 272 + (16 * s + 8 * h) * 2);
        zr = MFMA32(Ar, B, zr); zi = MFMA32(Ai, B, zi); }
    bf16* zo = ZB + ((size_t)((b * 4 + g) * 64) * 64 + bcol) * 256 + 32 * ct + r;
#pragma unroll
    for (int i = 0; i < 16; ++i) { const int c = 32 * rt + crow32(i, h); const float f = (float)((bcol * c) & 4095) * (1.0f / 4096.0f), cs = cosrev(f), sn = sinrev(f);
        const float vr = zr[i] * cs + zi[i] * sn, vi = zi[i] * cs - zr[i] * sn;
        bf16* p = zo + (size_t)c * 64 * 256; const unsigned z2 = cvtpk(vr, vi); p[0] = (bf16)(z2 & 0xffffu); p[128] = (bf16)(z2 >> 16); }
}
__device__ __forceinline__ int four_a_loop(const Args& a, const Wg& w, const bf16x8 (&T1)[8], unsigned* ctr, volatile LAS int* slot, int& par, int item, const int base, const int end, const bool run) {
    const int tid = w.tid, lane = w.lane, wave = w.wave, r = lane & 31, h = lane >> 5;
    const bf16* PBUF = WS_PTR(bf16, WS_PBUF); bf16* ZB = WS_PTR(bf16, WS_ZBUF);
    LAS unsigned char* M64 = w.lds; LAS unsigned char* U = w.lds + 34816; LAS unsigned char* XT = w.lds + 52224;
    int claim = wq_claim(ctr, tid);
    v4u u[2];
    { const int it = item - base, b = it >> 8, g = (it >> 6) & 3, bcol = it & 63;
#pragma unroll
      for (int i = 0; i < 2; ++i) { const int id = tid + NTHR * i, aa = id >> 4, ch = id & 15; u[i] = *(const v4u*)(PBUF + (size_t)(b * SEQ + 64 * aa + bcol) * INP + PC_U + g * 128 + ch * 8); } }
    while (item < end) {
        const int it = item - base, b = it >> 8, g = (it >> 6) & 3, bcol = it & 63;
#pragma unroll
        for (int i = 0; i < 2; ++i) { const int id = tid + NTHR * i, aa = id >> 4, ch = id & 15; *(LAS v4u*)(U + aa * 272 + ch * 16) = u[i]; }
        __syncthreads();
        f32x16 x0, x1;
#pragma unroll
        for (int i = 0; i < 16; ++i) { x0[i] = 0.f; x1[i] = 0.f; }
#pragma unroll
        for (int s = 0; s < 8; ++s) { const bf16x8 A0 = *(const LAS bf16x8*)(U + r * 272 + (16 * s + 8 * h) * 2), A1 = *(const LAS bf16x8*)(U + (32 + r) * 272 + (16 * s + 8 * h) * 2);
            x0 = MFMA32(A0, T1[s], x0); x1 = MFMA32(A1, T1[s], x1); }
        { const int k2 = (32 * wave + r) & 127, ri2 = wave >> 2;
#pragma unroll
          for (int qq = 0; qq < 4; ++qq) {
              *(LAS v2u*)(XT + k2 * 272 + (ri2 * 64 + 8 * qq + 4 * h) * 2) = (v2u){cvtpk(x0[4 * qq], x0[4 * qq + 1]), cvtpk(x0[4 * qq + 2], x0[4 * qq + 3])};
              *(LAS v2u*)(XT + k2 * 272 + (ri2 * 64 + 32 + 8 * qq + 4 * h) * 2) = (v2u){cvtpk(x1[4 * qq], x1[4 * qq + 1]), cvtpk(x1[4 * qq + 2], x1[4 * qq + 3])}; } }
        if (tid == 0) slot[par] = claim;
        __syncthreads();
        const int nitem = __builtin_amdgcn_readfirstlane(slot[par]); par ^= 1;
        claim = wq_claim(ctr, tid);
        if (nitem < end) { const int it2 = nitem - base, b2 = it2 >> 8, g2 = (it2 >> 6) & 3, bc2 = it2 & 63;
#pragma unroll
            for (int i = 0; i < 2; ++i) { const int id = tid + NTHR * i, aa = id >> 4, ch = id & 15; u[i] = *(const v4u*)(PBUF + (size_t)(b2 * SEQ + 64 * aa + bc2) * INP + PC_U + g2 * 128 + ch * 8); } }
        const int ct = wave & 3, rt = wave >> 2;
        f32x16 zr, zi;
#pragma unroll
        for (int i = 0; i < 16; ++i) { zr[i] = 0.f; zi[i] = 0.f; }
#pragma unroll
        for (int s = 0; s < 8; ++s) { const bf16x8 B = *(const LAS bf16x8*)(XT + (32 * ct + r) * 272 + (16 * s + 8 * h) * 2);
            const bf16x8 Ar = *(const LAS bf16x8*)(M64 + (32 * rt + r) * 272 + (16 * s + 8 * h) * 2), Ai = *(const LAS bf16x8*)(M64 + (64 + 32 * rt + r) * 272 + (16 * s + 8 * h) * 2);
            zr = MFMA32(Ar, B, zr); zi = MFMA32(Ai, B, zi); }
        if (run) { bf16* zo = ZB + ((size_t)((b * 4 + g) * 64) * 64 + bcol) * 256 + 32 * ct + r;
#pragma unroll
            for (int i = 0; i < 16; ++i) { const int c = 32 * rt + crow32(i, h); const float f = (float)((bcol * c) & 4095) * (1.0f / 4096.0f), cs = cosrev(f), sn = sinrev(f);
                const float vr = zr[i] * cs + zi[i] * sn, vi = zi[i] * cs - zr[i] * sn;
                bf16* p = zo + (size_t)c * 64 * 256; const unsigned z2 = cvtpk(vr, vi); p[0] = (bf16)(z2 & 0xffffu); p[128] = (bf16)(z2 >> 16); } }
        item = nitem;
    }
    return item;
}
__device__ __forceinline__ void four_b_setup(const Wg& w, bf16x8 (&M2)[8]) {
    const int lane = w.lane, wave = w.wave, r = lane & 31, h = lane >> 5, d = 32 * (wave >> 2) + r;
#pragma unroll
    for (int s = 0; s < 8; ++s) { unsigned pk[4];
#pragma unroll
        for (int j = 0; j < 4; ++j) { const int bc = (16 * s + 8 * h + 2 * j) >> 1; const float f = (float)((bc * d) & 63) * (1.0f / 64.0f); pk[j] = cvtpk(cosrev(f), sinrev(f)); }
        M2[s] = __builtin_bit_cast(bf16x8, (v4u){pk[0], pk[1], pk[2], pk[3]}); }
}
constexpr int FB_N = 4;
__device__ __forceinline__ void four_b_item(const Args& a, const Wg& w, const bf16x8 (&M2)[8], const int item) {
    const int tid = w.tid, lane = w.lane, wave = w.wave, r = lane & 31, h = lane >> 5, dt = wave >> 2, ct = wave & 3;
    const bf16* ZB = WS_PTR(bf16, WS_ZBUF); bf16* MIX = WS_PTR(bf16, WS_MIX);
    const float scale = 1.0f / sqrtf(4096.0f * 128.0f);
    const int b = item >> 6, g = (item >> 4) & 3, c0 = (item & 15) * FB_N;
    const bf16* zt = ZB + (size_t)((b * 4 + g) * 64 + c0) * 64 * 256;
    v4u v[FB_N][4];
#pragma unroll
    for (int t = 0; t < FB_N; ++t)
#pragma unroll
        for (int i = 0; i < 4; ++i) v[t][i] = *(const v4u*)(zt + (size_t)t * 64 * 256 + (size_t)(tid + NTHR * i) * 8);
#pragma unroll
    for (int t = 0; t < FB_N; ++t) { LAS unsigned char* ZT = w.lds + t * 33792;
#pragma unroll
        for (int i = 0; i < 4; ++i) { const int id = tid + NTHR * i, row = id >> 4, ch = id & 15;
            *(LAS v2u*)(ZT + row * 264 + ch * 16) = (v2u){v[t][i].x, v[t][i].y}; *(LAS v2u*)(ZT + row * 264 + ch * 16 + 8) = (v2u){v[t][i].z, v[t][i].w}; } }
    __syncthreads();
#pragma unroll
    for (int t = 0; t < FB_N; ++t) { const LAS unsigned char* ZT = w.lds + t * 33792;
        f32x16 y;
#pragma unroll
        for (int i = 0; i < 16; ++i) y[i] = 0.f;
#pragma unroll
        for (int s = 0; s < 8; ++s) y = MFMA32(M2[s], tr_frag32((unsigned)(size_t)ZT, 264, 16 * s, 32 * ct, lane), y);
        bf16* mo = MIX + (size_t)(b * SEQ + c0 + t) * D + g * 128 + 32 * ct + r;
#pragma unroll
        for (int i = 0; i < 16; ++i) { const int d = 32 * dt + crow32(i, h); mo[(size_t)d * 64 * D] = bf1(y[i] * scale); } }
}
__device__ __forceinline__ void ph_mix_a(const Args& a, const Wg& w, const int l, const int rep = 0, const int mask = 7) {
    unsigned* ctr = (unsigned*)(a.ws + WS_CTL) + CW_Q + 64 * (2 * l) + 256 * rep;
    volatile LAS int* slot = (volatile LAS int*)(w.lds + GL_SLOT);
    const int nc1 = (l == 0) ? NC * 4 / 64 : 0;
    int par = 0; int item = wq_next(ctr, slot + 2, w.tid);
    if (item < nc1) {
        bf16x8 T1[8]; four_t1_setup(w, T1);
        while (item < nc1) { const int c = wq_claim(ctr, w.tid); if (mask & 4) ctx_dft1_item(a, w, T1, item); item = wq_take(slot, par, c, w.tid); }
    }
    while (item < nc1 + NG1) { const int c = wq_claim(ctr, w.tid); if (mask & 1) gla_g1_job(a, w, l, item - nc1, rep ? REP_VAR : 0); item = wq_take(slot, par, c, w.tid); }
    if (item < nc1 + NG1 + 2048) {
        bf16x8 T1[8]; four_a_setup(w, T1);
        item = four_a_loop(a, w, T1, ctr, slot, par, item, nc1 + NG1, nc1 + NG1 + 2048, (mask & 2) != 0);
    }
}
__device__ __forceinline__ void ph_mix_c(const Args& a, const Wg& w, const int l, const int rep = 0, const int mask = 7) {
    unsigned* ctr = (unsigned*)(a.ws + WS_CTL) + CW_Q + 64 * (2 * l + 1) + 256 * rep;
    volatile LAS int* slot = (volatile LAS int*)(w.lds + GL_SLOT);
    const int ng3 = (l == 0) ? 544 : 512, nctx = (l == 0) ? 128 : 0;
    int par = 0; int item = wq_next(ctr, slot + 2, w.tid);
    if (item < nctx) {
        while (item < nctx) { const int c = wq_claim(ctr, w.tid); if (mask & 4) ctx_dft2_item(a, w, item); item = wq_take(slot, par, c, w.tid); }
    }
    while (item < nctx + ng3) {
        const int it = item - nctx, job = (l == 0) ? it : ((it >> 4) * 17 + (it & 15) + 1);
        const int c = wq_claim(ctr, w.tid); if (mask & 1) gla_g3_job(a, w, l, job, rep ? REP_VAR : 0); item = wq_take(slot, par, c, w.tid); }
    if (item < nctx + ng3 + 2048 / FB_N) {
        bf16x8 M2[8]; four_b_setup(w, M2);
        while (item < nctx + ng3 + 2048 / FB_N) { const int c = wq_claim(ctr, w.tid); __syncthreads(); if (mask & 2) four_b_item(a, w, M2, item - nctx - ng3); item = wq_take(slot, par, c, w.tid); }
    }
}
constexpr int CONV_WAVE_ITEMS = 16 * (16 * 112) + 8 * (56 * 32), CONV_ITEMS = CONV_WAVE_ITEMS / 8;
static_assert(CONV_WAVE_ITEMS % 8 == 0, "conversion items");
__device__ __forceinline__ void conv_items(const Args& a, const Wg& w, const int max_items) {
    const float* moe_w1 = a.in[19]; const float* moe_w3 = a.in[20]; const float* moe_w2 = a.in[21];
    unsigned char* MW13 = WS_PTR(unsigned char, WS_MW13); unsigned char* MW2 = WS_PTR(unsigned char, WS_MW2);
    unsigned* ctr = (unsigned*)(a.ws + WS_CTL) + CW_CONVQ;
    volatile LAS int* slot = (volatile LAS int*)(w.lds + 72 * 1024);
    LAS float* scr = (LAS float*)(w.lds + 1024 + w.wave * 8448);
    constexpr int I_M13 = 16 * 112, I_M2 = 56 * 32;
    for (int n = 0; n < max_items; ++n) {
        const int item = wq_next(ctr, slot, w.tid);
        if (item >= CONV_ITEMS) break;
        int r = item * 8 + w.wave;
        if (r < 8 * I_M13) { const int e = r / I_M13; transpose_item8(moe_w1 + (size_t)e * D * EFF, D, EFF, MW13 + (size_t)e * 2 * EFF * D, 0, 1, FP8_SW, scr, r % I_M13, w.lane); continue; } r -= 8 * I_M13;
        if (r < 8 * I_M13) { const int e = r / I_M13; transpose_item8(moe_w3 + (size_t)e * D * EFF, D, EFF, MW13 + (size_t)e * 2 * EFF * D, 0, 2, FP8_SW, scr, r % I_M13, w.lane); continue; } r -= 8 * I_M13;
        { const int e = r / I_M2; transpose_item8(moe_w2 + (size_t)e * EFF * D, EFF, D, MW2 + (size_t)e * D * EFF, 0, 0, FP8_SW, scr, r % I_M2, w.lane); }
    }
    __syncthreads();
}
__device__ __forceinline__ void conv_in_tail(const Args& a, const Wg& w, const int nunits, const int quota) {
    const int mine = (nunits - w.bx + w.G - 1) / w.G, most = (nunits + w.G - 1) / w.G;
    if (mine < most) conv_items(a, w, quota);
}
__device__ __forceinline__ void ph_gout(const Args& a, const Wg& w, const int l) {
    const float* modl = WS_PTR(float, WS_MODV) + (size_t)l * 9 * MOD6;
    pg8::DenseOrder S; S.init(WS_PTR(bf16, WS_MIX), WS_PTR(bf16, WS_WOUT) + (size_t)l * D * D, l == 0 ? MT : NL, D, D, w.G, w.bx);
    pg8::EpiRes E{l == 0 ? a.in[0] : nullptr, l == 0 ? a.in[2] : nullptr, WS_PTR(bf16, WS_XRES), modl + 2 * D, 1.0f};
    pg8::gemm_phase<pg8::EpiRes, pg8::DenseOrder, true, false>(w.lds, D, S, E);
    if (l == 0) conv_in_tail(a, w, (MT / 256) * (D / 256), CONV_Q_GOUT);
}
__device__ __forceinline__ void ph_fup(const Args& a, const Wg& w) {
    constexpr int KA = (FP8_FUP || I8_FUP) ? D / 2 : D;
    pg8::DenseOrder S; S.init(WS_PTR(bf16, WS_HBUF), WS_PTR(bf16, WS_W13), MT, 2 * DFF, KA, w.G, w.bx);
    constexpr float inv = FP8_FUP ? 1.0f / (FP8_SH * FP8_SW) : 1.0f;
    if constexpr (I8_FUP) { static_assert(FP8_FDN, "the int8 up GEMM writes an fp8 hidden");
        pg8::EpiSwiGLU8i E{WS_PTR(unsigned char, WS_HID), DFF, WS_PTR(float, WS_RS), WS_PTR(float, WS_WCS) + WCS_W1, WS_PTR(float, WS_WCS) + WCS_W3, FP8_SHID}; pg8::gemm_phase<pg8::EpiSwiGLU8i, pg8::DenseOrder, true, false, 2>(w.lds, KA, S, E); }
    else if constexpr (FP8_FDN) { pg8::EpiSwiGLU8 E{WS_PTR(unsigned char, WS_HID), DFF, inv, FP8_SHID, 0}; pg8::gemm_phase<pg8::EpiSwiGLU8, pg8::DenseOrder, true, false, FP8_FUP ? 1 : 0>(w.lds, KA, S, E); }
    else { pg8::EpiSwiGLU E{WS_PTR(bf16, WS_HID), DFF, inv}; pg8::gemm_phase<pg8::EpiSwiGLU, pg8::DenseOrder, true, false, FP8_FUP ? 1 : 0>(w.lds, KA, S, E); }
    conv_in_tail(a, w, (MT / 256) * (2 * DFF / 256), CONV_Q_FUP);
}
__device__ __forceinline__ void ph_fdn(const Args& a, const Wg& w) {
    const float* modl = WS_PTR(float, WS_MODV);
    constexpr int KA = FP8_FDN ? DFF / 2 : DFF;
    pg8::DenseOrder S; S.init(WS_PTR(bf16, WS_HID), WS_PTR(bf16, WS_W2), MT, D, KA, w.G, w.bx); pg8::EpiRes E{nullptr, nullptr, WS_PTR(bf16, WS_XRES), modl + 5 * D, FP8_FDN ? 1.0f / (FP8_SHID * FP8_SW) : 1.0f};
    pg8::gemm_phase<pg8::EpiRes, pg8::DenseOrder, true, false, FP8_FDN ? 1 : 0>(w.lds, KA, S, E);
    conv_in_tail(a, w, (MT / 256) * (D / 256), CONV_Q_FDN);
}
__device__ __forceinline__ void ph_route(const Args& a, const Wg& w) {
    if (w.bx >= 128) return;
    const int tid = w.tid, lane = w.lane, wave = w.wave;
    const int* TOKE = WS_PTR(int, WS_ROUTE + RT_TOKE); const float* TOKG = WS_PTR(float, WS_ROUTE + RT_TOKG);
    int* RIDX = WS_PTR(int, WS_ROUTE + RT_RIDX); float* RGATE = WS_PTR(float, WS_ROUTE + RT_RGATE); int* TEXP = WS_PTR(int, WS_ROUTE + RT_TEXP); int* NTL = WS_PTR(int, WS_ROUTE + RT_NT);
    const int s = w.bx >> 6, e = (w.bx >> 3) & 7, seg = w.bx & 7;
    LAS int* cnt = (LAS int*)w.lds;
    LAS int* wtot = (LAS int*)(w.lds + 64);
    if (tid < 9) cnt[tid] = 0;
    __syncthreads();
    int lc[9];
#pragma unroll
    for (int q = 0; q < 9; ++q) lc[q] = 0;
    for (int t = 4 * tid; t < NL; t += 4 * NTHR) { const int4 te = *(const int4*)(TOKE + s * NL + t); const int bef = t < seg * 4096;
#pragma unroll
        for (int q = 0; q < 8; ++q) lc[q] += (te.x == q) + (te.y == q) + (te.z == q) + (te.w == q);
        lc[8] += bef ? (te.x == e) + (te.y == e) + (te.z == e) + (te.w == e) : 0; }
#pragma unroll
    for (int q = 0; q < 9; ++q) { int v = lc[q];
#pragma unroll
        for (int o = 1; o < 64; o <<= 1) v += __shfl_xor(v, o);
        if (lane == 0) atomicAdd((int*)&cnt[q], v); }
    __syncthreads();
    int base = 0, total = 0, mycnt = 0;
    for (int q = 0; q < 8; ++q) { const int cq = cnt[q], tq = (cq + 255) >> 8; if (q < e) base += tq * 256; if (q == e) mycnt = cq; total += tq; }
    int running = cnt[8];
    for (int t0 = seg * 4096; t0 < seg * 4096 + 4096; t0 += 4 * NTHR) {
        const int t = t0 + 4 * tid; const int4 te = *(const int4*)(TOKE + s * NL + t);
        const int f0 = te.x == e, f1 = te.y == e, f2 = te.z == e, f3 = te.w == e, mine = f0 + f1 + f2 + f3;
        int incl = mine;
#pragma unroll
        for (int o = 1; o < 64; o <<= 1) { const int v = __shfl_up(incl, o); if (lane >= o) incl += v; }
        const int wt = __shfl(incl, 63);
        __syncthreads();
        if (lane == 0) wtot[wave] = wt;
        __syncthreads();
        int woff = 0, ctot = 0;
#pragma unroll
        for (int q = 0; q < 8; ++q) { const int v = wtot[q]; if (q < wave) woff += v; ctot += v; }
        int pos = s * RT_TILES * 256 + base + running + woff + incl - mine;
        int* POS = WS_PTR(int, WS_ROUTE + RT_POS) + s * NL; const int pb = s * RT_TILES * 256;
        if (f0) { RIDX[pos] = t;     RGATE[pos] = TOKG[s * NL + t];     POS[t] = pos - pb;     ++pos; }
        if (f1) { RIDX[pos] = t + 1; RGATE[pos] = TOKG[s * NL + t + 1]; POS[t + 1] = pos - pb; ++pos; }
        if (f2) { RIDX[pos] = t + 2; RGATE[pos] = TOKG[s * NL + t + 2]; POS[t + 2] = pos - pb; ++pos; }
        if (f3) { RIDX[pos] = t + 3; RGATE[pos] = TOKG[s * NL + t + 3]; POS[t + 3] = pos - pb; ++pos; }
        running += ctot; }
    if (seg == 0) {
        const int padend = base + ((mycnt + 255) >> 8) * 256;
        for (int p = base + mycnt + tid; p < padend; p += NTHR) { RIDX[s * RT_TILES * 256 + p] = -1; RGATE[s * RT_TILES * 256 + p] = 0.f; }
        for (int tl = (base >> 8) + tid; tl < (padend >> 8); tl += NTHR) TEXP[s * RT_TILES + tl] = e;
        if (e == 0 && tid == 0) NTL[s * 64] = total;
    }
    __syncthreads();
}
__device__ __forceinline__ void ph_mup(const Args& a, const Wg& w, const int skip = 0) {
    const int nt0 = __builtin_amdgcn_readfirstlane(__hip_atomic_load(WS_PTR(int, WS_ROUTE + RT_NT), __ATOMIC_RELAXED, __HIP_MEMORY_SCOPE_AGENT));
    const int nt1 = __builtin_amdgcn_readfirstlane(__hip_atomic_load(WS_PTR(int, WS_ROUTE + RT_NT) + 64, __ATOMIC_RELAXED, __HIP_MEMORY_SCOPE_AGENT));
    pg8::MoeOrder S; S.oc.init(nt0 + nt1, 2 * EFF / 256, w.G, w.bx); S.A = (const char*)WS_PTR(bf16, WS_HBUF); S.Bt = (const char*)WS_PTR(bf16, WS_MW13); S.tstepA = 0; S.tstepB = (size_t)256 * D; S.estride = (size_t)2 * EFF * D;
    S.texp = WS_PTR(int, WS_ROUTE + RT_TEXP); S.ridx = WS_PTR(int, WS_ROUTE + RT_RIDX); S.nt0 = nt0; S.gap = RT_TILES - nt0;
    pg8::EpiSwiGLU8 E{WS_PTR(unsigned char, WS_HID2), EFF, 1.0f / (FP8_SH * FP8_SW), FP8_SHID, skip};
    pg8::gemm_phase<pg8::EpiSwiGLU8, pg8::MoeOrder, true, true, 1>(w.lds, D / 2, S, E);
}
__device__ __forceinline__ void ph_mdn(const Args& a, const Wg& w, const int s) {
    const int ntl = __builtin_amdgcn_readfirstlane(__hip_atomic_load(WS_PTR(int, WS_ROUTE + RT_NT) + s * 64, __ATOMIC_RELAXED, __HIP_MEMORY_SCOPE_AGENT));
    const float* modl = WS_PTR(float, WS_MODV) + (size_t)9 * MOD6;
    pg8::MoeOrder S; S.oc.init(ntl, D / 256, w.G, w.bx); S.A = (const char*)WS_PTR(unsigned char, WS_HID2) + (size_t)s * RT_TILES * 256 * EFF; S.Bt = (const char*)WS_PTR(bf16, WS_MW2); S.tstepA = (size_t)256 * EFF; S.tstepB = (size_t)256 * EFF; S.estride = (size_t)D * EFF;
    S.texp = WS_PTR(int, WS_ROUTE + RT_TEXP) + s * RT_TILES; S.ridx = WS_PTR(int, WS_ROUTE + RT_RIDX) + s * RT_TILES * 256; S.nt0 = 1 << 30; S.gap = 0;
    pg8::EpiScatter E{WS_PTR(int, WS_ROUTE + RT_RIDX) + s * RT_TILES * 256, WS_PTR(float, WS_ROUTE + RT_RGATE) + s * RT_TILES * 256, WS_PTR(bf16, WS_XRES), modl + 5 * D, 1.0f / (FP8_SHID * FP8_SW)};
    pg8::gemm_phase<pg8::EpiScatter, pg8::MoeOrder, true, false, 1>(w.lds, EFF / 2, S, E);
}
__device__ __forceinline__ void ph_mdn2(const Args& a, const Wg& w) {
    const int nt0 = __builtin_amdgcn_readfirstlane(__hip_atomic_load(WS_PTR(int, WS_ROUTE + RT_NT), __ATOMIC_RELAXED, __HIP_MEMORY_SCOPE_AGENT));
    const int nt1 = __builtin_amdgcn_readfirstlane(__hip_atomic_load(WS_PTR(int, WS_ROUTE + RT_NT) + 64, __ATOMIC_RELAXED, __HIP_MEMORY_SCOPE_AGENT));
    pg8::MoeOrderRM S; S.nwg = (nt0 + nt1) * (D / 256); S.G = w.G; S.c = w.bx; S.A = (const char*)WS_PTR(unsigned char, WS_HID2); S.Bt = (const char*)WS_PTR(bf16, WS_MW2); S.tstepA = (size_t)256 * EFF; S.tstepB = (size_t)256 * EFF; S.estride = (size_t)D * EFF;
    S.texp = WS_PTR(int, WS_ROUTE + RT_TEXP); S.nt0 = nt0; S.gap = RT_TILES - nt0;
    pg8::EpiY E{WS_PTR(float, WS_ROUTE + RT_RGATE), WS_PTR(bf16, WS_Y0), WS_PTR(bf16, WS_HBUF), WS_PTR(bf16, WS_SLOC), 1.0f / (FP8_SHID * FP8_SW), RT_TILES, Y1_SPLIT};
    pg8::gemm_phase<pg8::EpiY, pg8::MoeOrderRM, true, false, 1>(w.lds, EFF / 2, S, E);
}
__device__ __forceinline__ void ph_final2(const Args& a, const Wg& w) {
    const int lane = w.lane; const float* fw = a.in[22]; const bf16* XRES = WS_PTR(bf16, WS_XRES); const bf16* Y0 = WS_PTR(bf16, WS_Y0);
    const bf16* Y1A = WS_PTR(bf16, WS_HBUF); const bf16* Y1B = WS_PTR(bf16, WS_SLOC) - (size_t)Y1_SPLIT * 256 * D;
    const int* POS = WS_PTR(int, WS_ROUTE + RT_POS); const float* gate = WS_PTR(float, WS_MODV) + (size_t)9 * MOD6 + 5 * D;
    f32x4 wv[4];
#pragma unroll
    for (int j = 0; j < 4; ++j) wv[j] = *(const f32x4*)(fw + 4 * lane + 256 * j);
    constexpr int TB = 2;
    int np0[TB], np1[TB];
    { const int m0 = w.gw * TB;
#pragma unroll
      for (int k = 0; k < TB; ++k) { np0[k] = m0 + k < NL ? POS[m0 + k] : 0; np1[k] = m0 + k < NL ? POS[NL + m0 + k] : 0; } }
    for (int m0 = w.gw * TB; m0 < NL; m0 += w.NGW * TB) {
        pg8::u32x2_t xr[TB][4], y0r[TB][4], y1r[TB][4];
#pragma unroll
        for (int k = 0; k < TB; ++k) { const int p0 = __builtin_amdgcn_readfirstlane(np0[k]), p1 = __builtin_amdgcn_readfirstlane(np1[k]);
            const bf16* y1p = (p1 < Y1_SPLIT * 256 ? Y1A : Y1B) + (size_t)p1 * D;
#pragma unroll
            for (int j = 0; j < 4; ++j) { const int c = 4 * lane + 256 * j; xr[k][j] = *(const pg8::u32x2_t*)(XRES + (size_t)(m0 + k) * D + c); y0r[k][j] = *(const pg8::u32x2_t*)(Y0 + (size_t)p0 * D + c); y1r[k][j] = *(const pg8::u32x2_t*)(y1p + c); } }
        { const int mn = m0 + w.NGW * TB;
#pragma unroll
          for (int k = 0; k < TB; ++k) { np0[k] = mn + k < NL ? POS[mn + k] : 0; np1[k] = mn + k < NL ? POS[NL + mn + k] : 0; } }
        const float* gp = gate + (m0 >> 12) * MOD6;
        f32x4 g[4];
#pragma unroll
        for (int j = 0; j < 4; ++j) g[j] = *(const f32x4*)(gp + 4 * lane + 256 * j);
#pragma unroll
        for (int k = 0; k < TB; ++k) {
            f32x4 v[4]; float ss = 0.f;
#pragma unroll
            for (int j = 0; j < 4; ++j) { v[j] = pg8::bf4_to_f32(xr[k][j]) + g[j] * (pg8::bf4_to_f32(y0r[k][j]) + pg8::bf4_to_f32(y1r[k][j])); ss += (v[j].x * v[j].x + v[j].y * v[j].y) + (v[j].z * v[j].z + v[j].w * v[j].w); }
            const float rstd = 1.0f / sqrtf(wave_sum(ss) * (1.0f / D) + EPS);
            float* xo = a.out + (size_t)(m0 + k) * D;
#pragma unroll
            for (int j = 0; j < 4; ++j) *(f32x4*)(xo + 4 * lane + 256 * j) = (v[j] * rstd) * wv[j]; }
    }
}
__device__ __forceinline__ void ph_final(const Args& a, const Wg& w) {
    const int lane = w.lane; const float* fw = a.in[22]; const bf16* XRES = WS_PTR(bf16, WS_XRES);
    for (int m = w.gw; m < NL; m += w.NGW) {
        float* xr = a.out + (size_t)m * D;
        f32x4 v[4]; float ss = 0.f;
#pragma unroll
        for (int j = 0; j < 4; ++j) { v[j] = pg8::bf4_to_f32(*(const pg8::u32x2_t*)(XRES + (size_t)m * D + 4 * lane + 256 * j)); ss += (v[j].x * v[j].x + v[j].y * v[j].y) + (v[j].z * v[j].z + v[j].w * v[j].w); }
        const float rstd = 1.0f / sqrtf(wave_sum(ss) * (1.0f / D) + EPS);
#pragma unroll
        for (int j = 0; j < 4; ++j) { const int c = 4 * lane + 256 * j; *(f32x4*)(xr + c) = (v[j] * rstd) * *(const f32x4*)(fw + c); }
    }
}

constexpr int NPH = 23;
__global__ void __launch_bounds__(NTHR, 2) fwd_kernel(Args args) {
    extern __shared__ __attribute__((aligned(16))) unsigned char lds_raw[];
    Wg w; w.lds = (LAS unsigned char*)lds_raw;
    volatile LAS unsigned* MISC = (volatile LAS unsigned*)(w.lds + MISC_OFF);
    w.wave = __builtin_amdgcn_readfirstlane((int)threadIdx.x >> 6); w.lane = (int)__builtin_amdgcn_mbcnt_hi(~0u, __builtin_amdgcn_mbcnt_lo(~0u, 0u)); w.tid = w.wave * 64 + w.lane;
    w.G = gridDim.x; w.bx = blockIdx.x; w.gw = w.bx * NWAVES + w.wave; w.NGW = w.G * NWAVES;
    unsigned* ctl = (unsigned*)(args.ws + WS_CTL);
    for (int u = w.tid; u < (LDS_BYTES - LDSCTL_OFF) / 4; u += NTHR) ((LAS unsigned*)(w.lds + LDSCTL_OFF))[u] = 0u;
    __syncthreads();
    XcdBarrier bar; bar.bar = ctl + CW_BAR; bar.x = 0; bar.st = nullptr;
    if (!MK_MULTI) bar = xcd_barrier_post(ctl + CW_BAR, MISC + 8);
    const int lo = args.ph_lo, hi = args.ph_hi;
#define PH(id, call) do { if (lo <= (id) && (id) < hi) { call; if (!MK_MULTI && (id) + 1 < hi) xcd_barrier(bar); } } while (0)
#define PHR(n, id, call) do { if ((n) > 1) { call; xcd_barrier(bar); } PH(id, call); } while (0)
    PHR(REP_PRO, 0, ph_prologue(args, w));
    PH(1, ph_modfin(args, w));
    PHR(REP_NORM, 2, (ph_norm(args, w, 0, 0), ph_quant(args, w)));
    PHR(REP_GIN, 3, ph_gin(args, w, 0));
    if (REP_MIXA > 1) { ph_mix_a(args, w, 0, 1, REP_MASK); xcd_barrier(bar); }
    PH(4, ph_mix_a(args, w, 0));
    PH(5, ph_gla_scan(args, w));
    if (REP_MIXC > 1) { ph_mix_c(args, w, 0, 1, REP_MASK); xcd_barrier(bar); }
    PH(6, ph_mix_c(args, w, 0));
    PHR(REP_GOUT, 7, ph_gout(args, w, 0));
    PHR(REP_NORM, 8, ph_norm(args, w, 0, 1));
    PHR(REP_FUP, 9, ph_fup(args, w));
    PH(10, ph_fdn(args, w));
    PHR(REP_NORM, 11, ph_norm(args, w, 1, 0));
    PHR(REP_GIN, 12, ph_gin(args, w, 1));
    if (REP_MIXA > 1) { ph_mix_a(args, w, 1, 1, REP_MASK); xcd_barrier(bar); }
    PH(13, ph_mix_a(args, w, 1));
    PH(14, ph_gla_scan(args, w));
    if (REP_MIXC > 1) { ph_mix_c(args, w, 1, 1, REP_MASK); xcd_barrier(bar); }
    PH(15, ph_mix_c(args, w, 1));
    PH(16, ph_gout(args, w, 1));
    PHR(REP_NORM, 17, ph_norm(args, w, 1, 1));
    PHR(REP_PRO, 18, (ph_route(args, w), conv_items(args, w, 1 << 30)));
    if (REP_MUP > 1) { ph_mup(args, w, REP_VAR); xcd_barrier(bar); } PH(19, ph_mup(args, w));
#if MDN_MERGE
    PH(20, ph_mdn2(args, w));
    PH(21, ph_final2(args, w));
#else
    PH(20, ph_mdn(args, w, 0));
    PH(21, ph_mdn(args, w, 1));
    PH(22, ph_final(args, w));
#endif
#undef PH
#undef PHR
}

extern "C" void kernel_launch(void* const* d_in, const int* in_sizes, int n_in, void* d_out, int out_size, void* d_ws, size_t ws_size, hipStream_t stream) {
    static int grid = 0;
    if (grid == 0) {
        if (n_in != 23 || out_size != NL * D || ws_size < WS_END) { fprintf(stderr, "kernel_launch: unexpected shapes (n_in %d, out %d, ws %zu < %zu); nothing launched\n", n_in, out_size, ws_size, (size_t)WS_END); grid = -1; return; }
        int dev = 0, cus = 0, per_cu = 0;
        if (hipGetDevice(&dev) != hipSuccess || hipDeviceGetAttribute(&cus, hipDeviceAttributeMultiprocessorCount, dev) != hipSuccess) { grid = -1; return; }
        if (hipFuncSetAttribute((const void*)fwd_kernel, hipFuncAttributeMaxDynamicSharedMemorySize, LDS_BYTES) != hipSuccess) { fprintf(stderr, "kernel_launch: hipFuncSetAttribute failed\n"); grid = -1; return; }
        if (hipOccupancyMaxActiveBlocksPerMultiprocessor(&per_cu, (const void*)fwd_kernel, NTHR, LDS_BYTES) != hipSuccess || per_cu < 1) { fprintf(stderr, "kernel_launch: occupancy query says %d blocks per CU\n", per_cu); }
        (void)hipGetLastError();
        grid = cus;
    }
    if (grid < 0) return;
    if (hipMemsetAsync((char*)d_ws + WS_CTL, 0, CTL_ZERO_BYTES, stream) != hipSuccess) { fprintf(stderr, "kernel_launch: memset failed\n"); return; }
    Args a{};
    for (int i = 0; i < 23; ++i) a.in[i] = (const float*)d_in[i];
    a.out = (float*)d_out; a.ws = (unsigned char*)d_ws; a.pad = 0;
#if MK_MULTI
    for (int p = 0; p < NPH; ++p) { a.ph_lo = p; a.ph_hi = p + 1; a.li = p; hipLaunchKernelGGL(fwd_kernel, dim3(grid), dim3(NTHR), LDS_BYTES, stream, a); }
#else
    a.ph_lo = 0; a.ph_hi = MDN_MERGE ? 22 : NPH; a.li = 0;
    hipLaunchKernelGGL(fwd_kernel, dim3(grid), dim3(NTHR), LDS_BYTES, stream, a);
#endif
    const hipError_t le = hipPeekAtLastError();
    if (le != hipSuccess) fprintf(stderr, "kernel_launch: launch failed: %s\n", hipGetErrorName(le));
}
```
